# Optimizing an MI355X kernel written in HIP

```python
import math
import jax
import jax.numpy as jnp
from jax import lax
import numpy as np

D_MODEL = 1024
BATCH = 8
SEQ = 2048
DEPTH = 4

CTX_LEN = 256
GRID_W = 64
N_MIXERS = 3
N_LAYERS_NA = (DEPTH + 2) // 3
N_LAYERS_DA = (DEPTH + 1) // 3
N_LAYERS_SW = DEPTH // 3
HEAD_DIM = 64
ROPE_AXIS_PAIRS = HEAD_DIM // 4
ROPE_BASE = 10000.0
NA_HEADS = D_MODEL // HEAD_DIM
NA_WIN_R = 8
NA_WIN_C = 16
DA_HEADS = D_MODEL // (2 * HEAD_DIM)
SW_Q_HEADS = D_MODEL // HEAD_DIM
SW_KV_HEADS = 4
SW_WINDOW = 128
Q_BLOCK = 128
N_GROUPS = 4
EXPERTS_PER_GROUP = 8
N_EXPERTS = N_GROUPS * EXPERTS_PER_GROUP
TOP_K = 2
D_EXPERT = 512
NORM_EPS = 1e-6
NEG_INF = -1e30

kernel_name = "hybrid_dit_natten_diff_swa_hmoe"


def _rmsnorm(x, g):
    xf = x.astype(jnp.float32)
    y = xf * lax.rsqrt(jnp.mean(xf * xf, axis=-1, keepdims=True) + NORM_EPS)
    return (y * g.astype(jnp.float32)).astype(x.dtype)


def _adaln(cond, w, b):
    m = (cond @ w + b)[:, None, :]
    return jnp.split(m, 6, axis=-1)


def _modulate(h, shift, scale):
    return h * (1.0 + scale) + shift


def _rope_2d_tables(n_tokens):
    t = jnp.arange(n_tokens, dtype=jnp.int32)
    row = (t // GRID_W).astype(jnp.float32)
    col = (t % GRID_W).astype(jnp.float32)
    inv = ROPE_BASE ** (-jnp.arange(ROPE_AXIS_PAIRS, dtype=jnp.float32) / ROPE_AXIS_PAIRS)
    ang_r = row[:, None] * inv[None, :]
    ang_c = col[:, None] * inv[None, :]
    ang = jnp.concatenate([ang_r, ang_r, ang_c, ang_c], axis=-1)
    return jnp.cos(ang)[:, None, :], jnp.sin(ang)[:, None, :]


def _apply_rope_2d(x, cos, sin):
    xr = x.reshape(x.shape[:-1] + (2, 2, ROPE_AXIS_PAIRS))
    rot = jnp.concatenate([-xr[..., 1:, :], xr[..., :1, :]], axis=-2).reshape(x.shape)
    return x * cos.astype(x.dtype) + rot * sin.astype(x.dtype)


def neighbourhood_attention(hx, hc, w_qkv, rpb, w_o, with_ctx_out):
    B, S, _ = hx.shape
    L = hc.shape[1]
    H, dh = NA_HEADS, HEAD_DIM
    rows = S // GRID_W
    win_r = min(NA_WIN_R, rows)
    scale = dh ** -0.5
    qkv_x = (hx @ w_qkv).reshape(B, S, 3, H, dh)
    qkv_c = (hc @ w_qkv).reshape(B, L, 3, H, dh)
    qc, kc, vc = qkv_c[:, :, 0], qkv_c[:, :, 1], qkv_c[:, :, 2]
    qg = qkv_x[:, :, 0].reshape(B, rows, GRID_W, H, dh)
    kg = qkv_x[:, :, 1].reshape(B, rows, GRID_W, H, dh)
    vg = qkv_x[:, :, 2].reshape(B, rows, GRID_W, H, dh)
    qcol = jnp.arange(GRID_W)
    kcol = jnp.arange(GRID_W)
    c0 = jnp.clip(qcol - NA_WIN_C // 2, 0, GRID_W - NA_WIN_C)
    col_ok = (kcol[None, :] >= c0[:, None]) & (kcol[None, :] < c0[:, None] + NA_WIN_C)
    col_idx = jnp.clip(kcol[None, :] - qcol[:, None] + NA_WIN_C - 1, 0, 2 * NA_WIN_C - 2)
    rpb_f = rpb.astype(jnp.float32)

    def row_block(r):
        r0 = jnp.clip(r - win_r // 2, 0, rows - win_r)
        q_r = lax.dynamic_index_in_dim(qg, r, axis=1, keepdims=False)
        k_r = lax.dynamic_slice_in_dim(kg, r0, win_r, axis=1)
        v_r = lax.dynamic_slice_in_dim(vg, r0, win_r, axis=1)
        s_nb = jnp.einsum('bqhd,bykhd->bhqyk', q_r, k_r).astype(jnp.float32) * scale
        row_idx = r0 + jnp.arange(win_r) - r + NA_WIN_R - 1
        bias = rpb_f[:, row_idx][:, :, col_idx].transpose(0, 2, 1, 3)
        s_nb = jnp.where(col_ok[:, None, :], s_nb + bias[None], NEG_INF)
        s_cx = jnp.einsum('bqhd,bkhd->bhqk', q_r, kc).astype(jnp.float32) * scale
        s_all = jnp.concatenate([s_cx, s_nb.reshape(B, H, GRID_W, win_r * GRID_W)], axis=-1)
        p = jax.nn.softmax(s_all, axis=-1).astype(hx.dtype)
        o = jnp.einsum('bhqk,bkhd->bqhd', p[..., :L], vc)
        o = o + jnp.einsum('bhqk,bkhd->bqhd', p[..., L:], v_r.reshape(B, win_r * GRID_W, H, dh))
        return o

    o = lax.map(row_block, jnp.arange(rows))
    ox = o.transpose(1, 0, 2, 3, 4).reshape(B, S, H * dh) @ w_o
    oc = None
    if with_ctx_out:
        s = jnp.einsum('bqhd,bkhd->bhqk', qc, kc).astype(jnp.float32) * scale
        p = jax.nn.softmax(s, axis=-1).astype(hc.dtype)
        oc = jnp.einsum('bhqk,bkhd->bqhd', p, vc).reshape(B, L, H * dh) @ w_o
    return ox, oc


def differential_attention(hx, hc, w_qkv, lam_params, subln_g, w_o, layer_idx, rope_cos, rope_sin, with_ctx_out):
    B, S, _ = hx.shape
    L = hc.shape[1]
    H, dh = DA_HEADS, HEAD_DIM
    nq = 2 * H * dh
    scale = dh ** -0.5

    def proj(h):
        t = h @ w_qkv
        q = t[..., :nq].reshape(B, -1, 2 * H, dh)
        k = t[..., nq:2 * nq].reshape(B, -1, 2 * H, dh)
        v = t[..., 2 * nq:].reshape(B, -1, H, 2 * dh)
        return q, k, v

    qx, kx, vx = proj(hx)
    qc, kc, vc = proj(hc)
    qx = _apply_rope_2d(qx, rope_cos, rope_sin)
    kx = _apply_rope_2d(kx, rope_cos, rope_sin)
    lam_init = 0.8 - 0.6 * math.exp(-0.3 * layer_idx)
    lp = lam_params.astype(jnp.float32)
    lam = jnp.exp(jnp.sum(lp[0] * lp[1])) - jnp.exp(jnp.sum(lp[2] * lp[3])) + lam_init

    def attend(q, k, v):
        n = q.shape[1]
        q = q.reshape(B, n, H, 2, dh)
        s = jnp.einsum('bqhjd,bkhjd->bhjqk', q, k).astype(jnp.float32) * scale
        p = jax.nn.softmax(s, axis=-1)
        a = (p[:, :, 0] - lam * p[:, :, 1]).astype(v.dtype)
        o = jnp.einsum('bhqk,bkhe->bqhe', a, v)
        o = _rmsnorm(o, subln_g) * (1.0 - lam_init)
        return o.reshape(B, n, H * 2 * dh)

    kc5 = kc.reshape(B, L, H, 2, dh)
    k_all = jnp.concatenate([kc5, kx.reshape(B, S, H, 2, dh)], axis=1)
    v_all = jnp.concatenate([vc, vx], axis=1)
    nblk = S // Q_BLOCK
    qb = qx.reshape(B, nblk, Q_BLOCK, 2 * H, dh).transpose(1, 0, 2, 3, 4)
    o = lax.map(lambda qq: attend(qq, k_all, v_all), qb)
    ox = o.transpose(1, 0, 2, 3).reshape(B, S, -1) @ w_o
    oc = None
    if with_ctx_out:
        oc = attend(qc, kc5, vc) @ w_o
    return ox, oc


def sliding_window_gqa(hx, hc, w_qkv, sinks, w_o, rope_cos, rope_sin, with_ctx_out):
    B, S, _ = hx.shape
    L = hc.shape[1]
    Hq, Hk, dh = SW_Q_HEADS, SW_KV_HEADS, HEAD_DIM
    G = Hq // Hk
    nq, nk = Hq * dh, Hk * dh
    scale = dh ** -0.5

    def proj(h):
        t = h @ w_qkv
        q = t[..., :nq].reshape(B, -1, Hq, dh)
        k = t[..., nq:nq + nk].reshape(B, -1, Hk, dh)
        v = t[..., nq + nk:].reshape(B, -1, Hk, dh)
        return q, k, v

    qx, kx, vx = proj(hx)
    qc, kc, vc = proj(hc)
    qx = _apply_rope_2d(qx, rope_cos, rope_sin).reshape(B, S, Hk, G, dh)
    kx = _apply_rope_2d(kx, rope_cos, rope_sin)
    qc = qc.reshape(B, L, Hk, G, dh)
    sink_logit = sinks.astype(jnp.float32).reshape(1, Hk, G, 1, 1)
    band = Q_BLOCK + 2 * SW_WINDOW
    kp = jnp.pad(kx, ((0, 0), (SW_WINDOW, SW_WINDOW), (0, 0), (0, 0)))
    vp = jnp.pad(vx, ((0, 0), (SW_WINDOW, SW_WINDOW), (0, 0), (0, 0)))
    q_local = jnp.arange(Q_BLOCK)
    k_local = jnp.arange(band) - SW_WINDOW
    in_band = jnp.abs(k_local[None, :] - q_local[:, None]) <= SW_WINDOW

    def softmax_with_sink(s_c, s_l):
        sink = jnp.broadcast_to(sink_logit, s_c.shape[:-1] + (1,))
        parts = [sink, s_c] if s_l is None else [sink, s_c, s_l]
        return jax.nn.softmax(jnp.concatenate(parts, axis=-1), axis=-1)[..., 1:]

    def block(n):
        start = n * Q_BLOCK
        q_n = lax.dynamic_slice_in_dim(qx, start, Q_BLOCK, axis=1)
        k_n = lax.dynamic_slice_in_dim(kp, start, band, axis=1)
        v_n = lax.dynamic_slice_in_dim(vp, start, band, axis=1)
        kpos = start + k_local
        valid = in_band & ((kpos >= 0) & (kpos < S))[None, :]
        s_l = jnp.einsum('bqhgd,bkhd->bhgqk', q_n, k_n).astype(jnp.float32) * scale
        s_l = jnp.where(valid, s_l, NEG_INF)
        s_c = jnp.einsum('bqhgd,bkhd->bhgqk', q_n, kc).astype(jnp.float32) * scale
        p = softmax_with_sink(s_c, s_l).astype(hx.dtype)
        o = jnp.einsum('bhgqk,bkhd->bqhgd', p[..., :L], vc)
        o = o + jnp.einsum('bhgqk,bkhd->bqhgd', p[..., L:], v_n)
        return o.reshape(B, Q_BLOCK, Hq * dh)

    o = lax.map(block, jnp.arange(S // Q_BLOCK))
    ox = o.transpose(1, 0, 2, 3).reshape(B, S, Hq * dh) @ w_o
    oc = None
    if with_ctx_out:
        s_c = jnp.einsum('bqhgd,bkhd->bhgqk', qc, kc).astype(jnp.float32) * scale
        p = softmax_with_sink(s_c, None).astype(hc.dtype)
        oc = jnp.einsum('bhgqk,bkhd->bqhgd', p, vc).reshape(B, L, Hq * dh) @ w_o
    return ox, oc


def hierarchical_moe(h, w_grp, b_grp, w_exp, b_exp, w_gate, w_up, w_down):
    T = h.shape[0]
    grp_prob = jax.nn.softmax((h @ w_grp).astype(jnp.float32) + b_grp.astype(jnp.float32), axis=-1)
    g_p, g_idx = lax.top_k(grp_prob, 1)
    exp_logits = ((h @ w_exp).astype(jnp.float32) + b_exp.astype(jnp.float32)).reshape(T, N_GROUPS, EXPERTS_PER_GROUP)
    in_grp = jnp.take_along_axis(exp_logits, g_idx[:, :, None], axis=1)[:, 0]
    top_v, top_i = lax.top_k(in_grp, TOP_K)
    top_w = jax.nn.softmax(top_v, axis=-1) * g_p
    expert_id = g_idx * EXPERTS_PER_GROUP + top_i
    combine = jnp.einsum('tk,tkn->tn', top_w, jax.nn.one_hot(expert_id, N_EXPERTS, dtype=jnp.float32)).astype(h.dtype)
    y = jnp.zeros_like(h)
    for g in range(N_GROUPS):
        sl = slice(g * EXPERTS_PER_GROUP, (g + 1) * EXPERTS_PER_GROUP)
        a = jnp.einsum('td,edf->tef', h, w_gate[sl])
        u = jnp.einsum('td,edf->tef', h, w_up[sl])
        y = y + jnp.einsum('tef,efd->td', jax.nn.silu(a) * u * combine[:, sl, None], w_down[sl])
    return y


def setup_inputs(seed: int = 0) -> dict:
    key = jax.random.key(seed)
    ks = jax.random.split(key, 32)
    D = D_MODEL
    nrm = jax.random.normal
    f32 = jnp.float32
    sw_cols = SW_Q_HEADS * HEAD_DIM + 2 * SW_KV_HEADS * HEAD_DIM
    return {
        "x": nrm(ks[0], (BATCH, SEQ, D), f32),
        "c": nrm(ks[1], (BATCH, D), f32),
        "ctx": nrm(ks[2], (BATCH, CTX_LEN, D), f32),
        "c_ctx": nrm(ks[3], (D,), f32),
        "ada_w": nrm(ks[4], (DEPTH, D, 6 * D), f32) * (0.5 * D ** -0.5),
        "ada_b": nrm(ks[5], (DEPTH, 6 * D), f32) * 0.02,
        "norm_mix_g": 1.0 + 0.02 * nrm(ks[6], (DEPTH, D), f32),
        "norm_ffn_g": 1.0 + 0.02 * nrm(ks[7], (DEPTH, D), f32),
        "final_norm_g": 1.0 + 0.02 * nrm(ks[8], (D,), f32),
        "na_w_qkv": nrm(ks[9], (N_LAYERS_NA, D, 3 * NA_HEADS * HEAD_DIM), f32) * D ** -0.5,
        "na_rpb": nrm(ks[10], (N_LAYERS_NA, NA_HEADS, 2 * NA_WIN_R - 1, 2 * NA_WIN_C - 1), f32) * 0.1,
        "na_w_o": nrm(ks[11], (N_LAYERS_NA, NA_HEADS * HEAD_DIM, D), f32) * (NA_HEADS * HEAD_DIM) ** -0.5,
        "da_w_qkv": nrm(ks[12], (N_LAYERS_DA, D, 6 * DA_HEADS * HEAD_DIM), f32) * D ** -0.5,
        "da_lambda": nrm(ks[13], (N_LAYERS_DA, 4, HEAD_DIM), f32) * 0.1,
        "da_subln_g": 1.0 + 0.02 * nrm(ks[14], (N_LAYERS_DA, 2 * HEAD_DIM), f32),
        "da_w_o": nrm(ks[15], (N_LAYERS_DA, 2 * DA_HEADS * HEAD_DIM, D), f32) * (2 * DA_HEADS * HEAD_DIM) ** -0.5,
        "sw_w_qkv": nrm(ks[16], (N_LAYERS_SW, D, sw_cols), f32) * D ** -0.5,
        "sw_sinks": nrm(ks[17], (N_LAYERS_SW, SW_Q_HEADS), f32),
        "sw_w_o": nrm(ks[18], (N_LAYERS_SW, SW_Q_HEADS * HEAD_DIM, D), f32) * (SW_Q_HEADS * HEAD_DIM) ** -0.5,
        "moe_w_grp": nrm(ks[19], (DEPTH, D, N_GROUPS), f32) * D ** -0.5,
        "moe_b_grp": nrm(ks[20], (DEPTH, N_GROUPS), f32) * 0.01,
        "moe_w_exp": nrm(ks[21], (DEPTH, D, N_EXPERTS), f32) * D ** -0.5,
        "moe_b_exp": nrm(ks[22], (DEPTH, N_EXPERTS), f32) * 0.01,
        "moe_w_gate": nrm(ks[23], (DEPTH, N_EXPERTS, D, D_EXPERT), f32) * D ** -0.5,
        "moe_w_up": nrm(ks[24], (DEPTH, N_EXPERTS, D, D_EXPERT), f32) * D ** -0.5,
        "moe_w_down": nrm(ks[25], (DEPTH, N_EXPERTS, D_EXPERT, D), f32) * D_EXPERT ** -0.5,
    }


def reference(x, c, ctx, c_ctx, ada_w, ada_b, norm_mix_g, norm_ffn_g, final_norm_g,
              na_w_qkv, na_rpb, na_w_o, da_w_qkv, da_lambda, da_subln_g, da_w_o,
              sw_w_qkv, sw_sinks, sw_w_o, moe_w_grp, moe_b_grp, moe_w_exp, moe_b_exp,
              moe_w_gate, moe_w_up, moe_w_down):
    B, S, D = x.shape
    rope_cos, rope_sin = _rope_2d_tables(S)
    cond_lat = jax.nn.silu(c)
    cond_ctx = jax.nn.silu(c_ctx)[None, :]
    xc = ctx
    for i in range(DEPTH):
        need_ctx = i < DEPTH - 1
        sh1, sc1, g1, sh2, sc2, g2 = _adaln(cond_lat, ada_w[i], ada_b[i])
        csh1, csc1, cg1, csh2, csc2, cg2 = _adaln(cond_ctx, ada_w[i], ada_b[i])
        hx = _modulate(_rmsnorm(x, norm_mix_g[i]), sh1, sc1)
        hc = _modulate(_rmsnorm(xc, norm_mix_g[i]), csh1, csc1)
        kind, j = i % N_MIXERS, i // N_MIXERS
        if kind == 0:
            ox, oc = neighbourhood_attention(hx, hc, na_w_qkv[j], na_rpb[j], na_w_o[j], need_ctx)
        elif kind == 1:
            ox, oc = differential_attention(hx, hc, da_w_qkv[j], da_lambda[j], da_subln_g[j], da_w_o[j],
                                            i, rope_cos, rope_sin, need_ctx)
        else:
            ox, oc = sliding_window_gqa(hx, hc, sw_w_qkv[j], sw_sinks[j], sw_w_o[j],
                                        rope_cos, rope_sin, need_ctx)
        x = x + g1 * ox
        hx = _modulate(_rmsnorm(x, norm_ffn_g[i]), sh2, sc2)
        if need_ctx:
            xc = xc + cg1 * oc
            hc = _modulate(_rmsnorm(xc, norm_ffn_g[i]), csh2, csc2)
            n_c = hc.shape[0] * hc.shape[1]
            y = hierarchical_moe(jnp.concatenate([hc.reshape(-1, D), hx.reshape(-1, D)], axis=0),
                                 moe_w_grp[i], moe_b_grp[i], moe_w_exp[i], moe_b_exp[i],
                                 moe_w_gate[i], moe_w_up[i], moe_w_down[i])
            xc = xc + cg2 * y[:n_c].reshape(hc.shape)
            x = x + g2 * y[n_c:].reshape(hx.shape)
        else:
            y = hierarchical_moe(hx.reshape(-1, D), moe_w_grp[i], moe_b_grp[i], moe_w_exp[i], moe_b_exp[i],
                                 moe_w_gate[i], moe_w_up[i], moe_w_down[i])
            x = x + g2 * y.reshape(hx.shape)
    return _rmsnorm(x, final_norm_g)
```

```cpp
#include <hip/hip_runtime.h>
#include <cstdio>
#include <cstdint>

#ifndef ONE_LAUNCH
#define ONE_LAUNCH 1
#define PROBE_REP 0ull
#ifndef IGLP_ATT
#define IGLP_ATT 3
#endif


#endif

#define DI __device__ __forceinline__
#define LAS __attribute__((address_space(3)))
typedef unsigned short bf16;
typedef short bf16x8 __attribute__((ext_vector_type(8)));
typedef float f32x16 __attribute__((ext_vector_type(16)));
typedef float f32x4 __attribute__((ext_vector_type(4)));
typedef float f32x2 __attribute__((ext_vector_type(2)));
typedef unsigned u32x4 __attribute__((ext_vector_type(4)));
typedef unsigned u32x2 __attribute__((ext_vector_type(2)));
typedef __bf16 bf16x2_t __attribute__((ext_vector_type(2)));
#define MFMA(a, b, c) __builtin_amdgcn_mfma_f32_32x32x16_bf16((a), (b), (c), 0, 0, 0)

constexpr int D = 1024, NB = 8, SEQ = 2048, CTX = 256, DEPTH = 4;
constexpr int TPB = CTX + SEQ;
constexpr int T = NB * TPB;
constexpr int NEXP = 32, DEXP = 512;
constexpr int LCAP = T;
constexpr float EPS = 1e-6f;
constexpr float LOG2E = 1.4426950408889634f;
constexpr float SM_C = 0.125f * LOG2E;
constexpr float NEG = -1e30f;

constexpr size_t MiB = 1u << 20;
constexpr size_t WS_CTL = 0, CTL_BYTES = 65536;
constexpr size_t WS_MOD = 1 * MiB;
constexpr size_t WS_ROPE = 2 * MiB;
constexpr size_t WS_LTOK = 3 * MiB;
constexpr size_t WS_LW = 6 * MiB;
constexpr size_t WS_WR = 9 * MiB;
constexpr size_t WS_WQKV = 416 * MiB;
constexpr size_t WS_WO = 440 * MiB;
constexpr size_t WS_GM = 10 * MiB;
constexpr size_t WS_RC = 11 * MiB;
constexpr size_t WS_RPB = 12 * MiB;
constexpr size_t WS_XRES = 16 * MiB;
constexpr size_t WS_H = 96 * MiB;
constexpr size_t WS_Q = 136 * MiB;
constexpr size_t WS_K = 176 * MiB;
constexpr size_t WS_VT = 216 * MiB;
constexpr size_t WS_O = 256 * MiB;
constexpr size_t WS_ACT = 296 * MiB;
constexpr size_t WS_YP = 336 * MiB;
constexpr size_t WS_WMG = 448 * MiB;
constexpr size_t WS_WMU = 480 * MiB;
constexpr size_t WS_WMD = 512 * MiB;
constexpr size_t WS_END = 544 * MiB;
constexpr int CW_BAR = 0;
constexpr int CW_CNT = 8192;

constexpr int NTHREADS = 256;
constexpr int LDS_GEMM = 73728;
constexpr int LDS_MISC = LDS_GEMM;
constexpr int LDS_BYTES = LDS_GEMM + 1024;
constexpr int NPHASES = 2 + 7 * DEPTH;

struct Params {
    const float* in[26];
    float* out;
    unsigned char* ws;
    int ph_lo, ph_hi;
};

DI unsigned pk2(float lo, float hi) { f32x2 v = {lo, hi}; bf16x2_t r = __builtin_convertvector(v, bf16x2_t); return __builtin_bit_cast(unsigned, r); }
DI float bf2f(unsigned short u) { return __builtin_bit_cast(float, (unsigned)u << 16); }
DI float wave_sum(float v) {
#pragma unroll
    for (int o = 1; o < 64; o <<= 1) v += __shfl_xor(v, o);
    return v;
}
DI float fexp2(float x) { return __builtin_amdgcn_exp2f(x); }
DI float silu(float v) { return v / (1.f + __expf(-v)); }
DI bf16x8 ldg8(const bf16* p) { return *(const bf16x8*)p; }
DI void glds16(const void* g, LAS unsigned char* l) {
    __builtin_amdgcn_global_load_lds((const unsigned*)g, (LAS unsigned*)l, 16, 0, 0);
}
DI int pi32(int r) { return (r & 0x13) | ((r & 4) << 1) | ((r & 8) >> 1); }

#define XB_TMO      128
#define XB_XCNT(j)  (256  + 64 * (j))
#define XB_XSUB(j)  (1280 + 64 * (j))
#define XB_XGEN(j)  (2304 + 64 * (j))
#define XB_TOP      3328
#define XB_TOPGEN   3392
#define XCD_BAR_WORDS 3456
#define XB_SPIN_CAP (1u << 20)
DI unsigned xb_ld(unsigned* p) { return __hip_atomic_load(p, __ATOMIC_RELAXED, __HIP_MEMORY_SCOPE_AGENT); }
DI unsigned xb_add(unsigned* p, unsigned v) { return __hip_atomic_fetch_add(p, v, __ATOMIC_RELAXED, __HIP_MEMORY_SCOPE_AGENT); }
DI unsigned xb_xcc_id() { return (unsigned)__builtin_amdgcn_s_getreg((3 << 11) | 20) & 0xFu; }
#define XB_SPIN(cond, bar) do { unsigned _sp = 0; while (cond) { __builtin_amdgcn_s_sleep(1); \
    if ((++_sp & 255u) == 0u) { if (xb_ld(&(bar)[XB_TMO])) break; if (_sp > XB_SPIN_CAP) { atomicAdd(&(bar)[XB_TMO], 1u); break; } } } } while (0)
struct XcdBarrier { unsigned* bar; unsigned x; volatile LAS unsigned* st; };
DI XcdBarrier xcd_barrier_post(unsigned* bar, volatile LAS unsigned* st) {
    XcdBarrier b; b.bar = bar; b.x = xb_xcc_id(); b.st = st;
    if (threadIdx.x == 0) (void)xb_add(&bar[XB_XCNT(b.x)], 1u);
    return b;
}
DI void xcd_barrier_complete(unsigned* bar, unsigned x, unsigned& nloc, unsigned& nx) {
    const unsigned G = gridDim.x * gridDim.y * gridDim.z;
    unsigned sum, cnt, mine, sp = 0u;
    for (;;) {
        sum = 0u; cnt = 0u; mine = 0u;
#pragma unroll
        for (unsigned j = 0; j < 16; ++j) { const unsigned c = xb_ld(&bar[XB_XCNT(j)]); sum += c; cnt += (c > 0u) ? 1u : 0u; mine = (j == x) ? c : mine; }
        if (sum == G) break;
        __builtin_amdgcn_s_sleep(1);
        if ((++sp & 255u) == 0u) { if (xb_ld(&bar[XB_TMO])) break; if (sp > XB_SPIN_CAP) { atomicAdd(&bar[XB_TMO], 1u); break; } }
    }
    nloc = mine > 0u ? mine : 1u; nx = cnt > 0u ? cnt : 1u;
}
DI void xcd_barrier(const XcdBarrier& b) {
    asm volatile("s_waitcnt vmcnt(0)" ::: "memory");
    __syncthreads();
    if (threadIdx.x == 0) {
        unsigned* bar = b.bar;
        __builtin_amdgcn_s_waitcnt(0);
        unsigned nloc = b.st[0], nx = b.st[1];
        if (nloc == 0u) { xcd_barrier_complete(bar, b.x, nloc, nx); b.st[0] = nloc; b.st[1] = nx; }
        const unsigned old = xb_add(&bar[XB_XSUB(b.x)], 1u);
        const unsigned gen = old / nloc;
        if (old + 1u == (gen + 1u) * nloc) {
            __builtin_amdgcn_fence(__ATOMIC_RELEASE, "agent");
            asm volatile("s_waitcnt vmcnt(0)" ::: "memory");
            const unsigned og = xb_add(&bar[XB_TOP], 1u);
            const unsigned tg = og / nx;
            if (og + 1u == (tg + 1u) * nx) xb_add(&bar[XB_TOPGEN], 1u);
            else XB_SPIN(xb_ld(&bar[XB_TOPGEN]) == tg, bar);
            __builtin_amdgcn_fence(__ATOMIC_ACQUIRE, "agent");
            xb_add(&bar[XB_XGEN(b.x)], 1u);
            asm volatile("s_waitcnt vmcnt(0)" ::: "memory");
        } else {
            XB_SPIN(xb_ld(&bar[XB_XGEN(b.x)]) == gen, bar);
            __builtin_amdgcn_fence(__ATOMIC_ACQUIRE, "agent");
            asm volatile("s_waitcnt vmcnt(0)" ::: "memory");
        }
    }
    __syncthreads();
}

typedef const __attribute__((address_space(4))) Params* ParamsPtr;
struct Ctx {
    ParamsPtr pp;
    LAS unsigned char* lds;
    int tid, lane, wave;
    DI const float* in(int i) const { return pp->in[i]; }
    DI float* out() const { return pp->out; }
    DI unsigned char* ws() const { return pp->ws; }
    DI unsigned* ctl() const { return (unsigned*)(ws() + WS_CTL); }
    DI float* mod() const { return (float*)(ws() + WS_MOD); }
    DI float* ropec() const { return (float*)(ws() + WS_ROPE); }
    DI float* ropes() const { return (float*)(ws() + WS_ROPE) + 1024; }
    DI int* ltok() const { return (int*)(ws() + WS_LTOK); }
    DI float* lw() const { return (float*)(ws() + WS_LW); }
    DI bf16* wr() const { return (bf16*)(ws() + WS_WR); }
    DI bf16* wqkv(int layer) const { return (bf16*)(ws() + WS_WQKV) + (size_t)layer * 3072 * D; }
    DI bf16* wmg() const { return (bf16*)(ws() + WS_WMG); }
    DI bf16* wmu() const { return (bf16*)(ws() + WS_WMU); }
    DI bf16* wmd() const { return (bf16*)(ws() + WS_WMD); }
    DI bf16* wo(int layer) const { return (bf16*)(ws() + WS_WO) + (size_t)layer * D * D; }
    DI float* gm() const { return (float*)(ws() + WS_GM); }
    DI float* rc() const { return (float*)(ws() + WS_RC); }
    DI float* rpbp() const { return (float*)(ws() + WS_RPB); }
    DI bf16* xres() const { return (bf16*)(ws() + WS_XRES); }
    DI bf16* H() const { return (bf16*)(ws() + WS_H); }
    DI bf16* Q() const { return (bf16*)(ws() + WS_Q); }
    DI bf16* K() const { return (bf16*)(ws() + WS_K); }
    DI bf16* VT() const { return (bf16*)(ws() + WS_VT); }
    DI bf16* O() const { return (bf16*)(ws() + WS_O); }
    DI bf16* ACT() const { return (bf16*)(ws() + WS_ACT); }
    DI bf16* YP() const { return (bf16*)(ws() + WS_YP); }
};

DI int mod_row(int t) { const int b = t / TPB; return (t - b * TPB) < CTX ? 8 : b; }

template <int MI, int NSTG, int BK, bool CHAIN, class Op>
DI void gemm_tile_x(const Op& op, const Op& nop, bool has_next, bool first, LAS unsigned char* lds, int tid) {
    constexpr int BM = 64 * MI, RB = BK * 2  , STG = (BM + 128) * RB, APC = BM * RB / 4096, BPC = 128 * RB / 4096, LPT = APC + BPC, KS = BK / 16, RPP = 4096 / RB  ;
    const int lane = tid & 63, wave = tid >> 6, wm = wave & 1, wn = wave >> 1;
    const int r = lane & 31, h = lane >> 5;
    const int K = op.K(), nk = K / BK;
    const int srow = (BK == 32) ? (tid >> 2) : (tid >> 3);
    const int sch = (BK == 32) ? ((tid & 3) ^ ((tid >> 4) & 3)) : ((tid & 7) ^ ((tid >> 4) & 7));
    const bf16* ap[APC]; const bf16* bpt[BPC];
#pragma unroll
    for (int i = 0; i < APC; ++i) ap[i] = op.arow(srow + RPP * i) + sch * 8;
#pragma unroll
    for (int i = 0; i < BPC; ++i) bpt[i] = op.brow_ptr(srow + RPP * i) + sch * 8;
    const unsigned xs = (BK == 32) ? ((r >> 2) & 3) : ((r >> 1) & 7);
    unsigned a_rd[MI], b_rd[2];
#pragma unroll
    for (int mi = 0; mi < MI; ++mi) a_rd[mi] = (32 * MI * wm + 32 * mi + r) * RB;
#pragma unroll
    for (int ni = 0; ni < 2; ++ni) b_rd[ni] = BM * RB + (op.brow(wn, ni) + r) * RB;

    f32x16 acc[2][MI];
#pragma unroll
    for (int ni = 0; ni < 2; ++ni)
#pragma unroll
        for (int mi = 0; mi < MI; ++mi)
#pragma unroll
            for (int i = 0; i < 16; ++i) acc[ni][mi][i] = 0.f;
    typename Op::template Pre<MI> pre;
    op.template prefetch<MI>(pre, wm, wn, r, h);

#define G_ISSUE(kt, stg) do { LAS unsigned char* s_ = lds + (stg) * STG + tid * 16; \
        _Pragma("unroll") for (int i = 0; i < APC; ++i) glds16(ap[i] + (kt) * BK, s_ + i * 4096); \
        _Pragma("unroll") for (int i = 0; i < BPC; ++i) glds16(bpt[i] + (kt) * BK, s_ + BM * RB + i * 4096); } while (0)

    if (!CHAIN || first) {
        __syncthreads();
#pragma unroll
        for (int s = 0; s < NSTG - 1; ++s) if (s < nk) G_ISSUE(s, s);
    }
    int stg = 0, istg = NSTG - 1;
    for (int kt = 0; kt < nk; ++kt) {
        if (kt + NSTG - 2 < nk) asm volatile("s_waitcnt vmcnt(%0)" :: "n"((NSTG - 2) * LPT) : "memory");
        else asm volatile("s_waitcnt vmcnt(0)" ::: "memory");
        __builtin_amdgcn_s_barrier();
        asm volatile("" ::: "memory");
        if (kt + NSTG - 1 < nk) G_ISSUE(kt + NSTG - 1, istg);
        __builtin_amdgcn_sched_barrier(0);
        LAS unsigned char* base = lds + stg * STG;
        __builtin_amdgcn_iglp_opt(1);
#pragma unroll
        for (int s = 0; s < KS; ++s) {
            const unsigned co = (unsigned)(((2 * s + h) ^ xs) << 4);
            bf16x8 af[MI], bfr[2];
#pragma unroll
            for (int mi = 0; mi < MI; ++mi) af[mi] = *(LAS bf16x8*)(base + a_rd[mi] + co);
#pragma unroll
            for (int ni = 0; ni < 2; ++ni) bfr[ni] = *(LAS bf16x8*)(base + b_rd[ni] + co);
#pragma unroll
            for (int ni = 0; ni < 2; ++ni)
#pragma unroll
                for (int mi = 0; mi < MI; ++mi) acc[ni][mi] = MFMA(bfr[ni], af[mi], acc[ni][mi]);
        }
        asm volatile("" ::: "memory");
        stg = (stg + 1 == NSTG) ? 0 : stg + 1; istg = (istg + 1 == NSTG) ? 0 : istg + 1;
    }
#undef G_ISSUE
    if (CHAIN) {
        __syncthreads();
        if (has_next) {
#pragma unroll
            for (int s = 0; s < NSTG - 1; ++s) if (s < nk) {
                LAS unsigned char* s_ = lds + s * STG + tid * 16;
#pragma unroll
                for (int i = 0; i < APC; ++i) glds16(nop.arow(srow + RPP * i) + sch * 8 + s * BK, s_ + i * 4096);
#pragma unroll
                for (int i = 0; i < BPC; ++i) glds16(nop.brow_ptr(srow + RPP * i) + sch * 8 + s * BK, s_ + BM * RB + i * 4096);
            }
        }
        __builtin_amdgcn_sched_barrier(0);
    }
    if (Op::kLdsEpi) {
        if (!CHAIN) __syncthreads();
        else asm volatile("s_waitcnt vmcnt(0)" ::: "memory");
        op.template epi_lds<MI>(acc, pre, wm, wn, r, h, lds + 32768 + wave * 8704);
    } else op.template epi<MI>(acc, pre, wm, wn, r, h);
}
template <int MI, int NSTG, int BK, class Op>
DI void gemm_tile(const Op& op, LAS unsigned char* lds, int tid) { gemm_tile_x<MI, NSTG, BK, false>(op, op, false, true, lds, tid); }

struct QkvOp {
    static constexpr bool kLdsEpi = false;
    template <int MI, class P> DI void epi_lds(f32x16 (&)[2][MI], const P&, int, int, int, int, LAS unsigned char*) const {}
    template <int MI> struct Pre {};
    template <int MI> DI void prefetch(Pre<MI>&, int, int, int, int) const {}
    const bf16* A; const bf16* Wt; int N, m0, n0, kind, kw, voff, vw;
    bf16* Q; bf16* Kb; bf16* VT; const float* rc; const float* rs;
    DI int K() const { return D; }
    DI const bf16* arow(int ml) const { return A + (size_t)(m0 + ml) * D; }
    DI const bf16* brow_ptr(int nl) const { return Wt + (size_t)(n0 + nl) * D; }
    DI int brow(int wn, int ni) const { return 64 * wn + 32 * ni; }
    template <int MI> DI void epi(f32x16 (&acc)[2][MI], const Pre<MI>& pre, int wm, int wn, int c, int h) const {
#pragma unroll
        for (int ni = 0; ni < 2; ++ni)
#pragma unroll
            for (int mi = 0; mi < MI; ++mi) {
                const int nb = n0 + 64 * wn + 32 * ni;
                const int t = m0 + 32 * MI * wm + 32 * mi + c;
                const int b = t / TPB, j = t - b * TPB;
                f32x16 v = acc[ni][mi];
                if (nb < voff) {
                    if (kind != 0 && j >= CTX) {
                        const int s = j - CTX;
                        const int pos = ((nb >> 5) & 1) ? (s & 63) : (s >> 6);
#pragma unroll
                        for (int g = 0; g < 2; ++g)
#pragma unroll
                            for (int e = 0; e < 4; ++e) {
                                const int i = 4 * g + e, d = e + 8 * g + 4 * h;
                                const float cs = rc[pos * 16 + d], sn = rs[pos * 16 + d];
                                const float x1 = v[i], x2 = v[i + 8];
                                v[i] = x1 * cs - x2 * sn; v[i + 8] = x2 * cs + x1 * sn;
                            }
                    }
                    bf16* dst = (nb < D) ? (Q + (size_t)t * D + nb) : (Kb + (size_t)t * kw + (nb - D));
#pragma unroll
                    for (int g = 0; g < 4; ++g) {
                        u32x2 w; w.x = pk2(v[4 * g], v[4 * g + 1]); w.y = pk2(v[4 * g + 2], v[4 * g + 3]);
                        *(u32x2*)(dst + 8 * g + 4 * h) = w;
                    }
                } else {
                    const unsigned off0 = (unsigned)((b * vw + (nb - voff) + 4 * h) * TPB + j);
#pragma unroll
                    for (int i = 0; i < 16; ++i)
                        VT[off0 + (unsigned)(((i & 3) + 8 * (i >> 2)) * TPB)] = (bf16)(pk2(v[i], 0.f) & 0xffffu);
                }
            }
    }
};

struct OutOp {
    static constexpr bool kLdsEpi = true;
    const bf16* A; const bf16* Wt; int m0, n0; const bf16* xres; bf16* xdst; const float* modl;
    template <int MI> struct Pre { u32x4 x[MI][4]; };
    DI int K() const { return D; }
    DI const bf16* arow(int ml) const { return A + (size_t)(m0 + ml) * D; }
    DI const bf16* brow_ptr(int nl) const { return Wt + (size_t)(n0 + nl) * D; }
    DI int brow(int wn, int ni) const { return 64 * wn + 32 * ni; }
    template <int MI> DI void prefetch(Pre<MI>& pre, int wm, int wn, int c, int h) const {
        const int lane = c + 32 * h, col = n0 + 64 * wn + 8 * (lane & 7);
#pragma unroll
        for (int mi = 0; mi < MI; ++mi)
#pragma unroll
            for (int p = 0; p < 4; ++p) { const int t = m0 + 32 * MI * wm + 32 * mi + ((lane + 64 * p) >> 3); pre.x[mi][p] = *(const u32x4*)(xres + (size_t)t * D + col); }
    }
    template <int MI> DI void epi(f32x16 (&)[2][MI], const Pre<MI>&, int, int, int, int) const {}
    template <int MI> DI void epi_lds(f32x16 (&acc)[2][MI], const Pre<MI>& pre, int wm, int wn, int c, int h, LAS unsigned char* wl) const {
        const int lane = c + 32 * h, col = n0 + 64 * wn + 8 * (lane & 7);
        const float* gp = modl + mod_row(m0) * 6144 + 2048 + col;
        const f32x4 g0 = *(const f32x4*)gp, g1 = *(const f32x4*)(gp + 4);
#pragma unroll
        for (int mi = 0; mi < MI; ++mi) {
#pragma unroll
            for (int ni = 0; ni < 2; ++ni)
#pragma unroll
                for (int g = 0; g < 4; ++g) {
                    f32x4 v = {acc[ni][mi][4 * g], acc[ni][mi][4 * g + 1], acc[ni][mi][4 * g + 2], acc[ni][mi][4 * g + 3]};
                    *(LAS f32x4*)(wl + c * 272 + (32 * ni + 8 * g + 4 * h) * 4) = v;
                }
            asm volatile("s_waitcnt lgkmcnt(0)" ::: "memory");
#pragma unroll
            for (int p = 0; p < 4; ++p) {
                const int q = lane + 64 * p, row = q >> 3;
                const f32x4 a0 = *(LAS f32x4*)(wl + row * 272 + (q & 7) * 32), a1 = *(LAS f32x4*)(wl + row * 272 + (q & 7) * 32 + 16);
                const u32x4 xv = pre.x[mi][p];
                u32x4 o;
                o.x = pk2(__builtin_bit_cast(float, xv.x << 16) + g0[0] * a0[0], __builtin_bit_cast(float, xv.x & 0xffff0000u) + g0[1] * a0[1]);
                o.y = pk2(__builtin_bit_cast(float, xv.y << 16) + g0[2] * a0[2], __builtin_bit_cast(float, xv.y & 0xffff0000u) + g0[3] * a0[3]);
                o.z = pk2(__builtin_bit_cast(float, xv.z << 16) + g1[0] * a1[0], __builtin_bit_cast(float, xv.z & 0xffff0000u) + g1[1] * a1[1]);
                o.w = pk2(__builtin_bit_cast(float, xv.w << 16) + g1[2] * a1[2], __builtin_bit_cast(float, xv.w & 0xffff0000u) + g1[3] * a1[3]);
                const int t = m0 + 32 * MI * wm + 32 * mi + row;
                *(u32x4*)(xdst + (size_t)t * D + col) = o;
            }
            asm volatile("s_waitcnt lgkmcnt(0)" ::: "memory");
        }
    }
};

struct GateUpOp {
    static constexpr bool kLdsEpi = false;
    template <int MI, class P> DI void epi_lds(f32x16 (&)[2][MI], const P&, int, int, int, int, LAS unsigned char*) const {}
    template <int MI> struct Pre {};
    template <int MI> DI void prefetch(Pre<MI>&, int, int, int, int) const {}
    const bf16* H; const bf16* WgT; const bf16* WuT; const int* ltok; int cnt, r0, f0; bf16* act;
    DI int K() const { return D; }
    DI const bf16* arow(int ml) const { int p = r0 + ml; p = p < cnt ? p : cnt - 1; return H + (size_t)(ltok[p] >> 1) * D; }
    DI const bf16* brow_ptr(int nl) const { return (nl < 64) ? (WgT + (size_t)(f0 + nl) * D) : (WuT + (size_t)(f0 + nl - 64) * D); }
    DI int brow(int wn, int ni) const { return 64 * ni + 32 * wn; }
    template <int MI> DI void epi(f32x16 (&acc)[2][MI], const Pre<MI>& pre, int wm, int wn, int c, int h) const {
#pragma unroll
        for (int mi = 0; mi < MI; ++mi) {
            const int p = r0 + 32 * MI * wm + 32 * mi + c;
            if (p < cnt) {
                bf16* dst = act + (size_t)p * DEXP + f0 + 32 * wn + 4 * h;
#pragma unroll
                for (int g = 0; g < 4; ++g) {
                    float o[4];
#pragma unroll
                    for (int e = 0; e < 4; ++e) { const float a = acc[0][mi][4 * g + e], u = acc[1][mi][4 * g + e]; o[e] = silu(a) * u; }
                    u32x2 w; w.x = pk2(o[0], o[1]); w.y = pk2(o[2], o[3]);
                    *(u32x2*)(dst + 8 * g) = w;
                }
            }
        }
    }
};

struct DownOp {
    static constexpr bool kLdsEpi = true;
    template <int MI> struct Pre { int tk[MI][4]; float w[MI]; };
    const bf16* act; const bf16* WdT; const int* ltok; const float* lw; int cnt, r0, n0; bf16* yp;
    DI int K() const { return DEXP; }
    DI const bf16* arow(int ml) const { int p = r0 + ml; p = p < cnt ? p : cnt - 1; return act + (size_t)p * DEXP; }
    DI const bf16* brow_ptr(int nl) const { return WdT + (size_t)(n0 + nl) * DEXP; }
    DI int brow(int wn, int ni) const { return 64 * wn + 32 * ni; }
    template <int MI> DI void prefetch(Pre<MI>& pre, int wm, int wn, int c, int h) const {
        const int lane = c + 32 * h;
#pragma unroll
        for (int mi = 0; mi < MI; ++mi) {
            const int pw = r0 + 32 * MI * wm + 32 * mi + c;
            pre.w[mi] = lw[pw < cnt ? pw : cnt - 1];
#pragma unroll
            for (int p = 0; p < 4; ++p) { const int pr = r0 + 32 * MI * wm + 32 * mi + ((lane + 64 * p) >> 3); pre.tk[mi][p] = ltok[pr < cnt ? pr : cnt - 1]; }
        }
    }
    template <int MI> DI void epi(f32x16 (&)[2][MI], const Pre<MI>&, int, int, int, int) const {}
    template <int MI> DI void epi_lds(f32x16 (&acc)[2][MI], const Pre<MI>& pre, int wm, int wn, int c, int h, LAS unsigned char* wl) const {
        const int lane = c + 32 * h;
#pragma unroll
        for (int mi = 0; mi < MI; ++mi) {
            const float w = pre.w[mi];
#pragma unroll
            for (int ni = 0; ni < 2; ++ni)
#pragma unroll
                for (int g = 0; g < 4; ++g) {
                    u32x2 o; o.x = pk2(w * acc[ni][mi][4 * g], w * acc[ni][mi][4 * g + 1]); o.y = pk2(w * acc[ni][mi][4 * g + 2], w * acc[ni][mi][4 * g + 3]);
                    *(LAS u32x2*)(wl + c * 144 + (32 * ni + 8 * g + 4 * h) * 2) = o;
                }
            asm volatile("s_waitcnt lgkmcnt(0)" ::: "memory");
#pragma unroll
            for (int p = 0; p < 4; ++p) {
                const int q = lane + 64 * p, row = q >> 3;
                const u32x4 v = *(LAS u32x4*)(wl + row * 144 + (q & 7) * 16);
                if (r0 + 32 * MI * wm + 32 * mi + row < cnt) *(u32x4*)(yp + (size_t)pre.tk[mi][p] * D + n0 + 64 * wn + 8 * (q & 7)) = v;
            }
            asm volatile("s_waitcnt lgkmcnt(0)" ::: "memory");
        }
    }
};

DI void transpose_tile(const float* W, int K, int N, bf16* Wt, int tile, LAS float* scr, int tid) {
    const int ntn = N / 64, k0 = (tile / ntn) * 64, n0 = (tile % ntn) * 64;
#pragma unroll 4
    for (int i = 0; i < 16; ++i) { const int kk = (tid >> 6) + 4 * i; scr[kk * 65 + (tid & 63)] = W[(size_t)(k0 + kk) * N + n0 + (tid & 63)]; }
    __syncthreads();
#pragma unroll
    for (int i = 0; i < 2; ++i) {
        const int q = tid + 256 * i, n = q >> 3, kc = q & 7;
        const LAS float* s = scr + (8 * kc) * 65 + n;
        u32x4 o; o.x = pk2(s[0], s[65]); o.y = pk2(s[2 * 65], s[3 * 65]); o.z = pk2(s[4 * 65], s[5 * 65]); o.w = pk2(s[6 * 65], s[7 * 65]);
        *(u32x4*)(Wt + (size_t)(n0 + n) * K + k0 + 8 * kc) = o;
    }
    __syncthreads();
}

DI f32x16 qk_tile(const bf16x8 (&qf)[4], const bf16* kp) {
    f32x16 s;
#pragma unroll
    for (int i = 0; i < 16; ++i) s[i] = 0.f;
    bf16x8 kf[4];
#pragma unroll
    for (int s4 = 0; s4 < 4; ++s4) kf[s4] = ldg8(kp + 16 * s4);
#pragma unroll
    for (int s4 = 0; s4 < 4; ++s4) s = MFMA(kf[s4], qf[s4], s);
    return s;
}
constexpr float RS_THR = 6.0f;
template <bool RAW>
DI bool softmax_tile(f32x16& s, float& m, float& l, float& alpha, bf16x8 (&pf)[2]) {
    float mx = s[0];
#pragma unroll
    for (int i = 1; i < 16; ++i) mx = fmaxf(mx, s[i]);
    mx = fmaxf(mx, __shfl_xor(mx, 32));
    if (RAW) mx *= SM_C;
    const bool resc = !__all(mx <= m + RS_THR);
    alpha = 1.f;
    if (resc) { const float mn = fmaxf(m, mx); alpha = fexp2(m - mn); m = mn; }
    float ps = 0.f;
#pragma unroll
    for (int i = 0; i < 16; ++i) { s[i] = RAW ? fexp2(__builtin_fmaf(s[i], SM_C, -m)) : fexp2(s[i] - m); ps += s[i]; }
    l = l * alpha + ps;
#pragma unroll
    for (int k2 = 0; k2 < 2; ++k2) {
        u32x4 w; w.x = pk2(s[8 * k2], s[8 * k2 + 1]); w.y = pk2(s[8 * k2 + 2], s[8 * k2 + 3]); w.z = pk2(s[8 * k2 + 4], s[8 * k2 + 5]); w.w = pk2(s[8 * k2 + 6], s[8 * k2 + 7]);
        pf[k2] = __builtin_bit_cast(bf16x8, w);
    }
    return resc;
}
template <int NDB>
DI void pv_tile(f32x16 (&O)[NDB], const bf16x8 (&pf)[2], const bf16* vp, float alpha) {
    bf16x8 vf[NDB][2];
#pragma unroll
    for (int db = 0; db < NDB; ++db)
#pragma unroll
        for (int k2 = 0; k2 < 2; ++k2) vf[db][k2] = ldg8(vp + (size_t)db * 32 * TPB + 16 * k2);
#pragma unroll
    for (int db = 0; db < NDB; ++db) {
#pragma unroll
        for (int i = 0; i < 16; ++i) O[db][i] *= alpha;
#pragma unroll
        for (int k2 = 0; k2 < 2; ++k2) O[db] = MFMA(vf[db][k2], pf[k2], O[db]);
    }
}
template <int NDB>
DI void store_o(const f32x16 (&O)[NDB], float inv, bf16* orow, int h) {
#pragma unroll
    for (int db = 0; db < NDB; ++db)
#pragma unroll
        for (int g = 0; g < 4; ++g) {
            u32x2 w; w.x = pk2(O[db][4 * g] * inv, O[db][4 * g + 1] * inv); w.y = pk2(O[db][4 * g + 2] * inv, O[db][4 * g + 3] * inv);
            *(u32x2*)(orow + 32 * db + 8 * g + 4 * h) = w;
        }
}

DI unsigned swz128(int row, int ch) { return (unsigned)(row * 128 + ((ch ^ ((row >> 1) & 7)) << 4)); }

template <bool RAW>
DI bool softmax_tile2(f32x16& sa, f32x16& sb, float& m, float& l, float& alpha, bf16x8 (&pf)[4]) {
    float mx = fmaxf(sa[0], sb[0]);
#pragma unroll
    for (int i = 1; i < 16; ++i) mx = fmaxf(mx, fmaxf(sa[i], sb[i]));
    mx = fmaxf(mx, __shfl_xor(mx, 32));
    if (RAW) mx *= SM_C;
    const bool resc = !__all(mx <= m + RS_THR);
    alpha = 1.f;
    if (resc) { const float mn = fmaxf(m, mx); alpha = fexp2(m - mn); m = mn; }
    float ps = 0.f;
#pragma unroll
    for (int i = 0; i < 16; ++i) {
        sa[i] = RAW ? fexp2(__builtin_fmaf(sa[i], SM_C, -m)) : fexp2(sa[i] - m);
        sb[i] = RAW ? fexp2(__builtin_fmaf(sb[i], SM_C, -m)) : fexp2(sb[i] - m);
        ps += sa[i] + sb[i];
    }
    l = l * alpha + ps;
#pragma unroll
    for (int k2 = 0; k2 < 2; ++k2) {
        u32x4 w; w.x = pk2(sa[8 * k2], sa[8 * k2 + 1]); w.y = pk2(sa[8 * k2 + 2], sa[8 * k2 + 3]); w.z = pk2(sa[8 * k2 + 4], sa[8 * k2 + 5]); w.w = pk2(sa[8 * k2 + 6], sa[8 * k2 + 7]);
        pf[k2] = __builtin_bit_cast(bf16x8, w);
        u32x4 v; v.x = pk2(sb[8 * k2], sb[8 * k2 + 1]); v.y = pk2(sb[8 * k2 + 2], sb[8 * k2 + 3]); v.z = pk2(sb[8 * k2 + 4], sb[8 * k2 + 5]); v.w = pk2(sb[8 * k2 + 6], sb[8 * k2 + 7]);
        pf[2 + k2] = __builtin_bit_cast(bf16x8, v);
    }
    return resc;
}

DI void attn_block_nasw(const Ctx& cx, int kind, int layer, bool need_ctx, int vbid) {
    const int tid = cx.tid, lane = cx.lane, w = cx.wave, c = lane & 31, h = lane >> 5;
    const int kw = (kind == 0) ? D : 256, vw = kw;
    const int n_lat = 2048, n_tasks = n_lat + (need_ctx ? 256 : 0);
    const float* rpb = cx.rpbp() + (size_t)(layer / 3) * 16 * 512;
    const float* sinks = cx.in(17);
    const int srow = tid >> 3, sch = (tid & 7) ^ ((srow >> 1) & 7);
    const int pr = pi32(c);
    const unsigned xk = (pr >> 1) & 7, xv = (c >> 1) & 7;
    LAS float* rpbs = (LAS float*)(cx.lds + 49152);
    LAS unsigned char* qreg = cx.lds + 51200 + w * 4096 + lane * 16;
    for (int base_ = 0; base_ < n_tasks; base_ += gridDim.x) {
        const int task = base_ + ((base_ + (int)gridDim.x <= n_tasks) ? vbid : (int)blockIdx.x);
        if (task >= n_tasks) break;
        int b, kmap, head, tq0, nt, rlo = 0, r0w = 0, rg = 0, qh = 0, p0 = 0, kb_lo = 0;
        const bool lat = task < n_lat;
        if (kind == 0) {
            if (lat) {
                const int rp = task & 15; head = (task >> 4) & 15; b = task >> 8; rg = 2 * rp + (c >> 4); qh = 0;
                tq0 = b * TPB + CTX + rg * 64 + 16 * w + (c & 15) - c;
                int a0 = 2 * rp - 4; a0 = a0 < 0 ? 0 : (a0 > 24 ? 24 : a0);
                int a1 = 2 * rp - 3; a1 = a1 < 0 ? 0 : (a1 > 24 ? 24 : a1);
                rlo = a0; nt = 4 + (a1 + 8 - a0); r0w = (c >> 4) ? a1 : a0;
            } else { const int u = task - n_lat; const int qb = u & 1; head = (u >> 1) & 15; b = u >> 5; tq0 = b * TPB + qb * 128 + w * 32; nt = 4; }
            kmap = head;
        } else {
            if (lat) {
                const int qb = task & 63; kmap = (task >> 6) & 3; b = task >> 8; p0 = qb * 32; tq0 = b * TPB + CTX + p0;
                int lo = p0 - 128; lo = lo < 0 ? 0 : lo; kb_lo = lo & ~63;
                int hi = p0 + 160; hi = hi > SEQ ? SEQ : hi; hi = (hi + 63) & ~63; nt = 4 + (hi - kb_lo) / 64;
            } else { const int u = task - n_lat; const int qb = u & 7; kmap = (u >> 3) & 3; b = u >> 5; tq0 = b * TPB + qb * 32; nt = 4; }
            head = kmap * 4 + w;
        }
#define KEY0(it) ((it) < 4 ? 64 * (it) : (kind == 0 ? CTX + (rlo + (it) - 4) * 64 : CTX + kb_lo + ((it) - 4) * 64))
        const bf16* kg = cx.K() + (size_t)(b * TPB + srow) * kw + kmap * 64 + sch * 8;
        const bf16* vg = cx.VT() + ((size_t)b * vw + kmap * 64 + srow) * TPB + sch * 8;
#define A_LOAD(it, buf) do { const int k0_ = KEY0(it); LAS unsigned char* b_ = cx.lds + (buf) * 16384 + tid * 16; \
                        glds16(kg + (size_t)k0_ * kw, b_); glds16(kg + (size_t)(k0_ + 32) * kw, b_ + 4096); \
                        glds16(vg + k0_, b_ + 8192); glds16(vg + (size_t)32 * TPB + k0_, b_ + 8192 + 4096); } while (0)
        __syncthreads();
        float m = NEG, l = 0.f;
        if (kind == 2) { m = sinks[head] * LOG2E; l = (h == 0) ? 1.f : 0.f; asm volatile("" : "+v"(m)); }
        { const bf16* qp = cx.Q() + (size_t)(tq0 + c) * D + head * 64 + 8 * h;
#pragma unroll
          for (int s4 = 0; s4 < 4; ++s4) glds16(qp + 16 * s4, qreg + s4 * 1024); }
        if (kind == 0 && lat && tid < 128) glds16(rpb + head * 512 + tid * 4, (LAS unsigned char*)rpbs + tid * 16);
#pragma unroll
        for (int s = 0; s < 2; ++s) if (s < nt) A_LOAD(s, s);
        f32x16 O[2];
#pragma unroll
        for (int db = 0; db < 2; ++db)
#pragma unroll
            for (int i = 0; i < 16; ++i) O[db][i] = 0.f;
        const int qc = 16 * w + (c & 15); int c0 = qc - 8; c0 = c0 < 0 ? 0 : (c0 > 48 ? 48 : c0);
        int kbase = 16 * w - 8; kbase = kbase < 0 ? 0 : (kbase > 32 ? 32 : kbase);
        const unsigned xkn = ((kbase + pr) >> 1) & 7;
        const int qpos = p0 + c;
        bf16x8 qf[4];
        int stg = 0, istg = 2;
#pragma unroll 1
        for (int it = 0; it < nt; ++it) {
            if (it + 1 < nt) asm volatile("s_waitcnt vmcnt(4)" ::: "memory");
            else asm volatile("s_waitcnt vmcnt(0)" ::: "memory");
            __builtin_amdgcn_s_barrier();
            asm volatile("" ::: "memory");
            if (it + 2 < nt) A_LOAD(it + 2, istg);
            __builtin_amdgcn_sched_barrier(0);
            if (it == 0) {
#pragma unroll
                for (int s4 = 0; s4 < 4; ++s4) qf[s4] = *(LAS bf16x8*)(qreg + s4 * 1024);
            }
            LAS unsigned char* kb = cx.lds + stg * 16384; LAS unsigned char* vb = kb + 8192;
            if (kind == 0 && it >= 4) {
                const int ry = rlo + it - 4;
                f32x16 sa;
#pragma unroll
                for (int i = 0; i < 16; ++i) sa[i] = 0.f;
#pragma unroll
                for (int s4 = 0; s4 < 4; ++s4) {
                    const bf16x8 ka = *(LAS bf16x8*)(kb + (kbase + pr) * 128 + (((2 * s4 + h) ^ xkn) << 4));
                    sa = MFMA(ka, qf[s4], sa);
                }
                const bool rowok = (ry >= r0w) && (ry <= r0w + 7);
                int dyi = ry - rg + 7; dyi = dyi < 0 ? 0 : (dyi > 14 ? 14 : dyi);
                const LAS float* rrow = rpbs + dyi * 31;
                int dwin = rowok ? (kbase + 8 * h - c0) : 0x40000000;
                int dci = kbase + 8 * h - qc + 15;
                asm volatile("" : "+v"(dwin), "+v"(dci));
#pragma unroll
                for (int i = 0; i < 16; ++i) {
                    const int off = (i & 7) + 16 * (i >> 3);
                    int ci = dci + off; ci = ci < 0 ? 0 : (ci > 30 ? 30 : ci);
                    const bool ok = (unsigned)(dwin + off) < 16u;
                    sa[i] = ok ? __builtin_fmaf(sa[i], SM_C, rrow[ci]) : NEG;
                }
                float alpha; bf16x8 pf[2];
                const bool resc = softmax_tile<false>(sa, m, l, alpha, pf);
                if (resc) {
#pragma unroll
                    for (int db = 0; db < 2; ++db)
#pragma unroll
                        for (int i = 0; i < 16; ++i) O[db][i] *= alpha;
                }
                const int kb8 = kbase >> 3;
#pragma unroll
                for (int db = 0; db < 2; ++db)
#pragma unroll
                    for (int k2 = 0; k2 < 2; ++k2) {
                        const bf16x8 vf = *(LAS bf16x8*)(vb + (32 * db + c) * 128 + (((kb8 + 2 * k2 + h) ^ xv) << 4));
                        O[db] = MFMA(vf, pf[k2], O[db]);
                    }
            } else {
                f32x16 sa, sb;
#pragma unroll
                for (int i = 0; i < 16; ++i) { sa[i] = 0.f; sb[i] = 0.f; }
#pragma unroll
                for (int s4 = 0; s4 < 4; ++s4) {
                    const unsigned co = (unsigned)(((2 * s4 + h) ^ xk) << 4);
                    const bf16x8 ka = *(LAS bf16x8*)(kb + pr * 128 + co), kb2 = *(LAS bf16x8*)(kb + (32 + pr) * 128 + co);
                    sa = MFMA(ka, qf[s4], sa); sb = MFMA(kb2, qf[s4], sb);
                }
                bool resc; float alpha; bf16x8 pf[4];
                if (it < 4) {
                    resc = softmax_tile2<true>(sa, sb, m, l, alpha, pf);
                } else {
                    const int kb0 = kb_lo + (it - 4) * 64;
                    if (kb0 < p0 - 97 || kb0 > p0 + 65) {
                        int dq = kb0 + 8 * h - qpos + 128; asm volatile("" : "+v"(dq));
#pragma unroll
                        for (int i = 0; i < 16; ++i) {
                            const int off = (i & 7) + 16 * (i >> 3);
                            sa[i] = ((unsigned)(dq + off) <= 256u) ? sa[i] : NEG;
                            sb[i] = ((unsigned)(dq + off + 32) <= 256u) ? sb[i] : NEG;
                        }
                    }
                    resc = softmax_tile2<true>(sa, sb, m, l, alpha, pf);
                }
                if (resc) {
#pragma unroll
                    for (int db = 0; db < 2; ++db)
#pragma unroll
                        for (int i = 0; i < 16; ++i) O[db][i] *= alpha;
                }
#pragma unroll
                for (int db = 0; db < 2; ++db) {
#pragma unroll
                    for (int k4 = 0; k4 < 4; ++k4) {
                        const bf16x8 vf = *(LAS bf16x8*)(vb + (32 * db + c) * 128 + (((2 * k4 + h) ^ xv) << 4));
                        O[db] = MFMA(vf, pf[k4], O[db]);
                    }
                }
            }
            asm volatile("" ::: "memory");
            stg = (stg == 2) ? 0 : stg + 1; istg = (istg == 2) ? 0 : istg + 1;
        }
#undef KEY0
#undef A_LOAD
        l += __shfl_xor(l, 32);
        store_o<2>(O, 1.f / l, cx.O() + (size_t)(tq0 + c) * D + head * 64, h);
    }
}

DI void attn_block_da(const Ctx& cx, int layer, bool need_ctx, int vbid) {
    const int tid = cx.tid, lane = cx.lane, w = cx.wave, c = lane & 31, h = lane >> 5;
    const int n_lat = NB * 8 * 16, n_tasks = n_lat + (need_ctx ? NB * 8 * 2 : 0);
    const float* lp = cx.in(13);
    const float d1 = wave_sum(lp[lane] * lp[64 + lane]), d2 = wave_sum(lp[128 + lane] * lp[192 + lane]);
    const float lam_init = 0.8f - 0.6f * __expf(-0.3f * (float)layer);
    const float lam = __expf(d1) - __expf(d2) + lam_init;
    const float* sg = cx.in(14);
    const int krow = tid >> 3, kch = (tid & 7) ^ ((krow >> 1) & 7), vdim = tid >> 2, vch = (tid & 3) ^ ((vdim >> 2) & 3);
    const int pr = pi32(c);
    const unsigned xk = (pr >> 1) & 7, xv = (c >> 2) & 3;
    LAS unsigned char* qlds = cx.lds + 49152 + w * 4096 + lane * 16;
    for (int base_ = 0; base_ < n_tasks; base_ += gridDim.x) {
        const int task = base_ + ((base_ + (int)gridDim.x <= n_tasks) ? vbid : (int)blockIdx.x);
        if (task >= n_tasks) break;
        int b, head, tq0, nt;
        if (task < n_lat) { const int qb = task & 15; head = (task >> 4) & 7; b = task >> 7; tq0 = b * TPB + CTX + qb * 128 + w * 32; nt = TPB / 32; }
        else { const int u = task - n_lat; const int qb = u & 1; head = (u >> 1) & 7; b = u >> 4; tq0 = b * TPB + qb * 128 + w * 32; nt = CTX / 32; }
        const bf16* kg = cx.K() + (size_t)(b * TPB + krow) * D + head * 128 + kch * 8;
        const bf16* vg = cx.VT() + ((size_t)b * D + head * 128 + vdim) * TPB + vch * 8;
#define D_LOAD(it, buf) do { const int k0_ = 32 * (it); LAS unsigned char* b_ = cx.lds + (buf) * 16384 + tid * 16; \
                        glds16(kg + (size_t)k0_ * D, b_); glds16(kg + (size_t)k0_ * D + 64, b_ + 4096); \
                        glds16(vg + k0_, b_ + 8192); glds16(vg + (size_t)64 * TPB + k0_, b_ + 8192 + 4096); } while (0)
        __syncthreads();
        bf16x8 q1f[4];
        { const bf16* qp = cx.Q() + (size_t)(tq0 + c) * D + head * 128 + 8 * h;
#pragma unroll
          for (int s4 = 0; s4 < 4; ++s4) q1f[s4] = ldg8(qp + 64 + 16 * s4);
#pragma unroll
          for (int s4 = 0; s4 < 4; ++s4) asm volatile("" : "+v"(q1f[s4]));
#pragma unroll
          for (int s4 = 0; s4 < 4; ++s4) glds16(qp + 16 * s4, qlds + s4 * 1024); }
#pragma unroll
        for (int s = 0; s < 2; ++s) if (s < nt) D_LOAD(s, s);
        float m0 = NEG, l0 = 0.f, m1 = NEG, l1 = 0.f;
        f32x16 O0[4], O1[4];
#pragma unroll
        for (int db = 0; db < 4; ++db)
#pragma unroll
            for (int i = 0; i < 16; ++i) { O0[db][i] = 0.f; O1[db][i] = 0.f; }
        int stg = 0, istg = 2;
#pragma unroll 1
        for (int it = 0; it < nt; ++it) {
            if (it + 1 < nt) asm volatile("s_waitcnt vmcnt(4)" ::: "memory");
            else asm volatile("s_waitcnt vmcnt(0)" ::: "memory");
            __builtin_amdgcn_s_barrier();
            asm volatile("" ::: "memory");
            if (it + 2 < nt) D_LOAD(it + 2, istg);
            __builtin_amdgcn_sched_barrier(0);
            __builtin_amdgcn_iglp_opt(IGLP_ATT);
            LAS unsigned char* kb = cx.lds + stg * 16384; LAS unsigned char* vb = kb + 8192;
            f32x16 s0, s1;
#pragma unroll
            for (int i = 0; i < 16; ++i) { s0[i] = 0.f; s1[i] = 0.f; }
#pragma unroll
            for (int s4 = 0; s4 < 4; ++s4) {
                const unsigned co = (unsigned)(((2 * s4 + h) ^ xk) << 4);
                const bf16x8 k0f = *(LAS bf16x8*)(kb + pr * 128 + co), q0f = *(LAS bf16x8*)(qlds + s4 * 1024);
                s0 = MFMA(k0f, q0f, s0);
            }
#pragma unroll
            for (int s4 = 0; s4 < 4; ++s4) {
                const unsigned co = (unsigned)(((2 * s4 + h) ^ xk) << 4);
                const bf16x8 k1f = *(LAS bf16x8*)(kb + 4096 + pr * 128 + co);
                s1 = MFMA(k1f, q1f[s4], s1);
            }
            __builtin_amdgcn_sched_barrier(0);
            float a0; bf16x8 pf0[2];
            const bool r0 = softmax_tile<true>(s0, m0, l0, a0, pf0);
            float a1; bf16x8 pf1[2];
            const bool r1 = softmax_tile<true>(s1, m1, l1, a1, pf1);
            if (r0 || r1) {
#pragma unroll
                for (int db = 0; db < 4; ++db)
#pragma unroll
                    for (int i = 0; i < 16; ++i) { O0[db][i] *= a0; O1[db][i] *= a1; }
            }
            __builtin_amdgcn_s_setprio(1);
#pragma unroll
            for (int db = 0; db < 4; ++db) {
                bf16x8 vf[2];
#pragma unroll
                for (int k2 = 0; k2 < 2; ++k2) vf[k2] = *(LAS bf16x8*)(vb + (32 * db + c) * 64 + (((2 * k2 + h) ^ xv) << 4));
#pragma unroll
                for (int k2 = 0; k2 < 2; ++k2) { O0[db] = MFMA(vf[k2], pf0[k2], O0[db]); O1[db] = MFMA(vf[k2], pf1[k2], O1[db]); }
            }
            __builtin_amdgcn_s_setprio(0);
            asm volatile("" ::: "memory");
            stg = (stg == 2) ? 0 : stg + 1; istg = (istg == 2) ? 0 : istg + 1;
        }
#undef D_LOAD
        l0 += __shfl_xor(l0, 32); l1 += __shfl_xor(l1, 32);
        const int lane_e = __builtin_amdgcn_mbcnt_hi(~0u, __builtin_amdgcn_mbcnt_lo(~0u, 0u));
        const int c_e = lane_e & 31, h_e = lane_e >> 5;
        const float i0 = 1.f / l0, i1 = lam / l1;
        float ss = 0.f;
#pragma unroll
        for (int db = 0; db < 4; ++db)
#pragma unroll
            for (int i = 0; i < 16; ++i) { const float o = O0[db][i] * i0 - O1[db][i] * i1; O0[db][i] = o; ss += o * o; }
        ss += __shfl_xor(ss, 32);
        const float rn = rsqrtf(ss * (1.f / 128.f) + EPS) * (1.f - lam_init);
        bf16* orow = cx.O() + (size_t)(tq0 + c_e) * D + head * 128;
#pragma unroll
        for (int db = 0; db < 4; ++db)
#pragma unroll
            for (int g = 0; g < 4; ++g) {
                const int dim = 32 * db + 8 * g + 4 * h_e;
                const f32x4 gg = *(const f32x4*)(sg + dim);
                u32x2 wv; wv.x = pk2(O0[db][4 * g] * rn * gg[0], O0[db][4 * g + 1] * rn * gg[1]); wv.y = pk2(O0[db][4 * g + 2] * rn * gg[2], O0[db][4 * g + 3] * rn * gg[3]);
                *(u32x2*)(orow + dim) = wv;
            }
    }
}

DI void load_row(const float* row, f32x4 (&v)[4], int lane) {
#pragma unroll
    for (int j = 0; j < 4; ++j) v[j] = ((const f32x4*)row)[lane + 64 * j];
}
DI void load_row_bf16(const bf16* row, f32x4 (&v)[4], int lane) {
#pragma unroll
    for (int j = 0; j < 4; ++j) { const u32x2 a = ((const u32x2*)row)[lane + 64 * j];
        v[j][0] = __builtin_bit_cast(float, a.x << 16); v[j][1] = __builtin_bit_cast(float, a.x & 0xffff0000u);
        v[j][2] = __builtin_bit_cast(float, a.y << 16); v[j][3] = __builtin_bit_cast(float, a.y & 0xffff0000u); }
}
DI void norm_mod(f32x4 (&v)[4], const float* g, const float* sh, const float* sc, int lane) {
    float ss = 0.f;
#pragma unroll
    for (int j = 0; j < 4; ++j) ss += (v[j][0] * v[j][0] + v[j][1] * v[j][1]) + (v[j][2] * v[j][2] + v[j][3] * v[j][3]);
    const float rn = rsqrtf(wave_sum(ss) * (1.f / D) + EPS);
#pragma unroll
    for (int j = 0; j < 4; ++j) {
        const f32x4 gg = ((const f32x4*)g)[lane + 64 * j], s1 = ((const f32x4*)sc)[lane + 64 * j], s0 = ((const f32x4*)sh)[lane + 64 * j];
#pragma unroll
        for (int e = 0; e < 4; ++e) v[j][e] = (v[j][e] * rn * gg[e]) * (1.f + s1[e]) + s0[e];
    }
}
DI void store_row_bf16(bf16* row, const f32x4 (&v)[4], int lane) {
#pragma unroll
    for (int j = 0; j < 4; ++j) { u32x2 w; w.x = pk2(v[j][0], v[j][1]); w.y = pk2(v[j][2], v[j][3]); ((u32x2*)row)[lane + 64 * j] = w; }
}

struct ConvTask { const float* src; bf16* dst; int N, K; };
DI ConvTask prologue_task(const Ctx& cx, int item, int lane) {
    const int layer = item < 2048 ? 0 : (item < 4096 ? 1 : (item < 5376 ? 2 : 3));
    const int u = item - (layer == 0 ? 0 : (layer == 1 ? 2048 : (layer == 2 ? 4096 : 5376)));
    const int kind = layer % 3, NQ = (kind == 2) ? 1536 : 3072, nq = 16 * (NQ / 32);
    const float* W; bf16* WT; int N, kt, nt;
    if (u < nq) { W = (kind == 0) ? cx.in(9) + (size_t)(layer / 3) * D * 3072 : (kind == 1 ? cx.in(12) : cx.in(16)); WT = cx.wqkv(layer); N = NQ; kt = u / (NQ / 32); nt = u - kt * (NQ / 32); }
    else { const int v = u - nq; W = (kind == 0) ? cx.in(11) + (size_t)(layer / 3) * D * D : (kind == 1 ? cx.in(15) : cx.in(18)); WT = cx.wo(layer); N = D; kt = v >> 5; nt = v & 31; }
    ConvTask t;
    t.src = W + (size_t)(kt * 64 + (lane >> 3)) * N + nt * 32 + (lane & 7) * 4;
    t.dst = WT + (size_t)(nt * 32 + (lane >> 3)) * D + kt * 64 + (lane & 7) * 8;
    t.N = N; t.K = D;
    return t;
}
constexpr int PRO_NT = 7424;
DI void prologue_convert(const Ctx& cx, int first, int stride) {
    const int lane = cx.lane;
    LAS float* scr = (LAS float*)(cx.lds + 36864) + cx.wave * (64 * 33);
#define PV_LOAD(X, task) do { const ConvTask ct_ = prologue_task(cx, (task), lane); \
        _Pragma("unroll") for (int p = 0; p < 8; ++p) X[p] = *(const f32x4*)(ct_.src + (size_t)(8 * p) * ct_.N); } while (0)
#define PV_PROC(X, task) do { const ConvTask ct_ = prologue_task(cx, (task), lane); \
        _Pragma("unroll") for (int p = 0; p < 8; ++p) { LAS float* d = scr + ((lane >> 3) + 8 * p) * 33 + (lane & 7) * 4; d[0] = X[p][0]; d[1] = X[p][1]; d[2] = X[p][2]; d[3] = X[p][3]; } \
        asm volatile("s_waitcnt lgkmcnt(0)" ::: "memory"); \
        _Pragma("unroll") for (int p = 0; p < 4; ++p) { const LAS float* s = scr + ((lane & 7) * 8) * 33 + (lane >> 3) + 8 * p; \
            u32x4 o; o.x = pk2(s[0], s[33]); o.y = pk2(s[2 * 33], s[3 * 33]); o.z = pk2(s[4 * 33], s[5 * 33]); o.w = pk2(s[6 * 33], s[7 * 33]); \
            *(u32x4*)(ct_.dst + (size_t)(8 * p) * ct_.K) = o; } \
        asm volatile("s_waitcnt lgkmcnt(0)" ::: "memory"); } while (0)
    f32x4 xa[8], xb[8];
    int task = first;
    if (task < PRO_NT) PV_LOAD(xa, task);
#pragma unroll 1
    while (task < PRO_NT) {
        const int t2 = task + stride, t3 = t2 + stride;
        if (t2 < PRO_NT) PV_LOAD(xb, t2);
        PV_PROC(xa, task);
        if (t3 < PRO_NT) PV_LOAD(xa, t3);
        if (t2 < PRO_NT) PV_PROC(xb, t2);
        task = t3;
    }
#undef PV_LOAD
#undef PV_PROC
}

DI void phase_prologue(const Ctx& cx) {
    LAS float* condS = (LAS float*)cx.lds;
    const float* cin = cx.in(1); const float* cctx = cx.in(3);
    for (int i = cx.tid; i < 9 * 1024; i += NTHREADS) { const int rr = i >> 10, k = i & 1023; const float v = (rr < 8) ? cin[rr * 1024 + k] : cctx[k]; condS[i] = silu(v); }
    __syncthreads();
    const float* ada_w = cx.in(4); const float* ada_b = cx.in(5);
    LAS float* red16 = (LAS float*)(cx.lds + 9 * 1024 * 4);
    for (int task = blockIdx.x; task < 4 * 96; task += gridDim.x) {
        const int layer = task / 96, cc = task % 96, r = cx.lane >> 4, cq = cx.lane & 15;
        const float* W = ada_w + (size_t)layer * D * 6144 + cc * 64 + 4 * cq;
        float acc[9][4];
#pragma unroll
        for (int rr = 0; rr < 9; ++rr)
#pragma unroll
            for (int e = 0; e < 4; ++e) acc[rr][e] = 0.f;
        const int k0 = cx.wave * 256 + r;
#pragma unroll 1
        for (int kb = 0; kb < 256; kb += 64) {
            f32x4 wv[16];
#pragma unroll
            for (int i = 0; i < 16; ++i) wv[i] = *(const f32x4*)(W + (size_t)(k0 + kb + 4 * i) * 6144);
#pragma unroll
            for (int i = 0; i < 16; ++i) {
#pragma unroll
                for (int rr = 0; rr < 9; ++rr) { const float cv = condS[rr * 1024 + k0 + kb + 4 * i];
#pragma unroll
                    for (int e = 0; e < 4; ++e) acc[rr][e] += cv * wv[i][e]; }
            }
        }
#pragma unroll
        for (int rr = 0; rr < 9; ++rr) *(LAS f32x4*)(red16 + ((cx.wave * 4 + r) * 9 + rr) * 64 + 4 * cq) = f32x4{acc[rr][0], acc[rr][1], acc[rr][2], acc[rr][3]};
        __syncthreads();
        for (int i = cx.tid; i < 9 * 64; i += NTHREADS) {
            const int rr = i >> 6, ln = i & 63;
            float s = 0.f;
#pragma unroll
            for (int g = 0; g < 16; ++g) s += red16[(g * 9 + rr) * 64 + ln];
            cx.mod()[((size_t)layer * 9 + rr) * 6144 + cc * 64 + ln] = s + ada_b[layer * 6144 + cc * 64 + ln];
        }
        __syncthreads();
    }
    {
        const int ng = (4 * 96 < (int)gridDim.x) ? 4 * 96 : (int)gridDim.x;
        const int nslots = ng * 4 + ((int)gridDim.x - ng) * 4 * 3;
        const int gw = blockIdx.x * 4 + cx.wave;
        if ((int)blockIdx.x < ng) prologue_convert(cx, gw, nslots);
        else { const int s0 = ng * 4 + (gw - ng * 4) * 3; prologue_convert(cx, s0, nslots); prologue_convert(cx, s0 + 1, nslots); prologue_convert(cx, s0 + 2, nslots); }
    }
    {
        bf16* wr = cx.wr();
        for (int i = blockIdx.x * NTHREADS + cx.tid; i < DEPTH * D * 64; i += gridDim.x * NTHREADS) {
            const int rho = i & 63, k = (i >> 6) & 1023, layer = i >> 16;
            float v = 0.f;
            if (rho < 32) v = cx.in(21)[((size_t)layer * D + k) * 32 + rho];
            else if (rho < 36) v = cx.in(19)[((size_t)layer * D + k) * 4 + (rho - 32)];
            const unsigned hi = pk2(v, 0.f) & 0xffffu;
            const unsigned lo = pk2(v - bf2f((unsigned short)hi), 0.f) & 0xffffu;
            wr[((size_t)(layer * 2 + 0) * 64 + rho) * D + k] = (bf16)hi;
            wr[((size_t)(layer * 2 + 1) * 64 + rho) * D + k] = (bf16)lo;
        }
    }
    if (blockIdx.x == gridDim.x - 2) {
        for (int i = cx.tid; i < 2 * 16 * 512; i += NTHREADS) { const int s = i >> 9, e = i & 511; cx.rpbp()[i] = (e < 465) ? cx.in(10)[s * 465 + e] * LOG2E : 0.f; }
    }
    if (blockIdx.x == gridDim.x - 1) {
        for (int i = cx.tid; i < 64 * 16; i += NTHREADS) {
            const int pos = i >> 4, f = i & 15;
            const float tab4[4] = {1.f, 0.5623413251903491f, 0.31622776601683794f, 0.1778279410038923f};
            float inv = (f & 3) == 0 ? tab4[0] : ((f & 3) == 1 ? tab4[1] : ((f & 3) == 2 ? tab4[2] : tab4[3]));
            const int dec = f >> 2; inv *= (dec == 0 ? 1.f : (dec == 1 ? 0.1f : (dec == 2 ? 0.01f : 0.001f)));
            const float ang = (float)pos * inv;
            const double rev = (double)ang * 0.15915494309189535; const float fr = (float)(rev - (double)(long long)rev);
            cx.ropec()[i] = __builtin_amdgcn_cosf(fr); cx.ropes()[i] = __builtin_amdgcn_sinf(fr);
        }
    }
}

DI void phase_first_norm(const Ctx& cx) {
    const int gw = blockIdx.x * 4 + cx.wave, gstride = gridDim.x * 4;
    {
        for (int pair = (int)gridDim.x - 1 - (int)blockIdx.x; pair < DEPTH * 9; pair += (int)gridDim.x) {
            const int layer = pair / 9, row = pair % 9;
            const float* md = cx.mod() + ((size_t)layer * 9 + row) * 6144;
            const float* g = cx.in(7) + layer * D;
            float* gmo = cx.gm() + (size_t)pair * D;
            const float* wexp = cx.in(21) + (size_t)layer * D * 32; const float* wgrp = cx.in(19) + (size_t)layer * D * 4;
            float acc[36];
#pragma unroll
            for (int e = 0; e < 36; ++e) acc[e] = 0.f;
#pragma unroll
            for (int i = 0; i < 4; ++i) {
                const int k = cx.lane + 64 * (4 * cx.wave + i);
                gmo[k] = g[k] * (1.f + md[4096 + k]);
                const float sh = md[3072 + k];
                const f32x4* we = (const f32x4*)(wexp + (size_t)k * 32);
#pragma unroll
                for (int q = 0; q < 8; ++q) { const f32x4 w = we[q];
#pragma unroll
                    for (int e = 0; e < 4; ++e) acc[4 * q + e] += sh * w[e]; }
                const f32x4 wg = *(const f32x4*)(wgrp + (size_t)k * 4);
#pragma unroll
                for (int e = 0; e < 4; ++e) acc[32 + e] += sh * wg[e];
            }
#pragma unroll
            for (int e = 0; e < 36; ++e) acc[e] = wave_sum(acc[e]);
            LAS float* part = (LAS float*)cx.lds;
            if (cx.lane == 0) {
#pragma unroll
                for (int e = 0; e < 36; ++e) part[cx.wave * 36 + e] = acc[e];
            }
            __syncthreads();
            if (cx.tid < 36) {
                const float s = (part[cx.tid] + part[36 + cx.tid]) + (part[72 + cx.tid] + part[108 + cx.tid]);
                float* rco = cx.rc() + (size_t)pair * 64;
                rco[cx.tid] = s + (cx.tid < 32 ? cx.in(22)[layer * 32 + cx.tid] : cx.in(20)[layer * 4 + cx.tid - 32]);
            }
            __syncthreads();
        }
    }
#define P1_SRC(tt) ({ const int b_ = (tt) / TPB, j_ = (tt) - b_ * TPB; (j_ < CTX) ? cx.in(2) + (size_t)(b_ * CTX + j_) * D : cx.in(0) + (size_t)(b_ * SEQ + j_ - CTX) * D; })
    f32x4 nv[4];
    if (gw < T) load_row(P1_SRC(gw), nv, cx.lane);
    for (int t = gw; t < T; t += gstride) {
        const int b = t / TPB, j = t - b * TPB;
        f32x4 v[4];
#pragma unroll
        for (int q = 0; q < 4; ++q) v[q] = nv[q];
        if (t + gstride < T) load_row(P1_SRC(t + gstride), nv, cx.lane);
        store_row_bf16(cx.xres() + (size_t)t * D, v, cx.lane);
        const float* md = cx.mod() + (size_t)(j < CTX ? 8 : b) * 6144;
        norm_mod(v, cx.in(6), md, md + 1024, cx.lane);
        store_row_bf16(cx.H() + (size_t)t * D, v, cx.lane);
    }
#undef P1_SRC
}

DI void phase_norm_route(const Ctx& cx, int layer, bool last, bool dummy) {
    const int lane = cx.lane, c = lane & 31, h = lane >> 5, w = cx.wave;
    {
        int nhb = (T / 32) % (int)gridDim.x;
        if (4 * nhb >= (int)gridDim.x) nhb = 0;
        const int gw = ((int)blockIdx.x - nhb) * 4 + w, gstride = ((int)gridDim.x - nhb) * 4;
#define H_SKIP(tt) (last && ((tt) - ((tt) / TPB) * TPB) < CTX)
        int t = (gw < 0 ? T : gw);
        while (t < T && H_SKIP(t)) t += gstride;
        u32x2 nx[4];
        if (t < T) { const u32x2* xr_ = (const u32x2*)(cx.xres() + (size_t)t * D);
#pragma unroll
            for (int q = 0; q < 4; ++q) nx[q] = xr_[lane + 64 * q]; }
        while (t < T) {
            const int b = t / TPB, j = t - b * TPB;
            int tn = t + gstride;
            while (tn < T && H_SKIP(tn)) tn += gstride;
            f32x4 v[4];
#pragma unroll
            for (int q = 0; q < 4; ++q) {
                v[q][0] = __builtin_bit_cast(float, nx[q].x << 16); v[q][1] = __builtin_bit_cast(float, nx[q].x & 0xffff0000u);
                v[q][2] = __builtin_bit_cast(float, nx[q].y << 16); v[q][3] = __builtin_bit_cast(float, nx[q].y & 0xffff0000u);
            }
            if (tn < T) { const u32x2* xr_ = (const u32x2*)(cx.xres() + (size_t)tn * D);
#pragma unroll
                for (int q = 0; q < 4; ++q) nx[q] = xr_[lane + 64 * q]; }
            const float* md = cx.mod() + ((size_t)layer * 9 + (j < CTX ? 8 : b)) * 6144;
            norm_mod(v, cx.in(7) + layer * D, md + 3072, md + 4096, lane);
            store_row_bf16(cx.H() + (size_t)t * D, v, lane);
            t = tn;
        }
#undef H_SKIP
    }
    unsigned* cnt = cx.ctl() + CW_CNT + layer * 32 * 64 + (dummy ? 32 : 0);
    int* ltok_ = dummy ? (int*)cx.YP() : cx.ltok(); float* lw_ = dummy ? (float*)(cx.YP() + 4 * 1024 * 1024) : cx.lw();
    const bf16* whi = cx.wr() + (size_t)(layer * 2) * 64 * D + (size_t)c * D + 256 * w + 8 * h;
    LAS float* red = (LAS float*)cx.lds;
    LAS unsigned* hist = (LAS unsigned*)(cx.lds + 4 * 33 * 64 * 4);
    for (int task = blockIdx.x; task < T / 32; task += gridDim.x) {
        const int t0 = task * 32, b = t0 / TPB, j0 = t0 - b * TPB;
        if (last && j0 < CTX) continue;
        const int t = t0 + c, mrow = (j0 < CTX ? 8 : b);
        const bf16* xrow = cx.xres() + (size_t)t * D + 256 * w + 8 * h;
        const float* gmv = cx.gm() + ((size_t)layer * 9 + mrow) * D + 256 * w + 8 * h;
        float ss = 0.f;
        f32x16 acc0, acc1;
#pragma unroll
        for (int i = 0; i < 16; ++i) { acc0[i] = 0.f; acc1[i] = 0.f; }
        LAS unsigned char* park = cx.lds + w * 16384 + lane * 16;
#pragma unroll
        for (int s = 0; s < 16; ++s) glds16(xrow + 16 * s, park + s * 1024);
        asm volatile("s_waitcnt vmcnt(0)" ::: "memory");
#pragma unroll 4
        for (int s = 0; s < 16; ++s) {
            float x[8];
            { const u32x4 xq = *(LAS u32x4*)(park + s * 1024);
              const f32x4 a = {__builtin_bit_cast(float, xq.x << 16), __builtin_bit_cast(float, xq.x & 0xffff0000u), __builtin_bit_cast(float, xq.y << 16), __builtin_bit_cast(float, xq.y & 0xffff0000u)};
              const f32x4 bq = {__builtin_bit_cast(float, xq.z << 16), __builtin_bit_cast(float, xq.z & 0xffff0000u), __builtin_bit_cast(float, xq.w << 16), __builtin_bit_cast(float, xq.w & 0xffff0000u)};
              const f32x4 g0 = *(const f32x4*)(gmv + 16 * s), g1 = *(const f32x4*)(gmv + 16 * s + 4);
              ss += (a[0] * a[0] + a[1] * a[1]) + (a[2] * a[2] + a[3] * a[3]) + (bq[0] * bq[0] + bq[1] * bq[1]) + (bq[2] * bq[2] + bq[3] * bq[3]);
#pragma unroll
              for (int e = 0; e < 4; ++e) { x[e] = a[e] * g0[e]; x[4 + e] = bq[e] * g1[e]; } }
            u32x4 hi, lo;
            hi.x = pk2(x[0], x[1]); hi.y = pk2(x[2], x[3]); hi.z = pk2(x[4], x[5]); hi.w = pk2(x[6], x[7]);
            lo.x = pk2(x[0] - __builtin_bit_cast(float, hi.x << 16), x[1] - __builtin_bit_cast(float, hi.x & 0xffff0000u));
            lo.y = pk2(x[2] - __builtin_bit_cast(float, hi.y << 16), x[3] - __builtin_bit_cast(float, hi.y & 0xffff0000u));
            lo.z = pk2(x[4] - __builtin_bit_cast(float, hi.z << 16), x[5] - __builtin_bit_cast(float, hi.z & 0xffff0000u));
            lo.w = pk2(x[6] - __builtin_bit_cast(float, hi.w << 16), x[7] - __builtin_bit_cast(float, hi.w & 0xffff0000u));
            const bf16x8 bhi = __builtin_bit_cast(bf16x8, hi), blo = __builtin_bit_cast(bf16x8, lo);
            const bf16x8 ah0 = ldg8(whi + 16 * s), ah1 = ldg8(whi + 32 * D + 16 * s), al0 = ldg8(whi + 64 * D + 16 * s), al1 = ldg8(whi + 96 * D + 16 * s);
            acc0 = MFMA(ah0, bhi, acc0); acc0 = MFMA(al0, bhi, acc0); acc0 = MFMA(ah0, blo, acc0);
            acc1 = MFMA(ah1, bhi, acc1); acc1 = MFMA(al1, bhi, acc1); acc1 = MFMA(ah1, blo, acc1);
        }
        __syncthreads();
        LAS float* my = red + (size_t)w * 33 * 64 + lane;
#pragma unroll
        for (int i = 0; i < 16; ++i) { my[i * 64] = acc0[i]; my[(16 + i) * 64] = acc1[i]; }
        my[32 * 64] = ss;
        __syncthreads();
        if (w == 0) {
#pragma unroll
            for (int ww = 1; ww < 4; ++ww) {
                const LAS float* o = red + (size_t)ww * 33 * 64 + lane;
#pragma unroll
                for (int i = 0; i < 16; ++i) { acc0[i] += o[i * 64]; acc1[i] += o[(16 + i) * 64]; }
                ss += o[32 * 64];
            }
            ss += __shfl_xor(ss, 32);
            const float rn = rsqrtf(ss * (1.f / D) + EPS);
            const float* rcv = cx.rc() + ((size_t)layer * 9 + mrow) * 64;
            float gl[4];
#pragma unroll
            for (int g = 0; g < 4; ++g) gl[g] = __shfl(acc1[g], c) * rn + rcv[32 + g];
            int gi = 0; float gmx = gl[0];
#pragma unroll
            for (int g = 1; g < 4; ++g) if (gl[g] > gmx) { gmx = gl[g]; gi = g; }
            float gs = 0.f;
#pragma unroll
            for (int g = 0; g < 4; ++g) gs += __expf(gl[g] - gmx);
            const float gp = 1.f / gs;
            float mine[4], other[4], el[8];
#pragma unroll
            for (int e = 0; e < 4; ++e) {
                float xv = acc0[e];
#pragma unroll
                for (int g = 1; g < 4; ++g) xv = (gi == g) ? acc0[4 * g + e] : xv;
                mine[e] = xv * rn + rcv[gi * 8 + 4 * h + e];
            }
#pragma unroll
            for (int e = 0; e < 4; ++e) other[e] = __shfl_xor(mine[e], 32);
#pragma unroll
            for (int e = 0; e < 4; ++e) { el[e] = (h == 0) ? mine[e] : other[e]; el[4 + e] = (h == 0) ? other[e] : mine[e]; }
            int i1 = 0; float v1 = el[0];
#pragma unroll
            for (int e = 1; e < 8; ++e) if (el[e] > v1) { v1 = el[e]; i1 = e; }
            int i2 = 0; float v2 = -3.0e38f;
#pragma unroll
            for (int e = 0; e < 8; ++e) if (e != i1 && el[e] > v2) { v2 = el[e]; i2 = e; }
            const float ex = __expf(v2 - v1);
            const float w1 = gp / (1.f + ex), w2 = gp * ex / (1.f + ex);
            if (h == 0) {
                const int e1 = gi * 8 + i1, e2 = gi * 8 + i2;
                hist[c] = 0u;
                asm volatile("s_waitcnt lgkmcnt(0)" ::: "memory");
                const unsigned r1 = __hip_atomic_fetch_add(&hist[e1], 1u, __ATOMIC_RELAXED, __HIP_MEMORY_SCOPE_WORKGROUP);
                const unsigned r2 = __hip_atomic_fetch_add(&hist[e2], 1u, __ATOMIC_RELAXED, __HIP_MEMORY_SCOPE_WORKGROUP);
                asm volatile("s_waitcnt lgkmcnt(0)" ::: "memory");
                const unsigned n = hist[c];
                unsigned bs = 0u;
                if (n) bs = atomicAdd(&cnt[c * 64], n);
                hist[32 + c] = bs;
                asm volatile("s_waitcnt lgkmcnt(0)" ::: "memory");
                const unsigned s1 = hist[32 + e1] + r1, s2 = hist[32 + e2] + r2;
                ltok_[(size_t)e1 * LCAP + s1] = t * 2;     lw_[(size_t)e1 * LCAP + s1] = w1;
                ltok_[(size_t)e2 * LCAP + s2] = t * 2 + 1; lw_[(size_t)e2 * LCAP + s2] = w2;
            }
        }
        __syncthreads();
    }
}

DI ConvTask conv_task(const Ctx& cx, int layer, int task, int lane) {
    const int e = task / 768, u = task - e * 768, which = u >> 8, v = u & 255;
    const float* W; bf16* WT; int K, N, kt, nt;
    if (which == 0) { W = cx.in(23) + ((size_t)layer * NEXP + e) * D * DEXP; WT = cx.wmg() + (size_t)e * DEXP * D; K = D; N = DEXP; kt = v >> 4; nt = v & 15; }
    else if (which == 1) { W = cx.in(24) + ((size_t)layer * NEXP + e) * D * DEXP; WT = cx.wmu() + (size_t)e * DEXP * D; K = D; N = DEXP; kt = v >> 4; nt = v & 15; }
    else { W = cx.in(25) + ((size_t)layer * NEXP + e) * DEXP * D; WT = cx.wmd() + (size_t)e * D * DEXP; K = DEXP; N = D; kt = v >> 5; nt = v & 31; }
    ConvTask t;
    t.src = W + (size_t)(kt * 64 + (lane >> 3)) * N + nt * 32 + (lane & 7) * 4;
    t.dst = WT + (size_t)(nt * 32 + (lane >> 3)) * K + kt * 64 + (lane & 7) * 8;
    t.N = N; t.K = K;
    return t;
}
DI void moe_convert(const Ctx& cx, int layer) {
    const int gw = blockIdx.x * 4 + cx.wave, nw = gridDim.x * 4;
    const int lane = cx.lane;
    constexpr int NT = NEXP * 768;
    LAS float* scr = (LAS float*)(cx.lds + 36864) + cx.wave * (64 * 33);
#define CV_LOAD(X, task) do { const ConvTask ct_ = conv_task(cx, layer, (task), lane); \
        _Pragma("unroll") for (int p = 0; p < 8; ++p) X[p] = *(const f32x4*)(ct_.src + (size_t)(8 * p) * ct_.N); } while (0)
#define CV_PROC(X, task) do { const ConvTask ct_ = conv_task(cx, layer, (task), lane); \
        _Pragma("unroll") for (int p = 0; p < 8; ++p) { LAS float* d = scr + ((lane >> 3) + 8 * p) * 33 + (lane & 7) * 4; d[0] = X[p][0]; d[1] = X[p][1]; d[2] = X[p][2]; d[3] = X[p][3]; } \
        asm volatile("s_waitcnt lgkmcnt(0)" ::: "memory"); \
        _Pragma("unroll") for (int p = 0; p < 4; ++p) { const LAS float* s = scr + ((lane & 7) * 8) * 33 + (lane >> 3) + 8 * p; \
            u32x4 o; o.x = pk2(s[0], s[33]); o.y = pk2(s[2 * 33], s[3 * 33]); o.z = pk2(s[4 * 33], s[5 * 33]); o.w = pk2(s[6 * 33], s[7 * 33]); \
            *(u32x4*)(ct_.dst + (size_t)(8 * p) * ct_.K) = o; } \
        asm volatile("s_waitcnt lgkmcnt(0)" ::: "memory"); } while (0)
    int nheavy = ((T / 32) % (int)gridDim.x) * 4;
    if (2 * nheavy >= nw) nheavy = 0;
    const bool heavy = gw < nheavy;
    const int S = nw - nheavy, base = gw - nheavy;
#define CV_ITEM(j) (heavy ? NT : base + S * (j))
    f32x4 xa[8], xb[8];
    int j = 0, task = CV_ITEM(0);
    if (task < NT) CV_LOAD(xa, task);
#pragma unroll 1
    while (task < NT) {
        const int t2 = CV_ITEM(j + 1), t3 = CV_ITEM(j + 2);
        if (t2 < NT) CV_LOAD(xb, t2);
        CV_PROC(xa, task);
        if (t3 < NT) CV_LOAD(xa, t3);
        if (t2 < NT) CV_PROC(xb, t2);
        task = t3; j += 2;
    }
#undef CV_ITEM
#undef CV_LOAD
#undef CV_PROC
}

DI void phase_combine(const Ctx& cx, int layer, bool last, bool dummy) {
    const int gw = blockIdx.x * 4 + cx.wave, gstride = gridDim.x * 4;
    u32x2 nx[4], ny0[4], ny1[4];
#define G_LOAD(tt) do { const u32x2* xr_ = (const u32x2*)(cx.xres() + (size_t)(tt) * D); const u32x2* y0_ = (const u32x2*)(cx.YP() + (size_t)(2 * (tt)) * D); \
        _Pragma("unroll") for (int q = 0; q < 4; ++q) { nx[q] = xr_[cx.lane + 64 * q]; ny0[q] = y0_[cx.lane + 64 * q]; ny1[q] = y0_[256 + cx.lane + 64 * q]; } } while (0)
#define G_SKIP(tt) (last && ((tt) - ((tt) / TPB) * TPB) < CTX)
    int t = gw;
    while (t < T && G_SKIP(t)) t += gstride;
    if (t < T) G_LOAD(t);
    while (t < T) {
        const int b = t / TPB, j = t - b * TPB;
        int tn = t + gstride;
        while (tn < T && G_SKIP(tn)) tn += gstride;
        bf16* xr = cx.xres() + (size_t)t * D;
        f32x4 v[4]; u32x2 cy0[4], cy1[4];
#pragma unroll
        for (int q = 0; q < 4; ++q) {
            v[q][0] = __builtin_bit_cast(float, nx[q].x << 16); v[q][1] = __builtin_bit_cast(float, nx[q].x & 0xffff0000u);
            v[q][2] = __builtin_bit_cast(float, nx[q].y << 16); v[q][3] = __builtin_bit_cast(float, nx[q].y & 0xffff0000u);
            cy0[q] = ny0[q]; cy1[q] = ny1[q];
        }
        if (tn < T) G_LOAD(tn);
        const int mr = (j < CTX) ? 8 : b;
        const float* g2 = cx.mod() + ((size_t)layer * 9 + mr) * 6144 + 5120;
#pragma unroll
        for (int jj = 0; jj < 4; ++jj) {
            const u32x2 a = cy0[jj], bq = cy1[jj];
            const f32x4 gg = ((const f32x4*)g2)[cx.lane + 64 * jj];
            float ya[4] = {bf2f((unsigned short)(a.x & 0xffff)), bf2f((unsigned short)(a.x >> 16)), bf2f((unsigned short)(a.y & 0xffff)), bf2f((unsigned short)(a.y >> 16))};
            float yb[4] = {bf2f((unsigned short)(bq.x & 0xffff)), bf2f((unsigned short)(bq.x >> 16)), bf2f((unsigned short)(bq.y & 0xffff)), bf2f((unsigned short)(bq.y >> 16))};
#pragma unroll
            for (int e = 0; e < 4; ++e) v[jj][e] += gg[e] * (ya[e] + yb[e]);
        }
        if (!last) {
            bf16* xw = dummy ? cx.Q() + (size_t)t * D : xr;
            store_row_bf16(xw, v, cx.lane);
            const float* md = cx.mod() + ((size_t)(layer + 1) * 9 + mr) * 6144;
            norm_mod(v, cx.in(6) + (layer + 1) * D, md, md + 1024, cx.lane);
            store_row_bf16(cx.H() + (size_t)t * D, v, cx.lane);
        } else {
            float ss = 0.f;
#pragma unroll
            for (int jj = 0; jj < 4; ++jj) ss += (v[jj][0] * v[jj][0] + v[jj][1] * v[jj][1]) + (v[jj][2] * v[jj][2] + v[jj][3] * v[jj][3]);
            const float rn = rsqrtf(wave_sum(ss) * (1.f / D) + EPS);
            float* orow = cx.out() + (size_t)(b * SEQ + j - CTX) * D;
#pragma unroll
            for (int jj = 0; jj < 4; ++jj) {
                const f32x4 gg = ((const f32x4*)cx.in(8))[cx.lane + 64 * jj];
                f32x4 o;
#pragma unroll
                for (int e = 0; e < 4; ++e) o[e] = v[jj][e] * rn * gg[e];
                ((f32x4*)orow)[cx.lane + 64 * jj] = o;
            }
        }
        t = tn;
    }
#undef G_LOAD
#undef G_SKIP
}

DI void moe_directory(const Ctx& cx, int layer, LAS int* s_off, LAS int* s_toff) {
    if (cx.tid == 0) {
        const unsigned* cnt = cx.ctl() + CW_CNT + layer * 32 * 64;
        int o = 0, to = 0;
        for (int e = 0; e < NEXP; ++e) { const int c = (int)cnt[e * 64]; s_off[e] = o; s_toff[e] = to; o += c; to += (c + 127) >> 7; }
        s_off[NEXP] = o; s_toff[NEXP] = to;
    }
    __syncthreads();
}

__global__ void __launch_bounds__(NTHREADS, 2) fwd_kernel(Params p) {
    extern __shared__ __attribute__((aligned(16))) unsigned char lds_raw[];
    Ctx cx;
    cx.pp = (ParamsPtr)__builtin_amdgcn_kernarg_segment_ptr();
    cx.lds = (LAS unsigned char*)lds_raw;
    cx.tid = threadIdx.x; cx.lane = cx.tid & 63; cx.wave = __builtin_amdgcn_readfirstlane(cx.tid >> 6);
    volatile LAS unsigned* misc = (volatile LAS unsigned*)(cx.lds + LDS_MISC);
    LAS int* s_off = (LAS int*)(cx.lds + LDS_MISC + 64);
    LAS int* s_toff = (LAS int*)(cx.lds + LDS_MISC + 64 + 160);
    if (cx.tid < 2) misc[cx.tid] = 0u;
    __syncthreads();
    if (cx.pp->ph_hi - cx.pp->ph_lo > 1) (void)xcd_barrier_post((unsigned*)(cx.pp->ws + WS_CTL) + CW_BAR, misc);
    bool again_ = false;
    for (int ph = cx.pp->ph_lo; ; ) {
        asm volatile("" : "+s"(cx.pp));
        { int tid_ = threadIdx.x; asm volatile("" : "+v"(tid_)); cx.tid = tid_; cx.lane = tid_ & 63; cx.wave = __builtin_amdgcn_readfirstlane(tid_ >> 6); }
        if (ph == 0) phase_prologue(cx);
        else if (ph == 1) phase_first_norm(cx);
        else {
            const int layer = (ph - 2) / 7, sub = (ph - 2) % 7, kind = layer % 3;
#ifdef PROBE_REP
            const bool dummy = !again_ && ((PROBE_REP >> ph) & 1ull);
#else
            const bool dummy = false;
#endif
            const bool last = (layer == DEPTH - 1);
            const int vbid = (gridDim.x & 7) ? (int)blockIdx.x : (int)((blockIdx.x & 7) * (gridDim.x >> 3) + (blockIdx.x >> 3));
            if (sub == 0) {
                QkvOp op; op.A = cx.H(); op.kind = kind; op.Q = cx.Q(); op.Kb = cx.K(); op.VT = cx.VT(); op.rc = cx.ropec(); op.rs = cx.ropes();
                op.Wt = cx.wqkv(layer);
                if (kind == 2) { op.N = 1536; op.kw = 256; op.voff = 1280; op.vw = 256; }
                else { op.N = 3072; op.kw = D; op.voff = 2048; op.vw = D; }
                const int ntn = op.N / 128, ntiles = (T / 128) * ntn;
                for (int tile = blockIdx.x; tile < ntiles; tile += gridDim.x) {
                    op.m0 = (tile / ntn) * 128; op.n0 = (tile % ntn) * 128;
                    gemm_tile<2, 2, 64>(op, cx.lds, cx.tid);
                }
            } else if (sub == 1) {
                if (kind == 1) attn_block_da(cx, layer, !last, vbid); else attn_block_nasw(cx, kind, layer, !last, vbid);
            } else if (sub == 2) {
                OutOp op; op.A = cx.O(); op.xres = cx.xres(); op.xdst = dummy ? cx.Q() : cx.xres(); op.modl = cx.mod() + (size_t)layer * 9 * 6144;
                op.Wt = cx.wo(layer);
                for (int tile = vbid; tile < 1024; tile += gridDim.x) {
                    int mt = tile >> 3;
                    if (last) mt = (mt >> 4) * 18 + 2 + (mt & 15);
                    op.m0 = mt * 128; op.n0 = (tile & 7) * 128;
                    gemm_tile<2, 2, 64>(op, cx.lds, cx.tid);
                }
                if (!last) for (int u = blockIdx.x; u < 256; u += gridDim.x) {
                    op.m0 = 128 * 128 + (u >> 3) * 64; op.n0 = (u & 7) * 128;
                    gemm_tile<1, 2, 64>(op, cx.lds, cx.tid);
                }
            } else if (sub == 3) {
                if (blockIdx.x & 1) { moe_convert(cx, layer); __syncthreads(); }
                phase_norm_route(cx, layer, last, dummy);
                if (!(blockIdx.x & 1)) { __syncthreads(); moe_convert(cx, layer); }
#ifdef PROBE_CONV2
                moe_convert(cx, layer);
#endif
            } else if (sub == 4) {
                moe_directory(cx, layer, s_off, s_toff);
                const int ntiles = s_toff[NEXP] * 8;
                for (int tile = vbid; tile < ntiles; tile += gridDim.x) {
                    const int rtg = tile >> 3; int e = 0;
                    while (s_toff[e + 1] <= rtg) ++e;
                    GateUpOp op; op.H = cx.H(); op.cnt = s_off[e + 1] - s_off[e]; op.r0 = (rtg - s_toff[e]) * 128; op.f0 = (tile & 7) * 64;
                    op.WgT = cx.wmg() + (size_t)e * DEXP * D; op.WuT = cx.wmu() + (size_t)e * DEXP * D;
                    op.ltok = cx.ltok() + (size_t)e * LCAP; op.act = cx.ACT() + (size_t)s_off[e] * DEXP;
                    gemm_tile<2, 2, 64>(op, cx.lds, cx.tid);
                }
            } else if (sub == 5) {
                moe_directory(cx, layer, s_off, s_toff);
                const int ntiles = s_toff[NEXP] * 8;
                DownOp op, nop; op.yp = cx.YP(); nop.yp = op.yp;
#define F_SET(o, tl) do { const int rtg_ = (tl) >> 3; int e_ = 0; while (s_toff[e_ + 1] <= rtg_) ++e_; \
                    (o).cnt = s_off[e_ + 1] - s_off[e_]; (o).r0 = (rtg_ - s_toff[e_]) * 128; (o).n0 = ((tl) & 7) * 128; \
                    (o).act = cx.ACT() + (size_t)s_off[e_] * DEXP; (o).WdT = cx.wmd() + (size_t)e_ * D * DEXP; \
                    (o).ltok = cx.ltok() + (size_t)e_ * LCAP; (o).lw = cx.lw() + (size_t)e_ * LCAP; } while (0)
                int tile = vbid; bool first = true;
                if (tile < ntiles) F_SET(op, tile);
                while (tile < ntiles) {
                    const int nt_ = tile + gridDim.x; const bool hn = nt_ < ntiles;
                    if (hn) F_SET(nop, nt_); else nop = op;
                    gemm_tile_x<2, 2, 64, true>(op, nop, hn, first, cx.lds, cx.tid);
                    op = nop; tile = nt_; first = false;
                }
#undef F_SET
            } else {
                phase_combine(cx, layer, last, dummy);
            }
        }
#ifdef PROBE_REP
        if (!again_ && ((PROBE_REP >> ph) & 1ull)) again_ = true; else { again_ = false; ++ph; }
#else
        ++ph;
#endif
        if (ph >= cx.pp->ph_hi) break;
        { XcdBarrier bar; bar.bar = cx.ctl() + CW_BAR; bar.x = xb_xcc_id(); bar.st = (volatile LAS unsigned*)(cx.lds + LDS_MISC); xcd_barrier(bar);
#ifdef PROBE_BAR2
          xcd_barrier(bar);
#endif
        }
    }
}

extern "C" void kernel_launch(void* const* d_in, const int* in_sizes, int n_in, void* d_out, int out_size, void* d_ws, size_t ws_size, hipStream_t stream) {
    static int grid = 0;
    if (grid == 0) {
        if (n_in != 26 || ws_size < WS_END) { fprintf(stderr, "kernel_launch: unexpected inputs (n_in %d) or workspace %zu < %zu\n", n_in, ws_size, (size_t)WS_END); grid = -1; return; }
        int dev = 0, cus = 0, per_cu = 0;
        (void)hipGetDevice(&dev);
        (void)hipDeviceGetAttribute(&cus, hipDeviceAttributeMultiprocessorCount, dev);
        if (hipFuncSetAttribute((const void*)fwd_kernel, hipFuncAttributeMaxDynamicSharedMemorySize, LDS_BYTES) != hipSuccess) { fprintf(stderr, "kernel_launch: hipFuncSetAttribute failed\n"); grid = -1; return; }
        if (hipOccupancyMaxActiveBlocksPerMultiprocessor(&per_cu, (const void*)fwd_kernel, NTHREADS, LDS_BYTES) != hipSuccess || per_cu < 1) { fprintf(stderr, "kernel_launch: occupancy query failed (%d)\n", per_cu); per_cu = 1; }
        (void)hipGetLastError();
        if (per_cu > 2) per_cu = 2;
        grid = cus * per_cu;
        fprintf(stderr, "kernel_launch: %d CUs x %d blocks\n", cus, per_cu);
    }
    if (grid < 0) return;
    (void)hipMemsetAsync((char*)d_ws + WS_CTL, 0, CTL_BYTES, stream);
    Params p{};
    for (int i = 0; i < 26; ++i) p.in[i] = (const float*)d_in[i];
    p.out = (float*)d_out; p.ws = (unsigned char*)d_ws;
#if ONE_LAUNCH
    p.ph_lo = 0; p.ph_hi = NPHASES;
    hipLaunchKernelGGL(fwd_kernel, dim3(grid), dim3(NTHREADS), LDS_BYTES, stream, p);
#else
    for (int ph = 0; ph < NPHASES; ++ph) {
        p.ph_lo = ph; p.ph_hi = ph + 1;
        hipLaunchKernelGGL(fwd_kernel, dim3(grid), dim3(NTHREADS), LDS_BYTES, stream, p);
    }
#endif
}
```

```cpp
#include <hip/hip_runtime.h>
#include <cstdio>
#include <cstdint>

#ifndef ONE_LAUNCH
#define ONE_LAUNCH 1
#define PROBE_REP 0ull
#ifndef IGLP_ATT
#define IGLP_ATT 3
#endif


#endif

#define DI __device__ __forceinline__
#define LAS __attribute__((address_space(3)))
typedef unsigned short bf16;
typedef short bf16x8 __attribute__((ext_vector_type(8)));
typedef float f32x16 __attribute__((ext_vector_type(16)));
typedef float f32x4 __attribute__((ext_vector_type(4)));
typedef float f32x2 __attribute__((ext_vector_type(2)));
typedef unsigned u32x4 __attribute__((ext_vector_type(4)));
typedef unsigned u32x2 __attribute__((ext_vector_type(2)));
typedef __bf16 bf16x2_t __attribute__((ext_vector_type(2)));
#define MFMA(a, b, c) __builtin_amdgcn_mfma_f32_32x32x16_bf16((a), (b), (c), 0, 0, 0)

constexpr int D = 1024, NB = 8, SEQ = 2048, CTX = 256, DEPTH = 4;
constexpr int TPB = CTX + SEQ;
constexpr int T = NB * TPB;
constexpr int NEXP = 32, DEXP = 512;
constexpr int LCAP = T;
constexpr float EPS = 1e-6f;
constexpr float LOG2E = 1.4426950408889634f;
constexpr float SM_C = 0.125f * LOG2E;
constexpr float NEG = -1e30f;

constexpr size_t MiB = 1u << 20;
constexpr size_t WS_CTL = 0, CTL_BYTES = 65536;
constexpr size_t WS_MOD = 1 * MiB;
constexpr size_t WS_ROPE = 2 * MiB;
constexpr size_t WS_LTOK = 3 * MiB;
constexpr size_t WS_LW = 6 * MiB;
constexpr size_t WS_WR = 9 * MiB;
constexpr size_t WS_WQKV = 416 * MiB;
constexpr size_t WS_WO = 440 * MiB;
constexpr size_t WS_GM = 10 * MiB;
constexpr size_t WS_RC = 11 * MiB;
constexpr size_t WS_RPB = 12 * MiB;
constexpr size_t WS_XRES = 16 * MiB;
constexpr size_t WS_H = 96 * MiB;
constexpr size_t WS_Q = 136 * MiB;
constexpr size_t WS_K = 176 * MiB;
constexpr size_t WS_VT = 216 * MiB;
constexpr size_t WS_O = 256 * MiB;
constexpr size_t WS_ACT = 296 * MiB;
constexpr size_t WS_YP = 336 * MiB;
constexpr size_t WS_WMG = 448 * MiB;
constexpr size_t WS_WMU = 480 * MiB;
constexpr size_t WS_WMD = 512 * MiB;
constexpr size_t WS_END = 544 * MiB;
constexpr int CW_BAR = 0;
constexpr int CW_CNT = 8192;

constexpr int NTHREADS = 256;
constexpr int LDS_GEMM = 73728;
constexpr int LDS_MISC = LDS_GEMM;
constexpr int LDS_BYTES = LDS_GEMM + 1024;
constexpr int NPHASES = 2 + 7 * DEPTH;

struct Params {
    const float* in[26];
    float* out;
    unsigned char* ws;
    int ph_lo, ph_hi;
};

DI unsigned pk2(float lo, float hi) { f32x2 v = {lo, hi}; bf16x2_t r = __builtin_convertvector(v, bf16x2_t); return __builtin_bit_cast(unsigned, r); }
DI float bf2f(unsigned short u) { return __builtin_bit_cast(float, (unsigned)u << 16); }
DI float wave_sum(float v) {
#pragma unroll
    for (int o = 1; o < 64; o <<= 1) v += __shfl_xor(v, o);
    return v;
}
DI float fexp2(float x) { return __builtin_amdgcn_exp2f(x); }
DI float silu(float v) { return v / (1.f + __expf(-v)); }
DI bf16x8 ldg8(const bf16* p) { return *(const bf16x8*)p; }
DI void glds16(const void* g, LAS unsigned char* l) {
    __builtin_amdgcn_global_load_lds((const unsigned*)g, (LAS unsigned*)l, 16, 0, 0);
}
DI int pi32(int r) { return (r & 0x13) | ((r & 4) << 1) | ((r & 8) >> 1); }

#define XB_TMO      128
#define XB_XCNT(j)  (256  + 64 * (j))
#define XB_XSUB(j)  (1280 + 64 * (j))
#define XB_XGEN(j)  (2304 + 64 * (j))
#define XB_TOP      3328
#define XB_TOPGEN   3392
#define XCD_BAR_WORDS 3456
#define XB_SPIN_CAP (1u << 20)
DI unsigned xb_ld(unsigned* p) { return __hip_atomic_load(p, __ATOMIC_RELAXED, __HIP_MEMORY_SCOPE_AGENT); }
DI unsigned xb_add(unsigned* p, unsigned v) { return __hip_atomic_fetch_add(p, v, __ATOMIC_RELAXED, __HIP_MEMORY_SCOPE_AGENT); }
DI unsigned xb_xcc_id() { return (unsigned)__builtin_amdgcn_s_getreg((3 << 11) | 20) & 0xFu; }
#define XB_SPIN(cond, bar) do { unsigned _sp = 0; while (cond) { __builtin_amdgcn_s_sleep(1); \
    if ((++_sp & 255u) == 0u) { if (xb_ld(&(bar)[XB_TMO])) break; if (_sp > XB_SPIN_CAP) { atomicAdd(&(bar)[XB_TMO], 1u); break; } } } } while (0)
struct XcdBarrier { unsigned* bar; unsigned x; volatile LAS unsigned* st; };
DI XcdBarrier xcd_barrier_post(unsigned* bar, volatile LAS unsigned* st) {
    XcdBarrier b; b.bar = bar; b.x = xb_xcc_id(); b.st = st;
    if (threadIdx.x == 0) (void)xb_add(&bar[XB_XCNT(b.x)], 1u);
    return b;
}
DI void xcd_barrier_complete(unsigned* bar, unsigned x, unsigned& nloc, unsigned& nx) {
    const unsigned G = gridDim.x * gridDim.y * gridDim.z;
    unsigned sum, cnt, mine, sp = 0u;
    for (;;) {
        sum = 0u; cnt = 0u; mine = 0u;
#pragma unroll
        for (unsigned j = 0; j < 16; ++j) { const unsigned c = xb_ld(&bar[XB_XCNT(j)]); sum += c; cnt += (c > 0u) ? 1u : 0u; mine = (j == x) ? c : mine; }
        if (sum == G) break;
        __builtin_amdgcn_s_sleep(1);
        if ((++sp & 255u) == 0u) { if (xb_ld(&bar[XB_TMO])) break; if (sp > XB_SPIN_CAP) { atomicAdd(&bar[XB_TMO], 1u); break; } }
    }
    nloc = mine > 0u ? mine : 1u; nx = cnt > 0u ? cnt : 1u;
}
DI void xcd_barrier(const XcdBarrier& b) {
    asm volatile("s_waitcnt vmcnt(0)" ::: "memory");
    __syncthreads();
    if (threadIdx.x == 0) {
        unsigned* bar = b.bar;
        __builtin_amdgcn_s_waitcnt(0);
        unsigned nloc = b.st[0], nx = b.st[1];
        if (nloc == 0u) { xcd_barrier_complete(bar, b.x, nloc, nx); b.st[0] = nloc; b.st[1] = nx; }
        const unsigned old = xb_add(&bar[XB_XSUB(b.x)], 1u);
        const unsigned gen = old / nloc;
        if (old + 1u == (gen + 1u) * nloc) {
            __builtin_amdgcn_fence(__ATOMIC_RELEASE, "agent");
            asm volatile("s_waitcnt vmcnt(0)" ::: "memory");
            const unsigned og = xb_add(&bar[XB_TOP], 1u);
            const unsigned tg = og / nx;
            if (og + 1u == (tg + 1u) * nx) xb_add(&bar[XB_TOPGEN], 1u);
            else XB_SPIN(xb_ld(&bar[XB_TOPGEN]) == tg, bar);
            __builtin_amdgcn_fence(__ATOMIC_ACQUIRE, "agent");
            xb_add(&bar[XB_XGEN(b.x)], 1u);
            asm volatile("s_waitcnt vmcnt(0)" ::: "memory");
        } else {
            XB_SPIN(xb_ld(&bar[XB_XGEN(b.x)]) == gen, bar);
            __builtin_amdgcn_fence(__ATOMIC_ACQUIRE, "agent");
            asm volatile("s_waitcnt vmcnt(0)" ::: "memory");
        }
    }
    __syncthreads();
}

typedef const __attribute__((address_space(4))) Params* ParamsPtr;
struct Ctx {
    ParamsPtr pp;
    LAS unsigned char* lds;
    int tid, lane, wave;
    DI const float* in(int i) const { return pp->in[i]; }
    DI float* out() const { return pp->out; }
    DI unsigned char* ws() const { return pp->ws; }
    DI unsigned* ctl() const { return (unsigned*)(ws() + WS_CTL); }
    DI float* mod() const { return (float*)(ws() + WS_MOD); }
    DI float* ropec() const { return (float*)(ws() + WS_ROPE); }
    DI float* ropes() const { return (float*)(ws() + WS_ROPE) + 1024; }
    DI int* ltok() const { return (int*)(ws() + WS_LTOK); }
    DI float* lw() const { return (float*)(ws() + WS_LW); }
    DI bf16* wr() const { return (bf16*)(ws() + WS_WR); }
    DI bf16* wqkv(int layer) const { return (bf16*)(ws() + WS_WQKV) + (size_t)layer * 3072 * D; }
    DI bf16* wmg() const { return (bf16*)(ws() + WS_WMG); }
    DI bf16* wmu() const { return (bf16*)(ws() + WS_WMU); }
    DI bf16* wmd() const { return (bf16*)(ws() + WS_WMD); }
    DI bf16* wo(int layer) const { return (bf16*)(ws() + WS_WO) + (size_t)layer * D * D; }
    DI float* gm() const { return (float*)(ws() + WS_GM); }
    DI float* rc() const { return (float*)(ws() + WS_RC); }
    DI float* rpbp() const { return (float*)(ws() + WS_RPB); }
    DI bf16* xres() const { return (bf16*)(ws() + WS_XRES); }
    DI bf16* H() const { return (bf16*)(ws() + WS_H); }
    DI bf16* Q() const { return (bf16*)(ws() + WS_Q); }
    DI bf16* K() const { return (bf16*)(ws() + WS_K); }
    DI bf16* VT() const { return (bf16*)(ws() + WS_VT); }
    DI bf16* O() const { return (bf16*)(ws() + WS_O); }
    DI bf16* ACT() const { return (bf16*)(ws() + WS_ACT); }
    DI bf16* YP() const { return (bf16*)(ws() + WS_YP); }
};

DI int mod_row(int t) { const int b = t / TPB; return (t - b * TPB) < CTX ? 8 : b; }

template <int MI, int NSTG, int BK, bool CHAIN, class Op>
DI void gemm_tile_x(const Op& op, const Op& nop, bool has_next, bool first, LAS unsigned char* lds, int tid) {
    constexpr int BM = 64 * MI, RB = BK * 2  , STG = (BM + 128) * RB, APC = BM * RB / 4096, BPC = 128 * RB / 4096, LPT = APC + BPC, KS = BK / 16, RPP = 4096 / RB  ;
    const int lane = tid & 63, wave = tid >> 6, wm = wave & 1, wn = wave >> 1;
    const int r = lane & 31, h = lane >> 5;
    const int K = op.K(), nk = K / BK;
    const int srow = (BK == 32) ? (tid >> 2) : (tid >> 3);
    const int sch = (BK == 32) ? ((tid & 3) ^ ((tid >> 4) & 3)) : ((tid & 7) ^ ((tid >> 4) & 7));
    const bf16* ap[APC]; const bf16* bpt[BPC];
#pragma unroll
    for (int i = 0; i < APC; ++i) ap[i] = op.arow(srow + RPP * i) + sch * 8;
#pragma unroll
    for (int i = 0; i < BPC; ++i) bpt[i] = op.brow_ptr(srow + RPP * i) + sch * 8;
    const unsigned xs = (BK == 32) ? ((r >> 2) & 3) : ((r >> 1) & 7);
    unsigned a_rd[MI], b_rd[2];
#pragma unroll
    for (int mi = 0; mi < MI; ++mi) a_rd[mi] = (32 * MI * wm + 32 * mi + r) * RB;
#pragma unroll
    for (int ni = 0; ni < 2; ++ni) b_rd[ni] = BM * RB + (op.brow(wn, ni) + r) * RB;

    f32x16 acc[2][MI];
#pragma unroll
    for (int ni = 0; ni < 2; ++ni)
#pragma unroll
        for (int mi = 0; mi < MI; ++mi)
#pragma unroll
            for (int i = 0; i < 16; ++i) acc[ni][mi][i] = 0.f;
    typename Op::template Pre<MI> pre;
    op.template prefetch<MI>(pre, wm, wn, r, h);

#define G_ISSUE(kt, stg) do { LAS unsigned char* s_ = lds + (stg) * STG + tid * 16; \
        _Pragma("unroll") for (int i = 0; i < APC; ++i) glds16(ap[i] + (kt) * BK, s_ + i * 4096); \
        _Pragma("unroll") for (int i = 0; i < BPC; ++i) glds16(bpt[i] + (kt) * BK, s_ + BM * RB + i * 4096); } while (0)

    if (!CHAIN || first) {
        __syncthreads();
#pragma unroll
        for (int s = 0; s < NSTG - 1; ++s) if (s < nk) G_ISSUE(s, s);
    }
    int stg = 0, istg = NSTG - 1;
    for (int kt = 0; kt < nk; ++kt) {
        if (kt + NSTG - 2 < nk) asm volatile("s_waitcnt vmcnt(%0)" :: "n"((NSTG - 2) * LPT) : "memory");
        else asm volatile("s_waitcnt vmcnt(0)" ::: "memory");
        __builtin_amdgcn_s_barrier();
        asm volatile("" ::: "memory");
        if (kt + NSTG - 1 < nk) G_ISSUE(kt + NSTG - 1, istg);
        __builtin_amdgcn_sched_barrier(0);
        LAS unsigned char* base = lds + stg * STG;
        __builtin_amdgcn_iglp_opt(1);
#pragma unroll
        for (int s = 0; s < KS; ++s) {
            const unsigned co = (unsigned)(((2 * s + h) ^ xs) << 4);
            bf16x8 af[MI], bfr[2];
#pragma unroll
            for (int mi = 0; mi < MI; ++mi) af[mi] = *(LAS bf16x8*)(base + a_rd[mi] + co);
#pragma unroll
            for (int ni = 0; ni < 2; ++ni) bfr[ni] = *(LAS bf16x8*)(base + b_rd[ni] + co);
#pragma unroll
            for (int ni = 0; ni < 2; ++ni)
#pragma unroll
                for (int mi = 0; mi < MI; ++mi) acc[ni][mi] = MFMA(bfr[ni], af[mi], acc[ni][mi]);
        }
        asm volatile("" ::: "memory");
        stg = (stg + 1 == NSTG) ? 0 : stg + 1; istg = (istg + 1 == NSTG) ? 0 : istg + 1;
    }
#undef G_ISSUE
    if (CHAIN) {
        __syncthreads();
        if (has_next) {
#pragma unroll
            for (int s = 0; s < NSTG - 1; ++s) if (s < nk) {
                LAS unsigned char* s_ = lds + s * STG + tid * 16;
#pragma unroll
                for (int i = 0; i < APC; ++i) glds16(nop.arow(srow + RPP * i) + sch * 8 + s * BK, s_ + i * 4096);
#pragma unroll
                for (int i = 0; i < BPC; ++i) glds16(nop.brow_ptr(srow + RPP * i) + sch * 8 + s * BK, s_ + BM * RB + i * 4096);
            }
        }
        __builtin_amdgcn_sched_barrier(0);
    }
    if (Op::kLdsEpi) {
        if (!CHAIN) __syncthreads();
        else asm volatile("s_waitcnt vmcnt(0)" ::: "memory");
        op.template epi_lds<MI>(acc, pre, wm, wn, r, h, lds + 32768 + wave * 8704);
    } else op.template epi<MI>(acc, pre, wm, wn, r, h);
}
template <int MI, int NSTG, int BK, class Op>
DI void gemm_tile(const Op& op, LAS unsigned char* lds, int tid) { gemm_tile_x<MI, NSTG, BK, false>(op, op, false, true, lds, tid); }

struct QkvOp {
    static constexpr bool kLdsEpi = false;
    template <int MI, class P> DI void epi_lds(f32x16 (&)[2][MI], const P&, int, int, int, int, LAS unsigned char*) const {}
    template <int MI> struct Pre {};
    template <int MI> DI void prefetch(Pre<MI>&, int, int, int, int) const {}
    const bf16* A; const bf16* Wt; int N, m0, n0, kind, kw, voff, vw;
    bf16* Q; bf16* Kb; bf16* VT; const float* rc; const float* rs;
    DI int K() const { return D; }
    DI const bf16* arow(int ml) const { return A + (size_t)(m0 + ml) * D; }
    DI const bf16* brow_ptr(int nl) const { return Wt + (size_t)(n0 + nl) * D; }
    DI int brow(int wn, int ni) const { return 64 * wn + 32 * ni; }
    template <int MI> DI void epi(f32x16 (&acc)[2][MI], const Pre<MI>& pre, int wm, int wn, int c, int h) const {
#pragma unroll
        for (int ni = 0; ni < 2; ++ni)
#pragma unroll
            for (int mi = 0; mi < MI; ++mi) {
                const int nb = n0 + 64 * wn + 32 * ni;
                const int t = m0 + 32 * MI * wm + 32 * mi + c;
                const int b = t / TPB, j = t - b * TPB;
                f32x16 v = acc[ni][mi];
                if (nb < voff) {
                    if (kind != 0 && j >= CTX) {
                        const int s = j - CTX;
                        const int pos = ((nb >> 5) & 1) ? (s & 63) : (s >> 6);
#pragma unroll
                        for (int g = 0; g < 2; ++g)
#pragma unroll
                            for (int e = 0; e < 4; ++e) {
                                const int i = 4 * g + e, d = e + 8 * g + 4 * h;
                                const float cs = rc[pos * 16 + d], sn = rs[pos * 16 + d];
                                const float x1 = v[i], x2 = v[i + 8];
                                v[i] = x1 * cs - x2 * sn; v[i + 8] = x2 * cs + x1 * sn;
                            }
                    }
                    bf16* dst = (nb < D) ? (Q + (size_t)t * D + nb) : (Kb + (size_t)t * kw + (nb - D));
#pragma unroll
                    for (int g = 0; g < 4; ++g) {
                        u32x2 w; w.x = pk2(v[4 * g], v[4 * g + 1]); w.y = pk2(v[4 * g + 2], v[4 * g + 3]);
                        *(u32x2*)(dst + 8 * g + 4 * h) = w;
                    }
                } else {
                    const unsigned off0 = (unsigned)((b * vw + (nb - voff) + 4 * h) * TPB + j);
#pragma unroll
                    for (int i = 0; i < 16; ++i)
                        VT[off0 + (unsigned)(((i & 3) + 8 * (i >> 2)) * TPB)] = (bf16)(pk2(v[i], 0.f) & 0xffffu);
                }
            }
    }
};

struct OutOp {
    static constexpr bool kLdsEpi = true;
    const bf16* A; const bf16* Wt; int m0, n0; const bf16* xres; bf16* xdst; const float* modl;
    template <int MI> struct Pre { u32x4 x[MI][4]; };
    DI int K() const { return D; }
    DI const bf16* arow(int ml) const { return A + (size_t)(m0 + ml) * D; }
    DI const bf16* brow_ptr(int nl) const { return Wt + (size_t)(n0 + nl) * D; }
    DI int brow(int wn, int ni) const { return 64 * wn + 32 * ni; }
    template <int MI> DI void prefetch(Pre<MI>& pre, int wm, int wn, int c, int h) const {
        const int lane = c + 32 * h, col = n0 + 64 * wn + 8 * (lane & 7);
#pragma unroll
        for (int mi = 0; mi < MI; ++mi)
#pragma unroll
            for (int p = 0; p < 4; ++p) { const int t = m0 + 32 * MI * wm + 32 * mi + ((lane + 64 * p) >> 3); pre.x[mi][p] = *(const u32x4*)(xres + (size_t)t * D + col); }
    }
    template <int MI> DI void epi(f32x16 (&)[2][MI], const Pre<MI>&, int, int, int, int) const {}
    template <int MI> DI void epi_lds(f32x16 (&acc)[2][MI], const Pre<MI>& pre, int wm, int wn, int c, int h, LAS unsigned char* wl) const {
        const int lane = c + 32 * h, col = n0 + 64 * wn + 8 * (lane & 7);
        const float* gp = modl + mod_row(m0) * 6144 + 2048 + col;
        const f32x4 g0 = *(const f32x4*)gp, g1 = *(const f32x4*)(gp + 4);
#pragma unroll
        for (int mi = 0; mi < MI; ++mi) {
#pragma unroll
            for (int ni = 0; ni < 2; ++ni)
#pragma unroll
                for (int g = 0; g < 4; ++g) {
                    f32x4 v = {acc[ni][mi][4 * g], acc[ni][mi][4 * g + 1], acc[ni][mi][4 * g + 2], acc[ni][mi][4 * g + 3]};
                    *(LAS f32x4*)(wl + c * 272 + (32 * ni + 8 * g + 4 * h) * 4) = v;
                }
            asm volatile("s_waitcnt lgkmcnt(0)" ::: "memory");
#pragma unroll
            for (int p = 0; p < 4; ++p) {
                const int q = lane + 64 * p, row = q >> 3;
                const f32x4 a0 = *(LAS f32x4*)(wl + row * 272 + (q & 7) * 32), a1 = *(LAS f32x4*)(wl + row * 272 + (q & 7) * 32 + 16);
                const u32x4 xv = pre.x[mi][p];
                u32x4 o;
                o.x = pk2(__builtin_bit_cast(float, xv.x << 16) + g0[0] * a0[0], __builtin_bit_cast(float, xv.x & 0xffff0000u) + g0[1] * a0[1]);
                o.y = pk2(__builtin_bit_cast(float, xv.y << 16) + g0[2] * a0[2], __builtin_bit_cast(float, xv.y & 0xffff0000u) + g0[3] * a0[3]);
                o.z = pk2(__builtin_bit_cast(float, xv.z << 16) + g1[0] * a1[0], __builtin_bit_cast(float, xv.z & 0xffff0000u) + g1[1] * a1[1]);
                o.w = pk2(__builtin_bit_cast(float, xv.w << 16) + g1[2] * a1[2], __builtin_bit_cast(float, xv.w & 0xffff0000u) + g1[3] * a1[3]);
                const int t = m0 + 32 * MI * wm + 32 * mi + row;
                *(u32x4*)(xdst + (size_t)t * D + col) = o;
            }
            asm volatile("s_waitcnt lgkmcnt(0)" ::: "memory");
        }
    }
};

struct GateUpOp {
    static constexpr bool kLdsEpi = false;
    template <int MI, class P> DI void epi_lds(f32x16 (&)[2][MI], const P&, int, int, int, int, LAS unsigned char*) const {}
    template <int MI> struct Pre {};
    template <int MI> DI void prefetch(Pre<MI>&, int, int, int, int) const {}
    const bf16* H; const bf16* WgT; const bf16* WuT; const int* ltok; int cnt, r0, f0; bf16* act;
    DI int K() const { return D; }
    DI const bf16* arow(int ml) const { int p = r0 + ml; p = p < cnt ? p : cnt - 1; return H + (size_t)(ltok[p] >> 1) * D; }
    DI const bf16* brow_ptr(int nl) const { return (nl < 64) ? (WgT + (size_t)(f0 + nl) * D) : (WuT + (size_t)(f0 + nl - 64) * D); }
    DI int brow(int wn, int ni) const { return 64 * ni + 32 * wn; }
    template <int MI> DI void epi(f32x16 (&acc)[2][MI], const Pre<MI>& pre, int wm, int wn, int c, int h) const {
#pragma unroll
        for (int mi = 0; mi < MI; ++mi) {
            const int p = r0 + 32 * MI * wm + 32 * mi + c;
            if (p < cnt) {
                bf16* dst = act + (size_t)p * DEXP + f0 + 32 * wn + 4 * h;
#pragma unroll
                for (int g = 0; g < 4; ++g) {
                    float o[4];
#pragma unroll
                    for (int e = 0; e < 4; ++e) { const float a = acc[0][mi][4 * g + e], u = acc[1][mi][4 * g + e]; o[e] = silu(a) * u; }
                    u32x2 w; w.x = pk2(o[0], o[1]); w.y = pk2(o[2], o[3]);
                    *(u32x2*)(dst + 8 * g) = w;
                }
            }
        }
    }
};

struct DownOp {
    static constexpr bool kLdsEpi = true;
    template <int MI> struct Pre { int tk[MI][4]; float w[MI]; };
    const bf16* act; const bf16* WdT; const int* ltok; const float* lw; int cnt, r0, n0; bf16* yp;
    DI int K() const { return DEXP; }
    DI const bf16* arow(int ml) const { int p = r0 + ml; p = p < cnt ? p : cnt - 1; return act + (size_t)p * DEXP; }
    DI const bf16* brow_ptr(int nl) const { return WdT + (size_t)(n0 + nl) * DEXP; }
    DI int brow(int wn, int ni) const { return 64 * wn + 32 * ni; }
    template <int MI> DI void prefetch(Pre<MI>& pre, int wm, int wn, int c, int h) const {
        const int lane = c + 32 * h;
#pragma unroll
        for (int mi = 0; mi < MI; ++mi) {
            const int pw = r0 + 32 * MI * wm + 32 * mi + c;
            pre.w[mi] = lw[pw < cnt ? pw : cnt - 1];
#pragma unroll
            for (int p = 0; p < 4; ++p) { const int pr = r0 + 32 * MI * wm + 32 * mi + ((lane + 64 * p) >> 3); pre.tk[mi][p] = ltok[pr < cnt ? pr : cnt - 1]; }
        }
    }
    template <int MI> DI void epi(f32x16 (&)[2][MI], const Pre<MI>&, int, int, int, int) const {}
    template <int MI> DI void epi_lds(f32x16 (&acc)[2][MI], const Pre<MI>& pre, int wm, int wn, int c, int h, LAS unsigned char* wl) const {
        const int lane = c + 32 * h;
#pragma unroll
        for (int mi = 0; mi < MI; ++mi) {
            const float w = pre.w[mi];
#pragma unroll
            for (int ni = 0; ni < 2; ++ni)
#pragma unroll
                for (int g = 0; g < 4; ++g) {
                    u32x2 o; o.x = pk2(w * acc[ni][mi][4 * g], w * acc[ni][mi][4 * g + 1]); o.y = pk2(w * acc[ni][mi][4 * g + 2], w * acc[ni][mi][4 * g + 3]);
                    *(LAS u32x2*)(wl + c * 144 + (32 * ni + 8 * g + 4 * h) * 2) = o;
                }
            asm volatile("s_waitcnt lgkmcnt(0)" ::: "memory");
#pragma unroll
            for (int p = 0; p < 4; ++p) {
                const int q = lane + 64 * p, row = q >> 3;
                const u32x4 v = *(LAS u32x4*)(wl + row * 144 + (q & 7) * 16);
                if (r0 + 32 * MI * wm + 32 * mi + row < cnt) *(u32x4*)(yp + (size_t)pre.tk[mi][p] * D + n0 + 64 * wn + 8 * (q & 7)) = v;
            }
            asm volatile("s_waitcnt lgkmcnt(0)" ::: "memory");
        }
    }
};

DI void transpose_tile(const float* W, int K, int N, bf16* Wt, int tile, LAS float* scr, int tid) {
    const int ntn = N / 64, k0 = (tile / ntn) * 64, n0 = (tile % ntn) * 64;
#pragma unroll 4
    for (int i = 0; i < 16; ++i) { const int kk = (tid >> 6) + 4 * i; scr[kk * 65 + (tid & 63)] = W[(size_t)(k0 + kk) * N + n0 + (tid & 63)]; }
    __syncthreads();
#pragma unroll
    for (int i = 0; i < 2; ++i) {
        const int q = tid + 256 * i, n = q >> 3, kc = q & 7;
        const LAS float* s = scr + (8 * kc) * 65 + n;
        u32x4 o; o.x = pk2(s[0], s[65]); o.y = pk2(s[2 * 65], s[3 * 65]); o.z = pk2(s[4 * 65], s[5 * 65]); o.w = pk2(s[6 * 65], s[7 * 65]);
        *(u32x4*)(Wt + (size_t)(n0 + n) * K + k0 + 8 * kc) = o;
    }
    __syncthreads();
}

DI f32x16 qk_tile(const bf16x8 (&qf)[4], const bf16* kp) {
    f32x16 s;
#pragma unroll
    for (int i = 0; i < 16; ++i) s[i] = 0.f;
    bf16x8 kf[4];
#pragma unroll
    for (int s4 = 0; s4 < 4; ++s4) kf[s4] = ldg8(kp + 16 * s4);
#pragma unroll
    for (int s4 = 0; s4 < 4; ++s4) s = MFMA(kf[s4], qf[s4], s);
    return s;
}
constexpr float RS_THR = 6.0f;
template <bool RAW>
DI bool softmax_tile(f32x16& s, float& m, float& l, float& alpha, bf16x8 (&pf)[2]) {
    float mx = s[0];
#pragma unroll
    for (int i = 1; i < 16; ++i) mx = fmaxf(mx, s[i]);
    mx = fmaxf(mx, __shfl_xor(mx, 32));
    if (RAW) mx *= SM_C;
    const bool resc = !__all(mx <= m + RS_THR);
    alpha = 1.f;
    if (resc) { const float mn = fmaxf(m, mx); alpha = fexp2(m - mn); m = mn; }
    float ps = 0.f;
#pragma unroll
    for (int i = 0; i < 16; ++i) { s[i] = RAW ? fexp2(__builtin_fmaf(s[i], SM_C, -m)) : fexp2(s[i] - m); ps += s[i]; }
    l = l * alpha + ps;
#pragma unroll
    for (int k2 = 0; k2 < 2; ++k2) {
        u32x4 w; w.x = pk2(s[8 * k2], s[8 * k2 + 1]); w.y = pk2(s[8 * k2 + 2], s[8 * k2 + 3]); w.z = pk2(s[8 * k2 + 4], s[8 * k2 + 5]); w.w = pk2(s[8 * k2 + 6], s[8 * k2 + 7]);
        pf[k2] = __builtin_bit_cast(bf16x8, w);
    }
    return resc;
}
template <int NDB>
DI void pv_tile(f32x16 (&O)[NDB], const bf16x8 (&pf)[2], const bf16* vp, float alpha) {
    bf16x8 vf[NDB][2];
#pragma unroll
    for (int db = 0; db < NDB; ++db)
#pragma unroll
        for (int k2 = 0; k2 < 2; ++k2) vf[db][k2] = ldg8(vp + (size_t)db * 32 * TPB + 16 * k2);
#pragma unroll
    for (int db = 0; db < NDB; ++db) {
#pragma unroll
        for (int i = 0; i < 16; ++i) O[db][i] *= alpha;
#pragma unroll
        for (int k2 = 0; k2 < 2; ++k2) O[db] = MFMA(vf[db][k2], pf[k2], O[db]);
    }
}
template <int NDB>
DI void store_o(const f32x16 (&O)[NDB], float inv, bf16* orow, int h) {
#pragma unroll
    for (int db = 0; db < NDB; ++db)
#pragma unroll
        for (int g = 0; g < 4; ++g) {
            u32x2 w; w.x = pk2(O[db][4 * g] * inv, O[db][4 * g + 1] * inv); w.y = pk2(O[db][4 * g + 2] * inv, O[db][4 * g + 3] * inv);
            *(u32x2*)(orow + 32 * db + 8 * g + 4 * h) = w;
        }
}

DI unsigned swz128(int row, int ch) { return (unsigned)(row * 128 + ((ch ^ ((row >> 1) & 7)) << 4)); }

template <bool RAW>
DI bool softmax_tile2(f32x16& sa, f32x16& sb, float& m, float& l, float& alpha, bf16x8 (&pf)[4]) {
    float mx = fmaxf(sa[0], sb[0]);
#pragma unroll
    for (int i = 1; i < 16; ++i) mx = fmaxf(mx, fmaxf(sa[i], sb[i]));
    mx = fmaxf(mx, __shfl_xor(mx, 32));
    if (RAW) mx *= SM_C;
    const bool resc = !__all(mx <= m + RS_THR);
    alpha = 1.f;
    if (resc) { const float mn = fmaxf(m, mx); alpha = fexp2(m - mn); m = mn; }
    float ps = 0.f;
#pragma unroll
    for (int i = 0; i < 16; ++i) {
        sa[i] = RAW ? fexp2(__builtin_fmaf(sa[i], SM_C, -m)) : fexp2(sa[i] - m);
        sb[i] = RAW ? fexp2(__builtin_fmaf(sb[i], SM_C, -m)) : fexp2(sb[i] - m);
        ps += sa[i] + sb[i];
    }
    l = l * alpha + ps;
#pragma unroll
    for (int k2 = 0; k2 < 2; ++k2) {
        u32x4 w; w.x = pk2(sa[8 * k2], sa[8 * k2 + 1]); w.y = pk2(sa[8 * k2 + 2], sa[8 * k2 + 3]); w.z = pk2(sa[8 * k2 + 4], sa[8 * k2 + 5]); w.w = pk2(sa[8 * k2 + 6], sa[8 * k2 + 7]);
        pf[k2] = __builtin_bit_cast(bf16x8, w);
        u32x4 v; v.x = pk2(sb[8 * k2], sb[8 * k2 + 1]); v.y = pk2(sb[8 * k2 + 2], sb[8 * k2 + 3]); v.z = pk2(sb[8 * k2 + 4], sb[8 * k2 + 5]); v.w = pk2(sb[8 * k2 + 6], sb[8 * k2 + 7]);
        pf[2 + k2] = __builtin_bit_cast(bf16x8, v);
    }
    return resc;
}

DI void attn_block_nasw(const Ctx& cx, int kind, int layer, bool need_ctx, int vbid) {
    const int tid = cx.tid, lane = cx.lane, w = cx.wave, c = lane & 31, h = lane >> 5;
    const int kw = (kind == 0) ? D : 256, vw = kw;
    const int n_lat = 2048, n_tasks = n_lat + (need_ctx ? 256 : 0);
    const float* rpb = cx.rpbp() + (size_t)(layer / 3) * 16 * 512;
    const float* sinks = cx.in(17);
    const int srow = tid >> 3, sch = (tid & 7) ^ ((srow >> 1) & 7);
    const int pr = pi32(c);
    const unsigned xk = (pr >> 1) & 7, xv = (c >> 1) & 7;
    LAS float* rpbs = (LAS float*)(cx.lds + 49152);
    LAS unsigned char* qreg = cx.lds + 51200 + w * 4096 + lane * 16;
    for (int base_ = 0; base_ < n_tasks; base_ += gridDim.x) {
        const int task = base_ + ((base_ + (int)gridDim.x <= n_tasks) ? vbid : (int)blockIdx.x);
        if (task >= n_tasks) break;
        int b, kmap, head, tq0, nt, rlo = 0, r0w = 0, rg = 0, qh = 0, p0 = 0, kb_lo = 0;
        const bool lat = task < n_lat;
        if (kind == 0) {
            if (lat) {
                const int rp = task & 15; head = (task >> 4) & 15; b = task >> 8; rg = 2 * rp + (c >> 4); qh = 0;
                tq0 = b * TPB + CTX + rg * 64 + 16 * w + (c & 15) - c;
                int a0 = 2 * rp - 4; a0 = a0 < 0 ? 0 : (a0 > 24 ? 24 : a0);
                int a1 = 2 * rp - 3; a1 = a1 < 0 ? 0 : (a1 > 24 ? 24 : a1);
                rlo = a0; nt = 4 + (a1 + 8 - a0); r0w = (c >> 4) ? a1 : a0;
            } else { const int u = task - n_lat; const int qb = u & 1; head = (u >> 1) & 15; b = u >> 5; tq0 = b * TPB + qb * 128 + w * 32; nt = 4; }
            kmap = head;
        } else {
            if (lat) {
                const int qb = task & 63; kmap = (task >> 6) & 3; b = task >> 8; p0 = qb * 32; tq0 = b * TPB + CTX + p0;
                int lo = p0 - 128; lo = lo < 0 ? 0 : lo; kb_lo = lo & ~63;
                int hi = p0 + 160; hi = hi > SEQ ? SEQ : hi; hi = (hi + 63) & ~63; nt = 4 + (hi - kb_lo) / 64;
            } else { const int u = task - n_lat; const int qb = u & 7; kmap = (u >> 3) & 3; b = u >> 5; tq0 = b * TPB + qb * 32; nt = 4; }
            head = kmap * 4 + w;
        }
#define KEY0(it) ((it) < 4 ? 64 * (it) : (kind == 0 ? CTX + (rlo + (it) - 4) * 64 : CTX + kb_lo + ((it) - 4) * 64))
        const bf16* kg = cx.K() + (size_t)(b * TPB + srow) * kw + kmap * 64 + sch * 8;
        const bf16* vg = cx.VT() + ((size_t)b * vw + kmap * 64 + srow) * TPB + sch * 8;
#define A_LOAD(it, buf) do { const int k0_ = KEY0(it); LAS unsigned char* b_ = cx.lds + (buf) * 16384 + tid * 16; \
                        glds16(kg + (size_t)k0_ * kw, b_); glds16(kg + (size_t)(k0_ + 32) * kw, b_ + 4096); \
                        glds16(vg + k0_, b_ + 8192); glds16(vg + (size_t)32 * TPB + k0_, b_ + 8192 + 4096); } while (0)
        __syncthreads();
        float m = NEG, l = 0.f;
        if (kind == 2) { m = sinks[head] * LOG2E; l = (h == 0) ? 1.f : 0.f; asm volatile("" : "+v"(m)); }
        { const bf16* qp = cx.Q() + (size_t)(tq0 + c) * D + head * 64 + 8 * h;
#pragma unroll
          for (int s4 = 0; s4 < 4; ++s4) glds16(qp + 16 * s4, qreg + s4 * 1024); }
        if (kind == 0 && lat && tid < 128) glds16(rpb + head * 512 + tid * 4, (LAS unsigned char*)rpbs + tid * 16);
#pragma unroll
        for (int s = 0; s < 2; ++s) if (s < nt) A_LOAD(s, s);
        f32x16 O[2];
#pragma unroll
        for (int db = 0; db < 2; ++db)
#pragma unroll
            for (int i = 0; i < 16; ++i) O[db][i] = 0.f;
        const int qc = 16 * w + (c & 15); int c0 = qc - 8; c0 = c0 < 0 ? 0 : (c0 > 48 ? 48 : c0);
        int kbase = 16 * w - 8; kbase = kbase < 0 ? 0 : (kbase > 32 ? 32 : kbase);
        const unsigned xkn = ((kbase + pr) >> 1) & 7;
        const int qpos = p0 + c;
        bf16x8 qf[4];
        int stg = 0, istg = 2;
#pragma unroll 1
        for (int it = 0; it < nt; ++it) {
            if (it + 1 < nt) asm volatile("s_waitcnt vmcnt(4)" ::: "memory");
            else asm volatile("s_waitcnt vmcnt(0)" ::: "memory");
            __builtin_amdgcn_s_barrier();
            asm volatile("" ::: "memory");
            if (it + 2 < nt) A_LOAD(it + 2, istg);
            __builtin_amdgcn_sched_barrier(0);
            if (it == 0) {
#pragma unroll
                for (int s4 = 0; s4 < 4; ++s4) qf[s4] = *(LAS bf16x8*)(qreg + s4 * 1024);
            }
            LAS unsigned char* kb = cx.lds + stg * 16384; LAS unsigned char* vb = kb + 8192;
            if (kind == 0 && it >= 4) {
                const int ry = rlo + it - 4;
                f32x16 sa;
#pragma unroll
                for (int i = 0; i < 16; ++i) sa[i] = 0.f;
#pragma unroll
                for (int s4 = 0; s4 < 4; ++s4) {
                    const bf16x8 ka = *(LAS bf16x8*)(kb + (kbase + pr) * 128 + (((2 * s4 + h) ^ xkn) << 4));
                    sa = MFMA(ka, qf[s4], sa);
                }
                const bool rowok = (ry >= r0w) && (ry <= r0w + 7);
                int dyi = ry - rg + 7; dyi = dyi < 0 ? 0 : (dyi > 14 ? 14 : dyi);
                const LAS float* rrow = rpbs + dyi * 31;
                int dwin = rowok ? (kbase + 8 * h - c0) : 0x40000000;
                int dci = kbase + 8 * h - qc + 15;
                asm volatile("" : "+v"(dwin), "+v"(dci));
#pragma unroll
                for (int i = 0; i < 16; ++i) {
                    const int off = (i & 7) + 16 * (i >> 3);
                    int ci = dci + off; ci = ci < 0 ? 0 : (ci > 30 ? 30 : ci);
                    const bool ok = (unsigned)(dwin + off) < 16u;
                    sa[i] = ok ? __builtin_fmaf(sa[i], SM_C, rrow[ci]) : NEG;
                }
                float alpha; bf16x8 pf[2];
                const bool resc = softmax_tile<false>(sa, m, l, alpha, pf);
                if (resc) {
#pragma unroll
                    for (int db = 0; db < 2; ++db)
#pragma unroll
                        for (int i = 0; i < 16; ++i) O[db][i] *= alpha;
                }
                const int kb8 = kbase >> 3;
#pragma unroll
                for (int db = 0; db < 2; ++db)
#pragma unroll
                    for (int k2 = 0; k2 < 2; ++k2) {
                        const bf16x8 vf = *(LAS bf16x8*)(vb + (32 * db + c) * 128 + (((kb8 + 2 * k2 + h) ^ xv) << 4));
                        O[db] = MFMA(vf, pf[k2], O[db]);
                    }
            } else {
                f32x16 sa, sb;
#pragma unroll
                for (int i = 0; i < 16; ++i) { sa[i] = 0.f; sb[i] = 0.f; }
#pragma unroll
                for (int s4 = 0; s4 < 4; ++s4) {
                    const unsigned co = (unsigned)(((2 * s4 + h) ^ xk) << 4);
                    const bf16x8 ka = *(LAS bf16x8*)(kb + pr * 128 + co), kb2 = *(LAS bf16x8*)(kb + (32 + pr) * 128 + co);
                    sa = MFMA(ka, qf[s4], sa); sb = MFMA(kb2, qf[s4], sb);
                }
                bool resc; float alpha; bf16x8 pf[4];
                if (it < 4) {
                    resc = softmax_tile2<true>(sa, sb, m, l, alpha, pf);
                } else {
                    const int kb0 = kb_lo + (it - 4) * 64;
                    if (kb0 < p0 - 97 || kb0 > p0 + 65) {
                        int dq = kb0 + 8 * h - qpos + 128; asm volatile("" : "+v"(dq));
#pragma unroll
                        for (int i = 0; i < 16; ++i) {
                            const int off = (i & 7) + 16 * (i >> 3);
                            sa[i] = ((unsigned)(dq + off) <= 256u) ? sa[i] : NEG;
                            sb[i] = ((unsigned)(dq + off + 32) <= 256u) ? sb[i] : NEG;
                        }
                    }
                    resc = softmax_tile2<true>(sa, sb, m, l, alpha, pf);
                }
                if (resc) {
#pragma unroll
                    for (int db = 0; db < 2; ++db)
#pragma unroll
                        for (int i = 0; i < 16; ++i) O[db][i] *= alpha;
                }
#pragma unroll
                for (int db = 0; db < 2; ++db) {
#pragma unroll
                    for (int k4 = 0; k4 < 4; ++k4) {
                        const bf16x8 vf = *(LAS bf16x8*)(vb + (32 * db + c) * 128 + (((2 * k4 + h) ^ xv) << 4));
                        O[db] = MFMA(vf, pf[k4], O[db]);
                    }
                }
            }
            asm volatile("" ::: "memory");
            stg = (stg == 2) ? 0 : stg + 1; istg = (istg == 2) ? 0 : istg + 1;
        }
#undef KEY0
#undef A_LOAD
        l += __shfl_xor(l, 32);
        store_o<2>(O, 1.f / l, cx.O() + (size_t)(tq0 + c) * D + head * 64, h);
    }
}

DI void attn_block_da(const Ctx& cx, int layer, bool need_ctx, int vbid) {
    const int tid = cx.tid, lane = cx.lane, w = cx.wave, c = lane & 31, h = lane >> 5;
    const int n_lat = NB * 8 * 16, n_tasks = n_lat + (need_ctx ? NB * 8 * 2 : 0);
    const float* lp = cx.in(13);
    const float d1 = wave_sum(lp[lane] * lp[64 + lane]), d2 = wave_sum(lp[128 + lane] * lp[192 + lane]);
    const float lam_init = 0.8f - 0.6f * __expf(-0.3f * (float)layer);
    const float lam = __expf(d1) - __expf(d2) + lam_init;
    const float* sg = cx.in(14);
    const int krow = tid >> 3, kch = (tid & 7) ^ ((krow >> 1) & 7), vdim = tid >> 2, vch = (tid & 3) ^ ((vdim >> 2) & 3);
    const int pr = pi32(c);
    const unsigned xk = (pr >> 1) & 7, xv = (c >> 2) & 3;
    LAS unsigned char* qlds = cx.lds + 49152 + w * 4096 + lane * 16;
    for (int base_ = 0; base_ < n_tasks; base_ += gridDim.x) {
        const int task = base_ + ((base_ + (int)gridDim.x <= n_tasks) ? vbid : (int)blockIdx.x);
        if (task >= n_tasks) break;
        int b, head, tq0, nt;
        if (task < n_lat) { const int qb = task & 15; head = (task >> 4) & 7; b = task >> 7; tq0 = b * TPB + CTX + qb * 128 + w * 32; nt = TPB / 32; }
        else { const int u = task - n_lat; const int qb = u & 1; head = (u >> 1) & 7; b = u >> 4; tq0 = b * TPB + qb * 128 + w * 32; nt = CTX / 32; }
        const bf16* kg = cx.K() + (size_t)(b * TPB + krow) * D + head * 128 + kch * 8;
        const bf16* vg = cx.VT() + ((size_t)b * D + head * 128 + vdim) * TPB + vch * 8;
#define D_LOAD(it, buf) do { const int k0_ = 32 * (it); LAS unsigned char* b_ = cx.lds + (buf) * 16384 + tid * 16; \
                        glds16(kg + (size_t)k0_ * D, b_); glds16(kg + (size_t)k0_ * D + 64, b_ + 4096); \
                        glds16(vg + k0_, b_ + 8192); glds16(vg + (size_t)64 * TPB + k0_, b_ + 8192 + 4096); } while (0)
        __syncthreads();
        bf16x8 q1f[4];
        { const bf16* qp = cx.Q() + (size_t)(tq0 + c) * D + head * 128 + 8 * h;
#pragma unroll
          for (int s4 = 0; s4 < 4; ++s4) q1f[s4] = ldg8(qp + 64 + 16 * s4);
#pragma unroll
          for (int s4 = 0; s4 < 4; ++s4) asm volatile("" : "+v"(q1f[s4]));
#pragma unroll
          for (int s4 = 0; s4 < 4; ++s4) glds16(qp + 16 * s4, qlds + s4 * 1024); }
#pragma unroll
        for (int s = 0; s < 2; ++s) if (s < nt) D_LOAD(s, s);
        float m0 = NEG, l0 = 0.f, m1 = NEG, l1 = 0.f;
        f32x16 O0[4], O1[4];
#pragma unroll
        for (int db = 0; db < 4; ++db)
#pragma unroll
            for (int i = 0; i < 16; ++i) { O0[db][i] = 0.f; O1[db][i] = 0.f; }
        int stg = 0, istg = 2;
#pragma unroll 1
        for (int it = 0; it < nt; ++it) {
            if (it + 1 < nt) asm volatile("s_waitcnt vmcnt(4)" ::: "memory");
            else asm volatile("s_waitcnt vmcnt(0)" ::: "memory");
            __builtin_amdgcn_s_barrier();
            asm volatile("" ::: "memory");
            if (it + 2 < nt) D_LOAD(it + 2, istg);
            __builtin_amdgcn_sched_barrier(0);
            __builtin_amdgcn_iglp_opt(IGLP_ATT);
            LAS unsigned char* kb = cx.lds + stg * 16384; LAS unsigned char* vb = kb + 8192;
            f32x16 s0, s1;
#pragma unroll
            for (int i = 0; i < 16; ++i) { s0[i] = 0.f; s1[i] = 0.f; }
#pragma unroll
            for (int s4 = 0; s4 < 4; ++s4) {
                const unsigned co = (unsigned)(((2 * s4 + h) ^ xk) << 4);
                const bf16x8 k0f = *(LAS bf16x8*)(kb + pr * 128 + co), q0f = *(LAS bf16x8*)(qlds + s4 * 1024);
                s0 = MFMA(k0f, q0f, s0);
            }
#pragma unroll
            for (int s4 = 0; s4 < 4; ++s4) {
                const unsigned co = (unsigned)(((2 * s4 + h) ^ xk) << 4);
                const bf16x8 k1f = *(LAS bf16x8*)(kb + 4096 + pr * 128 + co);
                s1 = MFMA(k1f, q1f[s4], s1);
            }
            __builtin_amdgcn_sched_barrier(0);
            float a0; bf16x8 pf0[2];
            const bool r0 = softmax_tile<true>(s0, m0, l0, a0, pf0);
            float a1; bf16x8 pf1[2];
            const bool r1 = softmax_tile<true>(s1, m1, l1, a1, pf1);
            if (r0 || r1) {
#pragma unroll
                for (int db = 0; db < 4; ++db)
#pragma unroll
                    for (int i = 0; i < 16; ++i) { O0[db][i] *= a0; O1[db][i] *= a1; }
            }
            __builtin_amdgcn_s_setprio(1);
#pragma unroll
            for (int db = 0; db < 4; ++db) {
                bf16x8 vf[2];
#pragma unroll
                for (int k2 = 0; k2 < 2; ++k2) vf[k2] = *(LAS bf16x8*)(vb + (32 * db + c) * 64 + (((2 * k2 + h) ^ xv) << 4));
#pragma unroll
                for (int k2 = 0; k2 < 2; ++k2) { O0[db] = MFMA(vf[k2], pf0[k2], O0[db]); O1[db] = MFMA(vf[k2], pf1[k2], O1[db]); }
            }
            __builtin_amdgcn_s_setprio(0);
            asm volatile("" ::: "memory");
            stg = (stg == 2) ? 0 : stg + 1; istg = (istg == 2) ? 0 : istg + 1;
        }
#undef D_LOAD
        l0 += __shfl_xor(l0, 32); l1 += __shfl_xor(l1, 32);
        const int lane_e = __builtin_amdgcn_mbcnt_hi(~0u, __builtin_amdgcn_mbcnt_lo(~0u, 0u));
        const int c_e = lane_e & 31, h_e = lane_e >> 5;
        const float i0 = 1.f / l0, i1 = lam / l1;
        float ss = 0.f;
#pragma unroll
        for (int db = 0; db < 4; ++db)
#pragma unroll
            for (int i = 0; i < 16; ++i) { const float o = O0[db][i] * i0 - O1[db][i] * i1; O0[db][i] = o; ss += o * o; }
        ss += __shfl_xor(ss, 32);
        const float rn = rsqrtf(ss * (1.f / 128.f) + EPS) * (1.f - lam_init);
        bf16* orow = cx.O() + (size_t)(tq0 + c_e) * D + head * 128;
#pragma unroll
        for (int db = 0; db < 4; ++db)
#pragma unroll
            for (int g = 0; g < 4; ++g) {
                const int dim = 32 * db + 8 * g + 4 * h_e;
                const f32x4 gg = *(const f32x4*)(sg + dim);
                u32x2 wv; wv.x = pk2(O0[db][4 * g] * rn * gg[0], O0[db][4 * g + 1] * rn * gg[1]); wv.y = pk2(O0[db][4 * g + 2] * rn * gg[2], O0[db][4 * g + 3] * rn * gg[3]);
                *(u32x2*)(orow + dim) = wv;
            }
    }
}

DI void load_row(const float* row, f32x4 (&v)[4], int lane) {
#pragma unroll
    for (int j = 0; j < 4; ++j) v[j] = ((const f32x4*)row)[lane + 64 * j];
}
DI void load_row_bf16(const bf16* row, f32x4 (&v)[4], int lane) {
#pragma unroll
    for (int j = 0; j < 4; ++j) { const u32x2 a = ((const u32x2*)row)[lane + 64 * j];
        v[j][0] = __builtin_bit_cast(float, a.x << 16); v[j][1] = __builtin_bit_cast(float, a.x & 0xffff0000u);
        v[j][2] = __builtin_bit_cast(float, a.y << 16); v[j][3] = __builtin_bit_cast(float, a.y & 0xffff0000u); }
}
DI void norm_mod(f32x4 (&v)[4], const float* g, const float* sh, const float* sc, int lane) {
    float ss = 0.f;
#pragma unroll
    for (int j = 0; j < 4; ++j) ss += (v[j][0] * v[j][0] + v[j][1] * v[j][1]) + (v[j][2] * v[j][2] + v[j][3] * v[j][3]);
    const float rn = rsqrtf(wave_sum(ss) * (1.f / D) + EPS);
#pragma unroll
    for (int j = 0; j < 4; ++j) {
        const f32x4 gg = ((const f32x4*)g)[lane + 64 * j], s1 = ((const f32x4*)sc)[lane + 64 * j], s0 = ((const f32x4*)sh)[lane + 64 * j];
#pragma unroll
        for (int e = 0; e < 4; ++e) v[j][e] = (v[j][e] * rn * gg[e]) * (1.f + s1[e]) + s0[e];
    }
}
DI void store_row_bf16(bf16* row, const f32x4 (&v)[4], int lane) {
#pragma unroll
    for (int j = 0; j < 4; ++j) { u32x2 w; w.x = pk2(v[j][0], v[j][1]); w.y = pk2(v[j][2], v[j][3]); ((u32x2*)row)[lane + 64 * j] = w; }
}

struct ConvTask { const float* src; bf16* dst; int N, K; };
DI ConvTask prologue_task(const Ctx& cx, int item, int lane) {
    const int layer = item < 2048 ? 0 : (item < 4096 ? 1 : (item < 5376 ? 2 : 3));
    const int u = item - (layer == 0 ? 0 : (layer == 1 ? 2048 : (layer == 2 ? 4096 : 5376)));
    const int kind = layer % 3, NQ = (kind == 2) ? 1536 : 3072, nq = 16 * (NQ / 32);
    const float* W; bf16* WT; int N, kt, nt;
    if (u < nq) { W = (kind == 0) ? cx.in(9) + (size_t)(layer / 3) * D * 3072 : (kind == 1 ? cx.in(12) : cx.in(16)); WT = cx.wqkv(layer); N = NQ; kt = u / (NQ / 32); nt = u - kt * (NQ / 32); }
    else { const int v = u - nq; W = (kind == 0) ? cx.in(11) + (size_t)(layer / 3) * D * D : (kind == 1 ? cx.in(15) : cx.in(18)); WT = cx.wo(layer); N = D; kt = v >> 5; nt = v & 31; }
    ConvTask t;
    t.src = W + (size_t)(kt * 64 + (lane >> 3)) * N + nt * 32 + (lane & 7) * 4;
    t.dst = WT + (size_t)(nt * 32 + (lane >> 3)) * D + kt * 64 + (lane & 7) * 8;
    t.N = N; t.K = D;
    return t;
}
constexpr int PRO_NT = 7424;
DI void prologue_convert(const Ctx& cx, int first, int stride) {
    const int lane = cx.lane;
    LAS float* scr = (LAS float*)(cx.lds + 36864) + cx.wave * (64 * 33);
#define PV_LOAD(X, task) do { const ConvTask ct_ = prologue_task(cx, (task), lane); \
        _Pragma("unroll") for (int p = 0; p < 8; ++p) X[p] = *(const f32x4*)(ct_.src + (size_t)(8 * p) * ct_.N); } while (0)
#define PV_PROC(X, task) do { const ConvTask ct_ = prologue_task(cx, (task), lane); \
        _Pragma("unroll") for (int p = 0; p < 8; ++p) { LAS float* d = scr + ((lane >> 3) + 8 * p) * 33 + (lane & 7) * 4; d[0] = X[p][0]; d[1] = X[p][1]; d[2] = X[p][2]; d[3] = X[p][3]; } \
        asm volatile("s_waitcnt lgkmcnt(0)" ::: "memory"); \
        _Pragma("unroll") for (int p = 0; p < 4; ++p) { const LAS float* s = scr + ((lane & 7) * 8) * 33 + (lane >> 3) + 8 * p; \
            u32x4 o; o.x = pk2(s[0], s[33]); o.y = pk2(s[2 * 33], s[3 * 33]); o.z = pk2(s[4 * 33], s[5 * 33]); o.w = pk2(s[6 * 33], s[7 * 33]); \
            *(u32x4*)(ct_.dst + (size_t)(8 * p) * ct_.K) = o; } \
        asm volatile("s_waitcnt lgkmcnt(0)" ::: "memory"); } while (0)
    f32x4 xa[8], xb[8];
    int task = first;
    if (task < PRO_NT) PV_LOAD(xa, task);
#pragma unroll 1
    while (task < PRO_NT) {
        const int t2 = task + stride, t3 = t2 + stride;
        if (t2 < PRO_NT) PV_LOAD(xb, t2);
        PV_PROC(xa, task);
        if (t3 < PRO_NT) PV_LOAD(xa, t3);
        if (t2 < PRO_NT) PV_PROC(xb, t2);
        task = t3;
    }
#undef PV_LOAD
#undef PV_PROC
}

DI void phase_prologue(const Ctx& cx) {
    LAS float* condS = (LAS float*)cx.lds;
    const float* cin = cx.in(1); const float* cctx = cx.in(3);
    for (int i = cx.tid; i < 9 * 1024; i += NTHREADS) { const int rr = i >> 10, k = i & 1023; const float v = (rr < 8) ? cin[rr * 1024 + k] : cctx[k]; condS[i] = silu(v); }
    __syncthreads();
    const float* ada_w = cx.in(4); const float* ada_b = cx.in(5);
    LAS float* red16 = (LAS float*)(cx.lds + 9 * 1024 * 4);
    for (int task = blockIdx.x; task < 4 * 96; task += gridDim.x) {
        const int layer = task / 96, cc = task % 96, r = cx.lane >> 4, cq = cx.lane & 15;
        const float* W = ada_w + (size_t)layer * D * 6144 + cc * 64 + 4 * cq;
        float acc[9][4];
#pragma unroll
        for (int rr = 0; rr < 9; ++rr)
#pragma unroll
            for (int e = 0; e < 4; ++e) acc[rr][e] = 0.f;
        const int k0 = cx.wave * 256 + r;
#pragma unroll 1
        for (int kb = 0; kb < 256; kb += 64) {
            f32x4 wv[16];
#pragma unroll
            for (int i = 0; i < 16; ++i) wv[i] = *(const f32x4*)(W + (size_t)(k0 + kb + 4 * i) * 6144);
#pragma unroll
            for (int i = 0; i < 16; ++i) {
#pragma unroll
                for (int rr = 0; rr < 9; ++rr) { const float cv = condS[rr * 1024 + k0 + kb + 4 * i];
#pragma unroll
                    for (int e = 0; e < 4; ++e) acc[rr][e] += cv * wv[i][e]; }
            }
        }
#pragma unroll
        for (int rr = 0; rr < 9; ++rr) *(LAS f32x4*)(red16 + ((cx.wave * 4 + r) * 9 + rr) * 64 + 4 * cq) = f32x4{acc[rr][0], acc[rr][1], acc[rr][2], acc[rr][3]};
        __syncthreads();
        for (int i = cx.tid; i < 9 * 64; i += NTHREADS) {
            const int rr = i >> 6, ln = i & 63;
            float s = 0.f;
#pragma unroll
            for (int g = 0; g < 16; ++g) s += red16[(g * 9 + rr) * 64 + ln];
            cx.mod()[((size_t)layer * 9 + rr) * 6144 + cc * 64 + ln] = s + ada_b[layer * 6144 + cc * 64 + ln];
        }
        __syncthreads();
    }
    {
        const int ng = (4 * 96 < (int)gridDim.x) ? 4 * 96 : (int)gridDim.x;
        const int nslots = ng * 4 + ((int)gridDim.x - ng) * 4 * 3;
        const int gw = blockIdx.x * 4 + cx.wave;
        if ((int)blockIdx.x < ng) prologue_convert(cx, gw, nslots);
        else { const int s0 = ng * 4 + (gw - ng * 4) * 3; prologue_convert(cx, s0, nslots); prologue_convert(cx, s0 + 1, nslots); prologue_convert(cx, s0 + 2, nslots); }
    }
    {
        bf16* wr = cx.wr();
        for (int i = blockIdx.x * NTHREADS + cx.tid; i < DEPTH * D * 64; i += gridDim.x * NTHREADS) {
            const int rho = i & 63, k = (i >> 6) & 1023, layer = i >> 16;
            float v = 0.f;
            if (rho < 32) v = cx.in(21)[((size_t)layer * D + k) * 32 + rho];
            else if (rho < 36) v = cx.in(19)[((size_t)layer * D + k) * 4 + (rho - 32)];
            const unsigned hi = pk2(v, 0.f) & 0xffffu;
            const unsigned lo = pk2(v - bf2f((unsigned short)hi), 0.f) & 0xffffu;
            wr[((size_t)(layer * 2 + 0) * 64 + rho) * D + k] = (bf16)hi;
            wr[((size_t)(layer * 2 + 1) * 64 + rho) * D + k] = (bf16)lo;
        }
    }
    if (blockIdx.x == gridDim.x - 2) {
        for (int i = cx.tid; i < 2 * 16 * 512; i += NTHREADS) { const int s = i >> 9, e = i & 511; cx.rpbp()[i] = (e < 465) ? cx.in(10)[s * 465 + e] * LOG2E : 0.f; }
    }
    if (blockIdx.x == gridDim.x - 1) {
        for (int i = cx.tid; i < 64 * 16; i += NTHREADS) {
            const int pos = i >> 4, f = i & 15;
            const float tab4[4] = {1.f, 0.5623413251903491f, 0.31622776601683794f, 0.1778279410038923f};
            float inv = (f & 3) == 0 ? tab4[0] : ((f & 3) == 1 ? tab4[1] : ((f & 3) == 2 ? tab4[2] : tab4[3]));
            const int dec = f >> 2; inv *= (dec == 0 ? 1.f : (dec == 1 ? 0.1f : (dec == 2 ? 0.01f : 0.001f)));
            const float ang = (float)pos * inv;
            const double rev = (double)ang * 0.15915494309189535; const float fr = (float)(rev - (double)(long long)rev);
            cx.ropec()[i] = __builtin_amdgcn_cosf(fr); cx.ropes()[i] = __builtin_amdgcn_sinf(fr);
        }
    }
}

DI void phase_first_norm(const Ctx& cx) {
    const int gw = blockIdx.x * 4 + cx.wave, gstride = gridDim.x * 4;
    {
        for (int pair = (int)gridDim.x - 1 - (int)blockIdx.x; pair < DEPTH * 9; pair += (int)gridDim.x) {
            const int layer = pair / 9, row = pair % 9;
            const float* md = cx.mod() + ((size_t)layer * 9 + row) * 6144;
            const float* g = cx.in(7) + layer * D;
            float* gmo = cx.gm() + (size_t)pair * D;
            const float* wexp = cx.in(21) + (size_t)layer * D * 32; const float* wgrp = cx.in(19) + (size_t)layer * D * 4;
            float acc[36];
#pragma unroll
            for (int e = 0; e < 36; ++e) acc[e] = 0.f;
#pragma unroll
            for (int i = 0; i < 4; ++i) {
                const int k = cx.lane + 64 * (4 * cx.wave + i);
                gmo[k] = g[k] * (1.f + md[4096 + k]);
                const float sh = md[3072 + k];
                const f32x4* we = (const f32x4*)(wexp + (size_t)k * 32);
#pragma unroll
                for (int q = 0; q < 8; ++q) { const f32x4 w = we[q];
#pragma unroll
                    for (int e = 0; e < 4; ++e) acc[4 * q + e] += sh * w[e]; }
                const f32x4 wg = *(const f32x4*)(wgrp + (size_t)k * 4);
#pragma unroll
                for (int e = 0; e < 4; ++e) acc[32 + e] += sh * wg[e];
            }
#pragma unroll
            for (int e = 0; e < 36; ++e) acc[e] = wave_sum(acc[e]);
            LAS float* part = (LAS float*)cx.lds;
            if (cx.lane == 0) {
#pragma unroll
                for (int e = 0; e < 36; ++e) part[cx.wave * 36 + e] = acc[e];
            }
            __syncthreads();
            if (cx.tid < 36) {
                const float s = (part[cx.tid] + part[36 + cx.tid]) + (part[72 + cx.tid] + part[108 + cx.tid]);
                float* rco = cx.rc() + (size_t)pair * 64;
                rco[cx.tid] = s + (cx.tid < 32 ? cx.in(22)[layer * 32 + cx.tid] : cx.in(20)[layer * 4 + cx.tid - 32]);
            }
            __syncthreads();
        }
    }
#define P1_SRC(tt) ({ const int b_ = (tt) / TPB, j_ = (tt) - b_ * TPB; (j_ < CTX) ? cx.in(2) + (size_t)(b_ * CTX + j_) * D : cx.in(0) + (size_t)(b_ * SEQ + j_ - CTX) * D; })
    f32x4 nv[4];
    if (gw < T) load_row(P1_SRC(gw), nv, cx.lane);
    for (int t = gw; t < T; t += gstride) {
        const int b = t / TPB, j = t - b * TPB;
        f32x4 v[4];
#pragma unroll
        for (int q = 0; q < 4; ++q) v[q] = nv[q];
        if (t + gstride < T) load_row(P1_SRC(t + gstride), nv, cx.lane);
        store_row_bf16(cx.xres() + (size_t)t * D, v, cx.lane);
        const float* md = cx.mod() + (size_t)(j < CTX ? 8 : b) * 6144;
        norm_mod(v, cx.in(6), md, md + 1024, cx.lane);
        store_row_bf16(cx.H() + (size_t)t * D, v, cx.lane);
    }
#undef P1_SRC
}

DI void phase_norm_route(const Ctx& cx, int layer, bool last, bool dummy) {
    const int lane = cx.lane, c = lane & 31, h = lane >> 5, w = cx.wave;
    {
        int nhb = (T / 32) % (int)gridDim.x;
        if (4 * nhb >= (int)gridDim.x) nhb = 0;
        const int gw = ((int)blockIdx.x - nhb) * 4 + w, gstride = ((int)gridDim.x - nhb) * 4;
        for (int t = (gw < 0 ? T : gw); t < T; t += gstride) {
            const int b = t / TPB, j = t - b * TPB;
            if (last && j < CTX) continue;
            f32x4 v[4]; load_row_bf16(cx.xres() + (size_t)t * D, v, lane);
            const float* md = cx.mod() + ((size_t)layer * 9 + (j < CTX ? 8 : b)) * 6144;
            norm_mod(v, cx.in(7) + layer * D, md + 3072, md + 4096, lane);
            store_row_bf16(cx.H() + (size_t)t * D, v, lane);
        }
    }
    unsigned* cnt = cx.ctl() + CW_CNT + layer * 32 * 64 + (dummy ? 32 : 0);
    int* ltok_ = dummy ? (int*)cx.YP() : cx.ltok(); float* lw_ = dummy ? (float*)(cx.YP() + 4 * 1024 * 1024) : cx.lw();
    const bf16* whi = cx.wr() + (size_t)(layer * 2) * 64 * D + (size_t)c * D + 256 * w + 8 * h;
    LAS float* red = (LAS float*)cx.lds;
    LAS unsigned* hist = (LAS unsigned*)(cx.lds + 4 * 33 * 64 * 4);
    for (int task = blockIdx.x; task < T / 32; task += gridDim.x) {
        const int t0 = task * 32, b = t0 / TPB, j0 = t0 - b * TPB;
        if (last && j0 < CTX) continue;
        const int t = t0 + c, mrow = (j0 < CTX ? 8 : b);
        const bf16* xrow = cx.xres() + (size_t)t * D + 256 * w + 8 * h;
        const float* gmv = cx.gm() + ((size_t)layer * 9 + mrow) * D + 256 * w + 8 * h;
        float ss = 0.f;
        f32x16 acc0, acc1;
#pragma unroll
        for (int i = 0; i < 16; ++i) { acc0[i] = 0.f; acc1[i] = 0.f; }
        LAS unsigned char* park = cx.lds + w * 16384 + lane * 16;
#pragma unroll
        for (int s = 0; s < 16; ++s) glds16(xrow + 16 * s, park + s * 1024);
        asm volatile("s_waitcnt vmcnt(0)" ::: "memory");
#pragma unroll 4
        for (int s = 0; s < 16; ++s) {
            float x[8];
            { const u32x4 xq = *(LAS u32x4*)(park + s * 1024);
              const f32x4 a = {__builtin_bit_cast(float, xq.x << 16), __builtin_bit_cast(float, xq.x & 0xffff0000u), __builtin_bit_cast(float, xq.y << 16), __builtin_bit_cast(float, xq.y & 0xffff0000u)};
              const f32x4 bq = {__builtin_bit_cast(float, xq.z << 16), __builtin_bit_cast(float, xq.z & 0xffff0000u), __builtin_bit_cast(float, xq.w << 16), __builtin_bit_cast(float, xq.w & 0xffff0000u)};
              const f32x4 g0 = *(const f32x4*)(gmv + 16 * s), g1 = *(const f32x4*)(gmv + 16 * s + 4);
              ss += (a[0] * a[0] + a[1] * a[1]) + (a[2] * a[2] + a[3] * a[3]) + (bq[0] * bq[0] + bq[1] * bq[1]) + (bq[2] * bq[2] + bq[3] * bq[3]);
#pragma unroll
              for (int e = 0; e < 4; ++e) { x[e] = a[e] * g0[e]; x[4 + e] = bq[e] * g1[e]; } }
            u32x4 hi, lo;
            hi.x = pk2(x[0], x[1]); hi.y = pk2(x[2], x[3]); hi.z = pk2(x[4], x[5]); hi.w = pk2(x[6], x[7]);
            lo.x = pk2(x[0] - __builtin_bit_cast(float, hi.x << 16), x[1] - __builtin_bit_cast(float, hi.x & 0xffff0000u));
            lo.y = pk2(x[2] - __builtin_bit_cast(float, hi.y << 16), x[3] - __builtin_bit_cast(float, hi.y & 0xffff0000u));
            lo.z = pk2(x[4] - __builtin_bit_cast(float, hi.z << 16), x[5] - __builtin_bit_cast(float, hi.z & 0xffff0000u));
            lo.w = pk2(x[6] - __builtin_bit_cast(float, hi.w << 16), x[7] - __builtin_bit_cast(float, hi.w & 0xffff0000u));
            const bf16x8 bhi = __builtin_bit_cast(bf16x8, hi), blo = __builtin_bit_cast(bf16x8, lo);
            const bf16x8 ah0 = ldg8(whi + 16 * s), ah1 = ldg8(whi + 32 * D + 16 * s), al0 = ldg8(whi + 64 * D + 16 * s), al1 = ldg8(whi + 96 * D + 16 * s);
            acc0 = MFMA(ah0, bhi, acc0); acc0 = MFMA(al0, bhi, acc0); acc0 = MFMA(ah0, blo, acc0);
            acc1 = MFMA(ah1, bhi, acc1); acc1 = MFMA(al1, bhi, acc1); acc1 = MFMA(ah1, blo, acc1);
        }
        __syncthreads();
        LAS float* my = red + (size_t)w * 33 * 64 + lane;
#pragma unroll
        for (int i = 0; i < 16; ++i) { my[i * 64] = acc0[i]; my[(16 + i) * 64] = acc1[i]; }
        my[32 * 64] = ss;
        __syncthreads();
        if (w == 0) {
#pragma unroll
            for (int ww = 1; ww < 4; ++ww) {
                const LAS float* o = red + (size_t)ww * 33 * 64 + lane;
#pragma unroll
                for (int i = 0; i < 16; ++i) { acc0[i] += o[i * 64]; acc1[i] += o[(16 + i) * 64]; }
                ss += o[32 * 64];
            }
            ss += __shfl_xor(ss, 32);
            const float rn = rsqrtf(ss * (1.f / D) + EPS);
            const float* rcv = cx.rc() + ((size_t)layer * 9 + mrow) * 64;
            float gl[4];
#pragma unroll
            for (int g = 0; g < 4; ++g) gl[g] = __shfl(acc1[g], c) * rn + rcv[32 + g];
            int gi = 0; float gmx = gl[0];
#pragma unroll
            for (int g = 1; g < 4; ++g) if (gl[g] > gmx) { gmx = gl[g]; gi = g; }
            float gs = 0.f;
#pragma unroll
            for (int g = 0; g < 4; ++g) gs += __expf(gl[g] - gmx);
            const float gp = 1.f / gs;
            float mine[4], other[4], el[8];
#pragma unroll
            for (int e = 0; e < 4; ++e) {
                float xv = acc0[e];
#pragma unroll
                for (int g = 1; g < 4; ++g) xv = (gi == g) ? acc0[4 * g + e] : xv;
                mine[e] = xv * rn + rcv[gi * 8 + 4 * h + e];
            }
#pragma unroll
            for (int e = 0; e < 4; ++e) other[e] = __shfl_xor(mine[e], 32);
#pragma unroll
            for (int e = 0; e < 4; ++e) { el[e] = (h == 0) ? mine[e] : other[e]; el[4 + e] = (h == 0) ? other[e] : mine[e]; }
            int i1 = 0; float v1 = el[0];
#pragma unroll
            for (int e = 1; e < 8; ++e) if (el[e] > v1) { v1 = el[e]; i1 = e; }
            int i2 = 0; float v2 = -3.0e38f;
#pragma unroll
            for (int e = 0; e < 8; ++e) if (e != i1 && el[e] > v2) { v2 = el[e]; i2 = e; }
            const float ex = __expf(v2 - v1);
            const float w1 = gp / (1.f + ex), w2 = gp * ex / (1.f + ex);
            if (h == 0) {
                const int e1 = gi * 8 + i1, e2 = gi * 8 + i2;
                hist[c] = 0u;
                asm volatile("s_waitcnt lgkmcnt(0)" ::: "memory");
                const unsigned r1 = __hip_atomic_fetch_add(&hist[e1], 1u, __ATOMIC_RELAXED, __HIP_MEMORY_SCOPE_WORKGROUP);
                const unsigned r2 = __hip_atomic_fetch_add(&hist[e2], 1u, __ATOMIC_RELAXED, __HIP_MEMORY_SCOPE_WORKGROUP);
                asm volatile("s_waitcnt lgkmcnt(0)" ::: "memory");
                const unsigned n = hist[c];
                unsigned bs = 0u;
                if (n) bs = atomicAdd(&cnt[c * 64], n);
                hist[32 + c] = bs;
                asm volatile("s_waitcnt lgkmcnt(0)" ::: "memory");
                const unsigned s1 = hist[32 + e1] + r1, s2 = hist[32 + e2] + r2;
                ltok_[(size_t)e1 * LCAP + s1] = t * 2;     lw_[(size_t)e1 * LCAP + s1] = w1;
                ltok_[(size_t)e2 * LCAP + s2] = t * 2 + 1; lw_[(size_t)e2 * LCAP + s2] = w2;
            }
        }
        __syncthreads();
    }
}

DI ConvTask conv_task(const Ctx& cx, int layer, int task, int lane) {
    const int e = task / 768, u = task - e * 768, which = u >> 8, v = u & 255;
    const float* W; bf16* WT; int K, N, kt, nt;
    if (which == 0) { W = cx.in(23) + ((size_t)layer * NEXP + e) * D * DEXP; WT = cx.wmg() + (size_t)e * DEXP * D; K = D; N = DEXP; kt = v >> 4; nt = v & 15; }
    else if (which == 1) { W = cx.in(24) + ((size_t)layer * NEXP + e) * D * DEXP; WT = cx.wmu() + (size_t)e * DEXP * D; K = D; N = DEXP; kt = v >> 4; nt = v & 15; }
    else { W = cx.in(25) + ((size_t)layer * NEXP + e) * DEXP * D; WT = cx.wmd() + (size_t)e * D * DEXP; K = DEXP; N = D; kt = v >> 5; nt = v & 31; }
    ConvTask t;
    t.src = W + (size_t)(kt * 64 + (lane >> 3)) * N + nt * 32 + (lane & 7) * 4;
    t.dst = WT + (size_t)(nt * 32 + (lane >> 3)) * K + kt * 64 + (lane & 7) * 8;
    t.N = N; t.K = K;
    return t;
}
DI void moe_convert(const Ctx& cx, int layer) {
    const int gw = blockIdx.x * 4 + cx.wave, nw = gridDim.x * 4;
    const int lane = cx.lane;
    constexpr int NT = NEXP * 768;
    LAS float* scr = (LAS float*)(cx.lds + 36864) + cx.wave * (64 * 33);
#define CV_LOAD(X, task) do { const ConvTask ct_ = conv_task(cx, layer, (task), lane); \
        _Pragma("unroll") for (int p = 0; p < 8; ++p) X[p] = *(const f32x4*)(ct_.src + (size_t)(8 * p) * ct_.N); } while (0)
#define CV_PROC(X, task) do { const ConvTask ct_ = conv_task(cx, layer, (task), lane); \
        _Pragma("unroll") for (int p = 0; p < 8; ++p) { LAS float* d = scr + ((lane >> 3) + 8 * p) * 33 + (lane & 7) * 4; d[0] = X[p][0]; d[1] = X[p][1]; d[2] = X[p][2]; d[3] = X[p][3]; } \
        asm volatile("s_waitcnt lgkmcnt(0)" ::: "memory"); \
        _Pragma("unroll") for (int p = 0; p < 4; ++p) { const LAS float* s = scr + ((lane & 7) * 8) * 33 + (lane >> 3) + 8 * p; \
            u32x4 o; o.x = pk2(s[0], s[33]); o.y = pk2(s[2 * 33], s[3 * 33]); o.z = pk2(s[4 * 33], s[5 * 33]); o.w = pk2(s[6 * 33], s[7 * 33]); \
            *(u32x4*)(ct_.dst + (size_t)(8 * p) * ct_.K) = o; } \
        asm volatile("s_waitcnt lgkmcnt(0)" ::: "memory"); } while (0)
    int nheavy = ((T / 32) % (int)gridDim.x) * 4;
    if (2 * nheavy >= nw) nheavy = 0;
    const bool heavy = gw < nheavy;
    const int S = nw - nheavy, base = gw - nheavy;
#define CV_ITEM(j) (heavy ? NT : base + S * (j))
    f32x4 xa[8], xb[8];
    int j = 0, task = CV_ITEM(0);
    if (task < NT) CV_LOAD(xa, task);
#pragma unroll 1
    while (task < NT) {
        const int t2 = CV_ITEM(j + 1), t3 = CV_ITEM(j + 2);
        if (t2 < NT) CV_LOAD(xb, t2);
        CV_PROC(xa, task);
        if (t3 < NT) CV_LOAD(xa, t3);
        if (t2 < NT) CV_PROC(xb, t2);
        task = t3; j += 2;
    }
#undef CV_ITEM
#undef CV_LOAD
#undef CV_PROC
}

DI void phase_combine(const Ctx& cx, int layer, bool last, bool dummy) {
    const int gw = blockIdx.x * 4 + cx.wave, gstride = gridDim.x * 4;
    for (int t = gw; t < T; t += gstride) {
        const int b = t / TPB, j = t - b * TPB;
        if (last && j < CTX) continue;
        bf16* xr = cx.xres() + (size_t)t * D;
        f32x4 v[4]; load_row_bf16(xr, v, cx.lane);
        const int mr = (j < CTX) ? 8 : b;
        const float* g2 = cx.mod() + ((size_t)layer * 9 + mr) * 6144 + 5120;
        const bf16* y0 = cx.YP() + (size_t)(2 * t) * D; const bf16* y1 = y0 + D;
#pragma unroll
        for (int jj = 0; jj < 4; ++jj) {
            const u32x2 a = ((const u32x2*)y0)[cx.lane + 64 * jj], bq = ((const u32x2*)y1)[cx.lane + 64 * jj];
            const f32x4 gg = ((const f32x4*)g2)[cx.lane + 64 * jj];
            float ya[4] = {bf2f((unsigned short)(a.x & 0xffff)), bf2f((unsigned short)(a.x >> 16)), bf2f((unsigned short)(a.y & 0xffff)), bf2f((unsigned short)(a.y >> 16))};
            float yb[4] = {bf2f((unsigned short)(bq.x & 0xffff)), bf2f((unsigned short)(bq.x >> 16)), bf2f((unsigned short)(bq.y & 0xffff)), bf2f((unsigned short)(bq.y >> 16))};
#pragma unroll
            for (int e = 0; e < 4; ++e) v[jj][e] += gg[e] * (ya[e] + yb[e]);
        }
        if (!last) {
            bf16* xw = dummy ? cx.Q() + (size_t)t * D : xr;
            store_row_bf16(xw, v, cx.lane);
            const float* md = cx.mod() + ((size_t)(layer + 1) * 9 + mr) * 6144;
            norm_mod(v, cx.in(6) + (layer + 1) * D, md, md + 1024, cx.lane);
            store_row_bf16(cx.H() + (size_t)t * D, v, cx.lane);
        } else {
            float ss = 0.f;
#pragma unroll
            for (int jj = 0; jj < 4; ++jj) ss += (v[jj][0] * v[jj][0] + v[jj][1] * v[jj][1]) + (v[jj][2] * v[jj][2] + v[jj][3] * v[jj][3]);
            const float rn = rsqrtf(wave_sum(ss) * (1.f / D) + EPS);
            float* orow = cx.out() + (size_t)(b * SEQ + j - CTX) * D;
#pragma unroll
            for (int jj = 0; jj < 4; ++jj) {
                const f32x4 gg = ((const f32x4*)cx.in(8))[cx.lane + 64 * jj];
                f32x4 o;
#pragma unroll
                for (int e = 0; e < 4; ++e) o[e] = v[jj][e] * rn * gg[e];
                ((f32x4*)orow)[cx.lane + 64 * jj] = o;
            }
        }
    }
}

DI void moe_directory(const Ctx& cx, int layer, LAS int* s_off, LAS int* s_toff) {
    if (cx.tid < 64) {
        const unsigned* cnt = cx.ctl() + CW_CNT + layer * 32 * 64;
        const int e = cx.lane;
        const int c = (e < NEXP) ? (int)cnt[e * 64] : 0;
        int o = c, to = (c + 127) >> 7;
#pragma unroll
        for (int d = 1; d < NEXP; d <<= 1) { const int a = __shfl_up(o, d), b2 = __shfl_up(to, d); if (e >= d) { o += a; to += b2; } }
        if (e < NEXP) { s_off[e + 1] = o; s_toff[e + 1] = to; }
        if (e == 0) { s_off[0] = 0; s_toff[0] = 0; }
    }
    __syncthreads();
}

__global__ void __launch_bounds__(NTHREADS, 2) fwd_kernel(Params p) {
    extern __shared__ __attribute__((aligned(16))) unsigned char lds_raw[];
    Ctx cx;
    cx.pp = (ParamsPtr)__builtin_amdgcn_kernarg_segment_ptr();
    cx.lds = (LAS unsigned char*)lds_raw;
    cx.tid = threadIdx.x; cx.lane = cx.tid & 63; cx.wave = __builtin_amdgcn_readfirstlane(cx.tid >> 6);
    volatile LAS unsigned* misc = (volatile LAS unsigned*)(cx.lds + LDS_MISC);
    LAS int* s_off = (LAS int*)(cx.lds + LDS_MISC + 64);
    LAS int* s_toff = (LAS int*)(cx.lds + LDS_MISC + 64 + 160);
    if (cx.tid < 2) misc[cx.tid] = 0u;
    __syncthreads();
    if (cx.pp->ph_hi - cx.pp->ph_lo > 1) (void)xcd_barrier_post((unsigned*)(cx.pp->ws + WS_CTL) + CW_BAR, misc);
    bool again_ = false;
    for (int ph = cx.pp->ph_lo; ; ) {
        asm volatile("" : "+s"(cx.pp));
        { int tid_ = threadIdx.x; asm volatile("" : "+v"(tid_)); cx.tid = tid_; cx.lane = tid_ & 63; cx.wave = __builtin_amdgcn_readfirstlane(tid_ >> 6); }
        if (ph == 0) phase_prologue(cx);
        else if (ph == 1) phase_first_norm(cx);
        else {
            const int layer = (ph - 2) / 7, sub = (ph - 2) % 7, kind = layer % 3;
#ifdef PROBE_REP
            const bool dummy = !again_ && ((PROBE_REP >> ph) & 1ull);
#else
            const bool dummy = false;
#endif
            const bool last = (layer == DEPTH - 1);
            const int vbid = (gridDim.x & 7) ? (int)blockIdx.x : (int)((blockIdx.x & 7) * (gridDim.x >> 3) + (blockIdx.x >> 3));
            if (sub == 0) {
                QkvOp op; op.A = cx.H(); op.kind = kind; op.Q = cx.Q(); op.Kb = cx.K(); op.VT = cx.VT(); op.rc = cx.ropec(); op.rs = cx.ropes();
                op.Wt = cx.wqkv(layer);
                if (kind == 2) { op.N = 1536; op.kw = 256; op.voff = 1280; op.vw = 256; }
                else { op.N = 3072; op.kw = D; op.voff = 2048; op.vw = D; }
                const int ntn = op.N / 128, ntiles = (T / 128) * ntn;
                for (int tile = blockIdx.x; tile < ntiles; tile += gridDim.x) {
                    op.m0 = (tile / ntn) * 128; op.n0 = (tile % ntn) * 128;
                    gemm_tile<2, 2, 64>(op, cx.lds, cx.tid);
                }
            } else if (sub == 1) {
                if (kind == 1) attn_block_da(cx, layer, !last, vbid); else attn_block_nasw(cx, kind, layer, !last, vbid);
            } else if (sub == 2) {
                OutOp op; op.A = cx.O(); op.xres = cx.xres(); op.xdst = dummy ? cx.Q() : cx.xres(); op.modl = cx.mod() + (size_t)layer * 9 * 6144;
                op.Wt = cx.wo(layer);
                for (int tile = vbid; tile < 1024; tile += gridDim.x) {
                    int mt = tile >> 3;
                    if (last) mt = (mt >> 4) * 18 + 2 + (mt & 15);
                    op.m0 = mt * 128; op.n0 = (tile & 7) * 128;
                    gemm_tile<2, 2, 64>(op, cx.lds, cx.tid);
                }
                if (!last) for (int u = blockIdx.x; u < 256; u += gridDim.x) {
                    op.m0 = 128 * 128 + (u >> 3) * 64; op.n0 = (u & 7) * 128;
                    gemm_tile<1, 2, 64>(op, cx.lds, cx.tid);
                }
            } else if (sub == 3) {
                if (blockIdx.x & 1) { moe_convert(cx, layer); __syncthreads(); }
                phase_norm_route(cx, layer, last, dummy);
                if (!(blockIdx.x & 1)) { __syncthreads(); moe_convert(cx, layer); }
#ifdef PROBE_CONV2
                moe_convert(cx, layer);
#endif
            } else if (sub == 4) {
                moe_directory(cx, layer, s_off, s_toff);
                const int ntiles = s_toff[NEXP] * 8;
                for (int tile = vbid; tile < ntiles; tile += gridDim.x) {
                    const int rtg = tile >> 3; int e = 0;
                    while (s_toff[e + 1] <= rtg) ++e;
                    GateUpOp op; op.H = cx.H(); op.cnt = s_off[e + 1] - s_off[e]; op.r0 = (rtg - s_toff[e]) * 128; op.f0 = (tile & 7) * 64;
                    op.WgT = cx.wmg() + (size_t)e * DEXP * D; op.WuT = cx.wmu() + (size_t)e * DEXP * D;
                    op.ltok = cx.ltok() + (size_t)e * LCAP; op.act = cx.ACT() + (size_t)s_off[e] * DEXP;
                    gemm_tile<2, 2, 64>(op, cx.lds, cx.tid);
                }
            } else if (sub == 5) {
                moe_directory(cx, layer, s_off, s_toff);
                const int ntiles = s_toff[NEXP] * 8;
                DownOp op, nop; op.yp = cx.YP(); nop.yp = op.yp;
#define F_SET(o, tl) do { const int rtg_ = (tl) >> 3; int e_ = 0; while (s_toff[e_ + 1] <= rtg_) ++e_; \
                    (o).cnt = s_off[e_ + 1] - s_off[e_]; (o).r0 = (rtg_ - s_toff[e_]) * 128; (o).n0 = ((tl) & 7) * 128; \
                    (o).act = cx.ACT() + (size_t)s_off[e_] * DEXP; (o).WdT = cx.wmd() + (size_t)e_ * D * DEXP; \
                    (o).ltok = cx.ltok() + (size_t)e_ * LCAP; (o).lw = cx.lw() + (size_t)e_ * LCAP; } while (0)
                int tile = vbid; bool first = true;
                if (tile < ntiles) F_SET(op, tile);
                while (tile < ntiles) {
                    const int nt_ = tile + gridDim.x; const bool hn = nt_ < ntiles;
                    if (hn) F_SET(nop, nt_); else nop = op;
                    gemm_tile_x<2, 2, 64, true>(op, nop, hn, first, cx.lds, cx.tid);
                    op = nop; tile = nt_; first = false;
                }
#undef F_SET
            } else {
                phase_combine(cx, layer, last, dummy);
            }
        }
#ifdef PROBE_REP
        if (!again_ && ((PROBE_REP >> ph) & 1ull)) again_ = true; else { again_ = false; ++ph; }
#else
        ++ph;
#endif
        if (ph >= cx.pp->ph_hi) break;
        { XcdBarrier bar; bar.bar = cx.ctl() + CW_BAR; bar.x = xb_xcc_id(); bar.st = (volatile LAS unsigned*)(cx.lds + LDS_MISC); xcd_barrier(bar);
#ifdef PROBE_BAR2
          xcd_barrier(bar);
#endif
        }
    }
}

extern "C" void kernel_launch(void* const* d_in, const int* in_sizes, int n_in, void* d_out, int out_size, void* d_ws, size_t ws_size, hipStream_t stream) {
    static int grid = 0;
    if (grid == 0) {
        if (n_in != 26 || ws_size < WS_END) { fprintf(stderr, "kernel_launch: unexpected inputs (n_in %d) or workspace %zu < %zu\n", n_in, ws_size, (size_t)WS_END); grid = -1; return; }
        int dev = 0, cus = 0, per_cu = 0;
        (void)hipGetDevice(&dev);
        (void)hipDeviceGetAttribute(&cus, hipDeviceAttributeMultiprocessorCount, dev);
        if (hipFuncSetAttribute((const void*)fwd_kernel, hipFuncAttributeMaxDynamicSharedMemorySize, LDS_BYTES) != hipSuccess) { fprintf(stderr, "kernel_launch: hipFuncSetAttribute failed\n"); grid = -1; return; }
        if (hipOccupancyMaxActiveBlocksPerMultiprocessor(&per_cu, (const void*)fwd_kernel, NTHREADS, LDS_BYTES) != hipSuccess || per_cu < 1) { fprintf(stderr, "kernel_launch: occupancy query failed (%d)\n", per_cu); per_cu = 1; }
        (void)hipGetLastError();
        if (per_cu > 2) per_cu = 2;
        grid = cus * per_cu;
        fprintf(stderr, "kernel_launch: %d CUs x %d blocks\n", cus, per_cu);
    }
    if (grid < 0) return;
    (void)hipMemsetAsync((char*)d_ws + WS_CTL, 0, CTL_BYTES, stream);
    Params p{};
    for (int i = 0; i < 26; ++i) p.in[i] = (const float*)d_in[i];
    p.out = (float*)d_out; p.ws = (unsigned char*)d_ws;
#if ONE_LAUNCH
    p.ph_lo = 0; p.ph_hi = NPHASES;
    hipLaunchKernelGGL(fwd_kernel, dim3(grid), dim3(NTHREADS), LDS_BYTES, stream, p);
#else
    for (int ph = 0; ph < NPHASES; ++ph) {
        p.ph_lo = ph; p.ph_hi = ph + 1;
        hipLaunchKernelGGL(fwd_kernel, dim3(grid), dim3(NTHREADS), LDS_BYTES, stream, p);
    }
#endif
}
```

```cpp
#include <hip/hip_runtime.h>
#include <cstdio>
#include <cstdint>

#ifndef ONE_LAUNCH
#define ONE_LAUNCH 1
#define PROBE_REP 0ull
#ifndef IGLP_ATT
#define IGLP_ATT 3
#endif


#endif

#define DI __device__ __forceinline__
#define LAS __attribute__((address_space(3)))
typedef unsigned short bf16;
typedef short bf16x8 __attribute__((ext_vector_type(8)));
typedef float f32x16 __attribute__((ext_vector_type(16)));
typedef float f32x4 __attribute__((ext_vector_type(4)));
typedef float f32x2 __attribute__((ext_vector_type(2)));
typedef unsigned u32x4 __attribute__((ext_vector_type(4)));
typedef unsigned u32x2 __attribute__((ext_vector_type(2)));
typedef __bf16 bf16x2_t __attribute__((ext_vector_type(2)));
#define MFMA(a, b, c) __builtin_amdgcn_mfma_f32_32x32x16_bf16((a), (b), (c), 0, 0, 0)

constexpr int D = 1024, NB = 8, SEQ = 2048, CTX = 256, DEPTH = 4;
constexpr int TPB = CTX + SEQ;
constexpr int T = NB * TPB;
constexpr int NEXP = 32, DEXP = 512;
constexpr int LCAP = T;
constexpr float EPS = 1e-6f;
constexpr float LOG2E = 1.4426950408889634f;
constexpr float SM_C = 0.125f * LOG2E;
constexpr float NEG = -1e30f;

constexpr size_t MiB = 1u << 20;
constexpr size_t WS_CTL = 0, CTL_BYTES = 65536;
constexpr size_t WS_MOD = 1 * MiB;
constexpr size_t WS_ROPE = 2 * MiB;
constexpr size_t WS_LTOK = 3 * MiB;
constexpr size_t WS_LW = 6 * MiB;
constexpr size_t WS_WR = 9 * MiB;
constexpr size_t WS_WQKV = 416 * MiB;
constexpr size_t WS_WO = 440 * MiB;
constexpr size_t WS_GM = 10 * MiB;
constexpr size_t WS_RC = 11 * MiB;
constexpr size_t WS_RPB = 12 * MiB;
constexpr size_t WS_XRES = 16 * MiB;
constexpr size_t WS_H = 96 * MiB;
constexpr size_t WS_Q = 136 * MiB;
constexpr size_t WS_K = 176 * MiB;
constexpr size_t WS_VT = 216 * MiB;
constexpr size_t WS_O = 256 * MiB;
constexpr size_t WS_ACT = 296 * MiB;
constexpr size_t WS_YP = 336 * MiB;
constexpr size_t WS_WMG = 448 * MiB;
constexpr size_t WS_WMU = 480 * MiB;
constexpr size_t WS_WMD = 512 * MiB;
constexpr size_t WS_END = 544 * MiB;
constexpr int CW_BAR = 0;
constexpr int CW_CNT = 8192;

constexpr int NTHREADS = 256;
constexpr int LDS_GEMM = 73728;
constexpr int LDS_MISC = LDS_GEMM;
constexpr int LDS_BYTES = LDS_GEMM + 1024;
constexpr int NPHASES = 2 + 7 * DEPTH;

struct Params {
    const float* in[26];
    float* out;
    unsigned char* ws;
    int ph_lo, ph_hi;
};

DI unsigned pk2(float lo, float hi) { f32x2 v = {lo, hi}; bf16x2_t r = __builtin_convertvector(v, bf16x2_t); return __builtin_bit_cast(unsigned, r); }
DI float bf2f(unsigned short u) { return __builtin_bit_cast(float, (unsigned)u << 16); }
DI float wave_sum(float v) {
#pragma unroll
    for (int o = 1; o < 64; o <<= 1) v += __shfl_xor(v, o);
    return v;
}
DI float fexp2(float x) { return __builtin_amdgcn_exp2f(x); }
DI float silu(float v) { return v / (1.f + __expf(-v)); }
DI bf16x8 ldg8(const bf16* p) { return *(const bf16x8*)p; }
DI void glds16(const void* g, LAS unsigned char* l) {
    __builtin_amdgcn_global_load_lds((const unsigned*)g, (LAS unsigned*)l, 16, 0, 0);
}
DI int pi32(int r) { return (r & 0x13) | ((r & 4) << 1) | ((r & 8) >> 1); }

#define XB_TMO      128
#define XB_XCNT(j)  (256  + 64 * (j))
#define XB_XSUB(j)  (1280 + 64 * (j))
#define XB_XGEN(j)  (2304 + 64 * (j))
#define XB_TOP      3328
#define XB_TOPGEN   3392
#define XCD_BAR_WORDS 3456
#define XB_SPIN_CAP (1u << 20)
DI unsigned xb_ld(unsigned* p) { return __hip_atomic_load(p, __ATOMIC_RELAXED, __HIP_MEMORY_SCOPE_AGENT); }
DI unsigned xb_add(unsigned* p, unsigned v) { return __hip_atomic_fetch_add(p, v, __ATOMIC_RELAXED, __HIP_MEMORY_SCOPE_AGENT); }
DI unsigned xb_xcc_id() { return (unsigned)__builtin_amdgcn_s_getreg((3 << 11) | 20) & 0xFu; }
#define XB_SPIN(cond, bar) do { unsigned _sp = 0; while (cond) { __builtin_amdgcn_s_sleep(1); \
    if ((++_sp & 255u) == 0u) { if (xb_ld(&(bar)[XB_TMO])) break; if (_sp > XB_SPIN_CAP) { atomicAdd(&(bar)[XB_TMO], 1u); break; } } } } while (0)
struct XcdBarrier { unsigned* bar; unsigned x; volatile LAS unsigned* st; };
DI XcdBarrier xcd_barrier_post(unsigned* bar, volatile LAS unsigned* st) {
    XcdBarrier b; b.bar = bar; b.x = xb_xcc_id(); b.st = st;
    if (threadIdx.x == 0) (void)xb_add(&bar[XB_XCNT(b.x)], 1u);
    return b;
}
DI void xcd_barrier_complete(unsigned* bar, unsigned x, unsigned& nloc, unsigned& nx) {
    const unsigned G = gridDim.x * gridDim.y * gridDim.z;
    unsigned sum, cnt, mine, sp = 0u;
    for (;;) {
        sum = 0u; cnt = 0u; mine = 0u;
#pragma unroll
        for (unsigned j = 0; j < 16; ++j) { const unsigned c = xb_ld(&bar[XB_XCNT(j)]); sum += c; cnt += (c > 0u) ? 1u : 0u; mine = (j == x) ? c : mine; }
        if (sum == G) break;
        __builtin_amdgcn_s_sleep(1);
        if ((++sp & 255u) == 0u) { if (xb_ld(&bar[XB_TMO])) break; if (sp > XB_SPIN_CAP) { atomicAdd(&bar[XB_TMO], 1u); break; } }
    }
    nloc = mine > 0u ? mine : 1u; nx = cnt > 0u ? cnt : 1u;
}
DI void xcd_barrier(const XcdBarrier& b) {
    asm volatile("s_waitcnt vmcnt(0)" ::: "memory");
    __syncthreads();
    if (threadIdx.x == 0) {
        unsigned* bar = b.bar;
        __builtin_amdgcn_s_waitcnt(0);
        unsigned nloc = b.st[0], nx = b.st[1];
        if (nloc == 0u) { xcd_barrier_complete(bar, b.x, nloc, nx); b.st[0] = nloc; b.st[1] = nx; }
        const unsigned old = xb_add(&bar[XB_XSUB(b.x)], 1u);
        const unsigned gen = old / nloc;
        if (old + 1u == (gen + 1u) * nloc) {
            __builtin_amdgcn_fence(__ATOMIC_RELEASE, "agent");
            asm volatile("s_waitcnt vmcnt(0)" ::: "memory");
            const unsigned og = xb_add(&bar[XB_TOP], 1u);
            const unsigned tg = og / nx;
            if (og + 1u == (tg + 1u) * nx) xb_add(&bar[XB_TOPGEN], 1u);
            else XB_SPIN(xb_ld(&bar[XB_TOPGEN]) == tg, bar);
            __builtin_amdgcn_fence(__ATOMIC_ACQUIRE, "agent");
            xb_add(&bar[XB_XGEN(b.x)], 1u);
            asm volatile("s_waitcnt vmcnt(0)" ::: "memory");
        } else {
            XB_SPIN(xb_ld(&bar[XB_XGEN(b.x)]) == gen, bar);
            __builtin_amdgcn_fence(__ATOMIC_ACQUIRE, "agent");
            asm volatile("s_waitcnt vmcnt(0)" ::: "memory");
        }
    }
    __syncthreads();
}

typedef const __attribute__((address_space(4))) Params* ParamsPtr;
struct Ctx {
    ParamsPtr pp;
    LAS unsigned char* lds;
    int tid, lane, wave;
    DI const float* in(int i) const { return pp->in[i]; }
    DI float* out() const { return pp->out; }
    DI unsigned char* ws() const { return pp->ws; }
    DI unsigned* ctl() const { return (unsigned*)(ws() + WS_CTL); }
    DI float* mod() const { return (float*)(ws() + WS_MOD); }
    DI float* ropec() const { return (float*)(ws() + WS_ROPE); }
    DI float* ropes() const { return (float*)(ws() + WS_ROPE) + 1024; }
    DI int* ltok() const { return (int*)(ws() + WS_LTOK); }
    DI float* lw() const { return (float*)(ws() + WS_LW); }
    DI bf16* wr() const { return (bf16*)(ws() + WS_WR); }
    DI bf16* wqkv(int layer) const { return (bf16*)(ws() + WS_WQKV) + (size_t)layer * 3072 * D; }
    DI bf16* wmg() const { return (bf16*)(ws() + WS_WMG); }
    DI bf16* wmu() const { return (bf16*)(ws() + WS_WMU); }
    DI bf16* wmd() const { return (bf16*)(ws() + WS_WMD); }
    DI bf16* wo(int layer) const { return (bf16*)(ws() + WS_WO) + (size_t)layer * D * D; }
    DI float* gm() const { return (float*)(ws() + WS_GM); }
    DI float* rc() const { return (float*)(ws() + WS_RC); }
    DI float* rpbp() const { return (float*)(ws() + WS_RPB); }
    DI bf16* xres() const { return (bf16*)(ws() + WS_XRES); }
    DI bf16* H() const { return (bf16*)(ws() + WS_H); }
    DI bf16* Q() const { return (bf16*)(ws() + WS_Q); }
    DI bf16* K() const { return (bf16*)(ws() + WS_K); }
    DI bf16* VT() const { return (bf16*)(ws() + WS_VT); }
    DI bf16* O() const { return (bf16*)(ws() + WS_O); }
    DI bf16* ACT() const { return (bf16*)(ws() + WS_ACT); }
    DI bf16* YP() const { return (bf16*)(ws() + WS_YP); }
};

DI int mod_row(int t) { const int b = t / TPB; return (t - b * TPB) < CTX ? 8 : b; }

template <int MI, int NSTG, int BK, bool CHAIN, class Op>
DI void gemm_tile_x(const Op& op, const Op& nop, bool has_next, bool first, LAS unsigned char* lds, int tid) {
    constexpr int BM = 64 * MI, RB = BK * 2  , STG = (BM + 128) * RB, APC = BM * RB / 4096, BPC = 128 * RB / 4096, LPT = APC + BPC, KS = BK / 16, RPP = 4096 / RB  ;
    const int lane = tid & 63, wave = tid >> 6, wm = wave & 1, wn = wave >> 1;
    const int r = lane & 31, h = lane >> 5;
    const int K = op.K(), nk = K / BK;
    const int srow = (BK == 32) ? (tid >> 2) : (tid >> 3);
    const int sch = (BK == 32) ? ((tid & 3) ^ ((tid >> 4) & 3)) : ((tid & 7) ^ ((tid >> 4) & 7));
    const bf16* ap[APC]; const bf16* bpt[BPC];
#pragma unroll
    for (int i = 0; i < APC; ++i) ap[i] = op.arow(srow + RPP * i) + sch * 8;
#pragma unroll
    for (int i = 0; i < BPC; ++i) bpt[i] = op.brow_ptr(srow + RPP * i) + sch * 8;
    const unsigned xs = (BK == 32) ? ((r >> 2) & 3) : ((r >> 1) & 7);
    unsigned a_rd[MI], b_rd[2];
#pragma unroll
    for (int mi = 0; mi < MI; ++mi) a_rd[mi] = (32 * MI * wm + 32 * mi + r) * RB;
#pragma unroll
    for (int ni = 0; ni < 2; ++ni) b_rd[ni] = BM * RB + (op.brow(wn, ni) + r) * RB;

    f32x16 acc[2][MI];
#pragma unroll
    for (int ni = 0; ni < 2; ++ni)
#pragma unroll
        for (int mi = 0; mi < MI; ++mi)
#pragma unroll
            for (int i = 0; i < 16; ++i) acc[ni][mi][i] = 0.f;
    typename Op::template Pre<MI> pre;
    op.template prefetch<MI>(pre, wm, wn, r, h);

#define G_ISSUE(kt, stg) do { LAS unsigned char* s_ = lds + (stg) * STG + tid * 16; \
        _Pragma("unroll") for (int i = 0; i < APC; ++i) glds16(ap[i] + (kt) * BK, s_ + i * 4096); \
        _Pragma("unroll") for (int i = 0; i < BPC; ++i) glds16(bpt[i] + (kt) * BK, s_ + BM * RB + i * 4096); } while (0)

    if (!CHAIN || first) {
        __syncthreads();
#pragma unroll
        for (int s = 0; s < NSTG - 1; ++s) if (s < nk) G_ISSUE(s, s);
    }
    int stg = 0, istg = NSTG - 1;
    for (int kt = 0; kt < nk; ++kt) {
        if (kt + NSTG - 2 < nk) asm volatile("s_waitcnt vmcnt(%0)" :: "n"((NSTG - 2) * LPT) : "memory");
        else asm volatile("s_waitcnt vmcnt(0)" ::: "memory");
        __builtin_amdgcn_s_barrier();
        asm volatile("" ::: "memory");
        if (kt + NSTG - 1 < nk) G_ISSUE(kt + NSTG - 1, istg);
        __builtin_amdgcn_sched_barrier(0);
        LAS unsigned char* base = lds + stg * STG;
        __builtin_amdgcn_iglp_opt(1);
#pragma unroll
        for (int s = 0; s < KS; ++s) {
            const unsigned co = (unsigned)(((2 * s + h) ^ xs) << 4);
            bf16x8 af[MI], bfr[2];
#pragma unroll
            for (int mi = 0; mi < MI; ++mi) af[mi] = *(LAS bf16x8*)(base + a_rd[mi] + co);
#pragma unroll
            for (int ni = 0; ni < 2; ++ni) bfr[ni] = *(LAS bf16x8*)(base + b_rd[ni] + co);
#pragma unroll
            for (int ni = 0; ni < 2; ++ni)
#pragma unroll
                for (int mi = 0; mi < MI; ++mi) acc[ni][mi] = MFMA(bfr[ni], af[mi], acc[ni][mi]);
        }
        asm volatile("" ::: "memory");
        stg = (stg + 1 == NSTG) ? 0 : stg + 1; istg = (istg + 1 == NSTG) ? 0 : istg + 1;
    }
#undef G_ISSUE
    if (CHAIN) {
        __syncthreads();
        if (has_next) {
#pragma unroll
            for (int s = 0; s < NSTG - 1; ++s) if (s < nk) {
                LAS unsigned char* s_ = lds + s * STG + tid * 16;
#pragma unroll
                for (int i = 0; i < APC; ++i) glds16(nop.arow(srow + RPP * i) + sch * 8 + s * BK, s_ + i * 4096);
#pragma unroll
                for (int i = 0; i < BPC; ++i) glds16(nop.brow_ptr(srow + RPP * i) + sch * 8 + s * BK, s_ + BM * RB + i * 4096);
            }
        }
        __builtin_amdgcn_sched_barrier(0);
    }
    if (Op::kLdsEpi) {
        if (!CHAIN) __syncthreads();
        else asm volatile("s_waitcnt vmcnt(0)" ::: "memory");
        op.template epi_lds<MI>(acc, pre, wm, wn, r, h, lds + 32768 + wave * 8704);
    } else op.template epi<MI>(acc, pre, wm, wn, r, h);
}
template <int MI, int NSTG, int BK, class Op>
DI void gemm_tile(const Op& op, LAS unsigned char* lds, int tid) { gemm_tile_x<MI, NSTG, BK, false>(op, op, false, true, lds, tid); }

struct QkvOp {
    static constexpr bool kLdsEpi = false;
    template <int MI, class P> DI void epi_lds(f32x16 (&)[2][MI], const P&, int, int, int, int, LAS unsigned char*) const {}
    template <int MI> struct Pre {};
    template <int MI> DI void prefetch(Pre<MI>&, int, int, int, int) const {}
    const bf16* A; const bf16* Wt; int N, m0, n0, kind, kw, voff, vw;
    bf16* Q; bf16* Kb; bf16* VT; const float* rc; const float* rs;
    DI int K() const { return D; }
    DI const bf16* arow(int ml) const { return A + (size_t)(m0 + ml) * D; }
    DI const bf16* brow_ptr(int nl) const { return Wt + (size_t)(n0 + nl) * D; }
    DI int brow(int wn, int ni) const { return 64 * wn + 32 * ni; }
    template <int MI> DI void epi(f32x16 (&acc)[2][MI], const Pre<MI>& pre, int wm, int wn, int c, int h) const {
#pragma unroll
        for (int ni = 0; ni < 2; ++ni)
#pragma unroll
            for (int mi = 0; mi < MI; ++mi) {
                const int nb = n0 + 64 * wn + 32 * ni;
                const int t = m0 + 32 * MI * wm + 32 * mi + c;
                const int b = t / TPB, j = t - b * TPB;
                f32x16 v = acc[ni][mi];
                if (nb < voff) {
                    if (kind != 0 && j >= CTX) {
                        const int s = j - CTX;
                        const int pos = ((nb >> 5) & 1) ? (s & 63) : (s >> 6);
#pragma unroll
                        for (int g = 0; g < 2; ++g)
#pragma unroll
                            for (int e = 0; e < 4; ++e) {
                                const int i = 4 * g + e, d = e + 8 * g + 4 * h;
                                const float cs = rc[pos * 16 + d], sn = rs[pos * 16 + d];
                                const float x1 = v[i], x2 = v[i + 8];
                                v[i] = x1 * cs - x2 * sn; v[i + 8] = x2 * cs + x1 * sn;
                            }
                    }
                    bf16* dst = (nb < D) ? (Q + (size_t)t * D + nb) : (Kb + (size_t)t * kw + (nb - D));
#pragma unroll
                    for (int g = 0; g < 4; ++g) {
                        u32x2 w; w.x = pk2(v[4 * g], v[4 * g + 1]); w.y = pk2(v[4 * g + 2], v[4 * g + 3]);
                        *(u32x2*)(dst + 8 * g + 4 * h) = w;
                    }
                } else {
                    const unsigned off0 = (unsigned)((b * vw + (nb - voff) + 4 * h) * TPB + j);
#pragma unroll
                    for (int i = 0; i < 16; ++i)
                        VT[off0 + (unsigned)(((i & 3) + 8 * (i >> 2)) * TPB)] = (bf16)(pk2(v[i], 0.f) & 0xffffu);
                }
            }
    }
};

struct OutOp {
    static constexpr bool kLdsEpi = true;
    const bf16* A; const bf16* Wt; int m0, n0; const bf16* xres; bf16* xdst; const float* modl;
    template <int MI> struct Pre { u32x4 x[MI][4]; };
    DI int K() const { return D; }
    DI const bf16* arow(int ml) const { return A + (size_t)(m0 + ml) * D; }
    DI const bf16* brow_ptr(int nl) const { return Wt + (size_t)(n0 + nl) * D; }
    DI int brow(int wn, int ni) const { return 64 * wn + 32 * ni; }
    template <int MI> DI void prefetch(Pre<MI>& pre, int wm, int wn, int c, int h) const {
        const int lane = c + 32 * h, col = n0 + 64 * wn + 8 * (lane & 7);
#pragma unroll
        for (int mi = 0; mi < MI; ++mi)
#pragma unroll
            for (int p = 0; p < 4; ++p) { const int t = m0 + 32 * MI * wm + 32 * mi + ((lane + 64 * p) >> 3); pre.x[mi][p] = *(const u32x4*)(xres + (size_t)t * D + col); }
    }
    template <int MI> DI void epi(f32x16 (&)[2][MI], const Pre<MI>&, int, int, int, int) const {}
    template <int MI> DI void epi_lds(f32x16 (&acc)[2][MI], const Pre<MI>& pre, int wm, int wn, int c, int h, LAS unsigned char* wl) const {
        const int lane = c + 32 * h, col = n0 + 64 * wn + 8 * (lane & 7);
        const float* gp = modl + mod_row(m0) * 6144 + 2048 + col;
        const f32x4 g0 = *(const f32x4*)gp, g1 = *(const f32x4*)(gp + 4);
#pragma unroll
        for (int mi = 0; mi < MI; ++mi) {
#pragma unroll
            for (int ni = 0; ni < 2; ++ni)
#pragma unroll
                for (int g = 0; g < 4; ++g) {
                    f32x4 v = {acc[ni][mi][4 * g], acc[ni][mi][4 * g + 1], acc[ni][mi][4 * g + 2], acc[ni][mi][4 * g + 3]};
                    *(LAS f32x4*)(wl + c * 272 + (32 * ni + 8 * g + 4 * h) * 4) = v;
                }
            asm volatile("s_waitcnt lgkmcnt(0)" ::: "memory");
#pragma unroll
            for (int p = 0; p < 4; ++p) {
                const int q = lane + 64 * p, row = q >> 3;
                const f32x4 a0 = *(LAS f32x4*)(wl + row * 272 + (q & 7) * 32), a1 = *(LAS f32x4*)(wl + row * 272 + (q & 7) * 32 + 16);
                const u32x4 xv = pre.x[mi][p];
                u32x4 o;
                o.x = pk2(__builtin_bit_cast(float, xv.x << 16) + g0[0] * a0[0], __builtin_bit_cast(float, xv.x & 0xffff0000u) + g0[1] * a0[1]);
                o.y = pk2(__builtin_bit_cast(float, xv.y << 16) + g0[2] * a0[2], __builtin_bit_cast(float, xv.y & 0xffff0000u) + g0[3] * a0[3]);
                o.z = pk2(__builtin_bit_cast(float, xv.z << 16) + g1[0] * a1[0], __builtin_bit_cast(float, xv.z & 0xffff0000u) + g1[1] * a1[1]);
                o.w = pk2(__builtin_bit_cast(float, xv.w << 16) + g1[2] * a1[2], __builtin_bit_cast(float, xv.w & 0xffff0000u) + g1[3] * a1[3]);
                const int t = m0 + 32 * MI * wm + 32 * mi + row;
                *(u32x4*)(xdst + (size_t)t * D + col) = o;
            }
            asm volatile("s_waitcnt lgkmcnt(0)" ::: "memory");
        }
    }
};

struct GateUpOp {
    static constexpr bool kLdsEpi = false;
    template <int MI, class P> DI void epi_lds(f32x16 (&)[2][MI], const P&, int, int, int, int, LAS unsigned char*) const {}
    template <int MI> struct Pre {};
    template <int MI> DI void prefetch(Pre<MI>&, int, int, int, int) const {}
    const bf16* H; const bf16* WgT; const bf16* WuT; const int* ltok; int cnt, r0, f0; bf16* act;
    DI int K() const { return D; }
    DI const bf16* arow(int ml) const { int p = r0 + ml; p = p < cnt ? p : cnt - 1; return H + (size_t)(ltok[p] >> 1) * D; }
    DI const bf16* brow_ptr(int nl) const { return (nl < 64) ? (WgT + (size_t)(f0 + nl) * D) : (WuT + (size_t)(f0 + nl - 64) * D); }
    DI int brow(int wn, int ni) const { return 64 * ni + 32 * wn; }
    template <int MI> DI void epi(f32x16 (&acc)[2][MI], const Pre<MI>& pre, int wm, int wn, int c, int h) const {
#pragma unroll
        for (int mi = 0; mi < MI; ++mi) {
            const int p = r0 + 32 * MI * wm + 32 * mi + c;
            if (p < cnt) {
                bf16* dst = act + (size_t)p * DEXP + f0 + 32 * wn + 4 * h;
#pragma unroll
                for (int g = 0; g < 4; ++g) {
                    float o[4];
#pragma unroll
                    for (int e = 0; e < 4; ++e) { const float a = acc[0][mi][4 * g + e], u = acc[1][mi][4 * g + e]; o[e] = silu(a) * u; }
                    u32x2 w; w.x = pk2(o[0], o[1]); w.y = pk2(o[2], o[3]);
                    *(u32x2*)(dst + 8 * g) = w;
                }
            }
        }
    }
};

struct DownOp {
    static constexpr bool kLdsEpi = true;
    template <int MI> struct Pre { int tk[MI][4]; float w[MI]; };
    const bf16* act; const bf16* WdT; const int* ltok; const float* lw; int cnt, r0, n0; bf16* yp;
    DI int K() const { return DEXP; }
    DI const bf16* arow(int ml) const { int p = r0 + ml; p = p < cnt ? p : cnt - 1; return act + (size_t)p * DEXP; }
    DI const bf16* brow_ptr(int nl) const { return WdT + (size_t)(n0 + nl) * DEXP; }
    DI int brow(int wn, int ni) const { return 64 * wn + 32 * ni; }
    template <int MI> DI void prefetch(Pre<MI>& pre, int wm, int wn, int c, int h) const {
        const int lane = c + 32 * h;
#pragma unroll
        for (int mi = 0; mi < MI; ++mi) {
            const int pw = r0 + 32 * MI * wm + 32 * mi + c;
            pre.w[mi] = lw[pw < cnt ? pw : cnt - 1];
#pragma unroll
            for (int p = 0; p < 4; ++p) { const int pr = r0 + 32 * MI * wm + 32 * mi + ((lane + 64 * p) >> 3); pre.tk[mi][p] = ltok[pr < cnt ? pr : cnt - 1]; }
        }
    }
    template <int MI> DI void epi(f32x16 (&)[2][MI], const Pre<MI>&, int, int, int, int) const {}
    template <int MI> DI void epi_lds(f32x16 (&acc)[2][MI], const Pre<MI>& pre, int wm, int wn, int c, int h, LAS unsigned char* wl) const {
        const int lane = c + 32 * h;
#pragma unroll
        for (int mi = 0; mi < MI; ++mi) {
            const float w = pre.w[mi];
#pragma unroll
            for (int ni = 0; ni < 2; ++ni)
#pragma unroll
                for (int g = 0; g < 4; ++g) {
                    u32x2 o; o.x = pk2(w * acc[ni][mi][4 * g], w * acc[ni][mi][4 * g + 1]); o.y = pk2(w * acc[ni][mi][4 * g + 2], w * acc[ni][mi][4 * g + 3]);
                    *(LAS u32x2*)(wl + c * 144 + (32 * ni + 8 * g + 4 * h) * 2) = o;
                }
            asm volatile("s_waitcnt lgkmcnt(0)" ::: "memory");
#pragma unroll
            for (int p = 0; p < 4; ++p) {
                const int q = lane + 64 * p, row = q >> 3;
                const u32x4 v = *(LAS u32x4*)(wl + row * 144 + (q & 7) * 16);
                if (r0 + 32 * MI * wm + 32 * mi + row < cnt) *(u32x4*)(yp + (size_t)pre.tk[mi][p] * D + n0 + 64 * wn + 8 * (q & 7)) = v;
            }
            asm volatile("s_waitcnt lgkmcnt(0)" ::: "memory");
        }
    }
};

DI void transpose_tile(const float* W, int K, int N, bf16* Wt, int tile, LAS float* scr, int tid) {
    const int ntn = N / 64, k0 = (tile / ntn) * 64, n0 = (tile % ntn) * 64;
#pragma unroll 4
    for (int i = 0; i < 16; ++i) { const int kk = (tid >> 6) + 4 * i; scr[kk * 65 + (tid & 63)] = W[(size_t)(k0 + kk) * N + n0 + (tid & 63)]; }
    __syncthreads();
#pragma unroll
    for (int i = 0; i < 2; ++i) {
        const int q = tid + 256 * i, n = q >> 3, kc = q & 7;
        const LAS float* s = scr + (8 * kc) * 65 + n;
        u32x4 o; o.x = pk2(s[0], s[65]); o.y = pk2(s[2 * 65], s[3 * 65]); o.z = pk2(s[4 * 65], s[5 * 65]); o.w = pk2(s[6 * 65], s[7 * 65]);
        *(u32x4*)(Wt + (size_t)(n0 + n) * K + k0 + 8 * kc) = o;
    }
    __syncthreads();
}

DI f32x16 qk_tile(const bf16x8 (&qf)[4], const bf16* kp) {
    f32x16 s;
#pragma unroll
    for (int i = 0; i < 16; ++i) s[i] = 0.f;
    bf16x8 kf[4];
#pragma unroll
    for (int s4 = 0; s4 < 4; ++s4) kf[s4] = ldg8(kp + 16 * s4);
#pragma unroll
    for (int s4 = 0; s4 < 4; ++s4) s = MFMA(kf[s4], qf[s4], s);
    return s;
}
constexpr float RS_THR = 6.0f;
template <bool RAW>
DI bool softmax_tile(f32x16& s, float& m, float& l, float& alpha, bf16x8 (&pf)[2]) {
    float mx = s[0];
#pragma unroll
    for (int i = 1; i < 16; ++i) mx = fmaxf(mx, s[i]);
    mx = fmaxf(mx, __shfl_xor(mx, 32));
    if (RAW) mx *= SM_C;
    const bool resc = !__all(mx <= m + RS_THR);
    alpha = 1.f;
    if (resc) { const float mn = fmaxf(m, mx); alpha = fexp2(m - mn); m = mn; }
    float ps = 0.f;
#pragma unroll
    for (int i = 0; i < 16; ++i) { s[i] = RAW ? fexp2(__builtin_fmaf(s[i], SM_C, -m)) : fexp2(s[i] - m); ps += s[i]; }
    l = l * alpha + ps;
#pragma unroll
    for (int k2 = 0; k2 < 2; ++k2) {
        u32x4 w; w.x = pk2(s[8 * k2], s[8 * k2 + 1]); w.y = pk2(s[8 * k2 + 2], s[8 * k2 + 3]); w.z = pk2(s[8 * k2 + 4], s[8 * k2 + 5]); w.w = pk2(s[8 * k2 + 6], s[8 * k2 + 7]);
        pf[k2] = __builtin_bit_cast(bf16x8, w);
    }
    return resc;
}
template <int NDB>
DI void pv_tile(f32x16 (&O)[NDB], const bf16x8 (&pf)[2], const bf16* vp, float alpha) {
    bf16x8 vf[NDB][2];
#pragma unroll
    for (int db = 0; db < NDB; ++db)
#pragma unroll
        for (int k2 = 0; k2 < 2; ++k2) vf[db][k2] = ldg8(vp + (size_t)db * 32 * TPB + 16 * k2);
#pragma unroll
    for (int db = 0; db < NDB; ++db) {
#pragma unroll
        for (int i = 0; i < 16; ++i) O[db][i] *= alpha;
#pragma unroll
        for (int k2 = 0; k2 < 2; ++k2) O[db] = MFMA(vf[db][k2], pf[k2], O[db]);
    }
}
template <int NDB>
DI void store_o(const f32x16 (&O)[NDB], float inv, bf16* orow, int h) {
#pragma unroll
    for (int db = 0; db < NDB; ++db)
#pragma unroll
        for (int g = 0; g < 4; ++g) {
            u32x2 w; w.x = pk2(O[db][4 * g] * inv, O[db][4 * g + 1] * inv); w.y = pk2(O[db][4 * g + 2] * inv, O[db][4 * g + 3] * inv);
            *(u32x2*)(orow + 32 * db + 8 * g + 4 * h) = w;
        }
}

DI unsigned swz128(int row, int ch) { return (unsigned)(row * 128 + ((ch ^ ((row >> 1) & 7)) << 4)); }

template <bool RAW>
DI bool softmax_tile2(f32x16& sa, f32x16& sb, float& m, float& l, float& alpha, bf16x8 (&pf)[4]) {
    float mx = fmaxf(sa[0], sb[0]);
#pragma unroll
    for (int i = 1; i < 16; ++i) mx = fmaxf(mx, fmaxf(sa[i], sb[i]));
    mx = fmaxf(mx, __shfl_xor(mx, 32));
    if (RAW) mx *= SM_C;
    const bool resc = !__all(mx <= m + RS_THR);
    alpha = 1.f;
    if (resc) { const float mn = fmaxf(m, mx); alpha = fexp2(m - mn); m = mn; }
    float ps = 0.f;
#pragma unroll
    for (int i = 0; i < 16; ++i) {
        sa[i] = RAW ? fexp2(__builtin_fmaf(sa[i], SM_C, -m)) : fexp2(sa[i] - m);
        sb[i] = RAW ? fexp2(__builtin_fmaf(sb[i], SM_C, -m)) : fexp2(sb[i] - m);
        ps += sa[i] + sb[i];
    }
    l = l * alpha + ps;
#pragma unroll
    for (int k2 = 0; k2 < 2; ++k2) {
        u32x4 w; w.x = pk2(sa[8 * k2], sa[8 * k2 + 1]); w.y = pk2(sa[8 * k2 + 2], sa[8 * k2 + 3]); w.z = pk2(sa[8 * k2 + 4], sa[8 * k2 + 5]); w.w = pk2(sa[8 * k2 + 6], sa[8 * k2 + 7]);
        pf[k2] = __builtin_bit_cast(bf16x8, w);
        u32x4 v; v.x = pk2(sb[8 * k2], sb[8 * k2 + 1]); v.y = pk2(sb[8 * k2 + 2], sb[8 * k2 + 3]); v.z = pk2(sb[8 * k2 + 4], sb[8 * k2 + 5]); v.w = pk2(sb[8 * k2 + 6], sb[8 * k2 + 7]);
        pf[2 + k2] = __builtin_bit_cast(bf16x8, v);
    }
    return resc;
}

DI void attn_block_nasw(const Ctx& cx, int kind, int layer, bool need_ctx, int vbid) {
    const int tid = cx.tid, lane = cx.lane, w = cx.wave, c = lane & 31, h = lane >> 5;
    const int kw = (kind == 0) ? D : 256, vw = kw;
    const int n_lat = 2048, n_tasks = n_lat + (need_ctx ? 256 : 0);
    const float* rpb = cx.rpbp() + (size_t)(layer / 3) * 16 * 512;
    const float* sinks = cx.in(17);
    const int srow = tid >> 3, sch = (tid & 7) ^ ((srow >> 1) & 7);
    const int pr = pi32(c);
    const unsigned xk = (pr >> 1) & 7, xv = (c >> 1) & 7;
    LAS float* rpbs = (LAS float*)(cx.lds + 49152);
    LAS unsigned char* qreg = cx.lds + 51200 + w * 4096 + lane * 16;
    for (int base_ = 0; base_ < n_tasks; base_ += gridDim.x) {
        const int task = base_ + ((base_ + (int)gridDim.x <= n_tasks) ? vbid : (int)blockIdx.x);
        if (task >= n_tasks) break;
        int b, kmap, head, tq0, nt, rlo = 0, r0w = 0, rg = 0, qh = 0, p0 = 0, kb_lo = 0;
        const bool lat = task < n_lat;
        if (kind == 0) {
            if (lat) {
                const int rp = task & 15; head = (task >> 4) & 15; b = task >> 8; rg = 2 * rp + (c >> 4); qh = 0;
                tq0 = b * TPB + CTX + rg * 64 + 16 * w + (c & 15) - c;
                int a0 = 2 * rp - 4; a0 = a0 < 0 ? 0 : (a0 > 24 ? 24 : a0);
                int a1 = 2 * rp - 3; a1 = a1 < 0 ? 0 : (a1 > 24 ? 24 : a1);
                rlo = a0; nt = 4 + (a1 + 8 - a0); r0w = (c >> 4) ? a1 : a0;
            } else { const int u = task - n_lat; const int qb = u & 1; head = (u >> 1) & 15; b = u >> 5; tq0 = b * TPB + qb * 128 + w * 32; nt = 4; }
            kmap = head;
        } else {
            if (lat) {
                const int qb = task & 63; kmap = (task >> 6) & 3; b = task >> 8; p0 = qb * 32; tq0 = b * TPB + CTX + p0;
                int lo = p0 - 128; lo = lo < 0 ? 0 : lo; kb_lo = lo & ~63;
                int hi = p0 + 160; hi = hi > SEQ ? SEQ : hi; hi = (hi + 63) & ~63; nt = 4 + (hi - kb_lo) / 64;
            } else { const int u = task - n_lat; const int qb = u & 7; kmap = (u >> 3) & 3; b = u >> 5; tq0 = b * TPB + qb * 32; nt = 4; }
            head = kmap * 4 + w;
        }
#define KEY0(it) ((it) < 4 ? 64 * (it) : (kind == 0 ? CTX + (rlo + (it) - 4) * 64 : CTX + kb_lo + ((it) - 4) * 64))
        const bf16* kg = cx.K() + (size_t)(b * TPB + srow) * kw + kmap * 64 + sch * 8;
        const bf16* vg = cx.VT() + ((size_t)b * vw + kmap * 64 + srow) * TPB + sch * 8;
#define A_LOAD(it, buf) do { const int k0_ = KEY0(it); LAS unsigned char* b_ = cx.lds + (buf) * 16384 + tid * 16; \
                        glds16(kg + (size_t)k0_ * kw, b_); glds16(kg + (size_t)(k0_ + 32) * kw, b_ + 4096); \
                        glds16(vg + k0_, b_ + 8192); glds16(vg + (size_t)32 * TPB + k0_, b_ + 8192 + 4096); } while (0)
        __syncthreads();
        float m = NEG, l = 0.f;
        if (kind == 2) { m = sinks[head] * LOG2E; l = (h == 0) ? 1.f : 0.f; asm volatile("" : "+v"(m)); }
        { const bf16* qp = cx.Q() + (size_t)(tq0 + c) * D + head * 64 + 8 * h;
#pragma unroll
          for (int s4 = 0; s4 < 4; ++s4) glds16(qp + 16 * s4, qreg + s4 * 1024); }
        if (kind == 0 && lat && tid < 128) glds16(rpb + head * 512 + tid * 4, (LAS unsigned char*)rpbs + tid * 16);
#pragma unroll
        for (int s = 0; s < 2; ++s) if (s < nt) A_LOAD(s, s);
        f32x16 O[2];
#pragma unroll
        for (int db = 0; db < 2; ++db)
#pragma unroll
            for (int i = 0; i < 16; ++i) O[db][i] = 0.f;
        const int qc = 16 * w + (c & 15); int c0 = qc - 8; c0 = c0 < 0 ? 0 : (c0 > 48 ? 48 : c0);
        int kbase = 16 * w - 8; kbase = kbase < 0 ? 0 : (kbase > 32 ? 32 : kbase);
        const unsigned xkn = ((kbase + pr) >> 1) & 7;
        const int qpos = p0 + c;
        bf16x8 qf[4];
        int stg = 0, istg = 2;
#pragma unroll 1
        for (int it = 0; it < nt; ++it) {
            if (it + 1 < nt) asm volatile("s_waitcnt vmcnt(4)" ::: "memory");
            else asm volatile("s_waitcnt vmcnt(0)" ::: "memory");
            __builtin_amdgcn_s_barrier();
            asm volatile("" ::: "memory");
            if (it + 2 < nt) A_LOAD(it + 2, istg);
            __builtin_amdgcn_sched_barrier(0);
            if (it == 0) {
#pragma unroll
                for (int s4 = 0; s4 < 4; ++s4) qf[s4] = *(LAS bf16x8*)(qreg + s4 * 1024);
            }
            LAS unsigned char* kb = cx.lds + stg * 16384; LAS unsigned char* vb = kb + 8192;
            if (kind == 0 && it >= 4) {
                const int ry = rlo + it - 4;
                f32x16 sa;
#pragma unroll
                for (int i = 0; i < 16; ++i) sa[i] = 0.f;
#pragma unroll
                for (int s4 = 0; s4 < 4; ++s4) {
                    const bf16x8 ka = *(LAS bf16x8*)(kb + (kbase + pr) * 128 + (((2 * s4 + h) ^ xkn) << 4));
                    sa = MFMA(ka, qf[s4], sa);
                }
                const bool rowok = (ry >= r0w) && (ry <= r0w + 7);
                int dyi = ry - rg + 7; dyi = dyi < 0 ? 0 : (dyi > 14 ? 14 : dyi);
                const LAS float* rrow = rpbs + dyi * 31;
                int dwin = rowok ? (kbase + 8 * h - c0) : 0x40000000;
                int dci = kbase + 8 * h - qc + 15;
                asm volatile("" : "+v"(dwin), "+v"(dci));
#pragma unroll
                for (int i = 0; i < 16; ++i) {
                    const int off = (i & 7) + 16 * (i >> 3);
                    int ci = dci + off; ci = ci < 0 ? 0 : (ci > 30 ? 30 : ci);
                    const bool ok = (unsigned)(dwin + off) < 16u;
                    sa[i] = ok ? __builtin_fmaf(sa[i], SM_C, rrow[ci]) : NEG;
                }
                float alpha; bf16x8 pf[2];
                const bool resc = softmax_tile<false>(sa, m, l, alpha, pf);
                if (resc) {
#pragma unroll
                    for (int db = 0; db < 2; ++db)
#pragma unroll
                        for (int i = 0; i < 16; ++i) O[db][i] *= alpha;
                }
                const int kb8 = kbase >> 3;
#pragma unroll
                for (int db = 0; db < 2; ++db)
#pragma unroll
                    for (int k2 = 0; k2 < 2; ++k2) {
                        const bf16x8 vf = *(LAS bf16x8*)(vb + (32 * db + c) * 128 + (((kb8 + 2 * k2 + h) ^ xv) << 4));
                        O[db] = MFMA(vf, pf[k2], O[db]);
                    }
            } else {
                f32x16 sa, sb;
#pragma unroll
                for (int i = 0; i < 16; ++i) { sa[i] = 0.f; sb[i] = 0.f; }
#pragma unroll
                for (int s4 = 0; s4 < 4; ++s4) {
                    const unsigned co = (unsigned)(((2 * s4 + h) ^ xk) << 4);
                    const bf16x8 ka = *(LAS bf16x8*)(kb + pr * 128 + co), kb2 = *(LAS bf16x8*)(kb + (32 + pr) * 128 + co);
                    sa = MFMA(ka, qf[s4], sa); sb = MFMA(kb2, qf[s4], sb);
                }
                bool resc; float alpha; bf16x8 pf[4];
                if (it < 4) {
                    resc = softmax_tile2<true>(sa, sb, m, l, alpha, pf);
                } else {
                    const int kb0 = kb_lo + (it - 4) * 64;
                    if (kb0 < p0 - 97 || kb0 > p0 + 65) {
                        int dq = kb0 + 8 * h - qpos + 128; asm volatile("" : "+v"(dq));
#pragma unroll
                        for (int i = 0; i < 16; ++i) {
                            const int off = (i & 7) + 16 * (i >> 3);
                            sa[i] = ((unsigned)(dq + off) <= 256u) ? sa[i] : NEG;
                            sb[i] = ((unsigned)(dq + off + 32) <= 256u) ? sb[i] : NEG;
                        }
                    }
                    resc = softmax_tile2<true>(sa, sb, m, l, alpha, pf);
                }
                if (resc) {
#pragma unroll
                    for (int db = 0; db < 2; ++db)
#pragma unroll
                        for (int i = 0; i < 16; ++i) O[db][i] *= alpha;
                }
#pragma unroll
                for (int db = 0; db < 2; ++db) {
#pragma unroll
                    for (int k4 = 0; k4 < 4; ++k4) {
                        const bf16x8 vf = *(LAS bf16x8*)(vb + (32 * db + c) * 128 + (((2 * k4 + h) ^ xv) << 4));
                        O[db] = MFMA(vf, pf[k4], O[db]);
                    }
                }
            }
            asm volatile("" ::: "memory");
            stg = (stg == 2) ? 0 : stg + 1; istg = (istg == 2) ? 0 : istg + 1;
        }
#undef KEY0
#undef A_LOAD
        l += __shfl_xor(l, 32);
        store_o<2>(O, 1.f / l, cx.O() + (size_t)(tq0 + c) * D + head * 64, h);
    }
}

DI void attn_block_da(const Ctx& cx, int layer, bool need_ctx, int vbid) {
    const int tid = cx.tid, lane = cx.lane, w = cx.wave, c = lane & 31, h = lane >> 5;
    const int n_lat = NB * 8 * 16, n_tasks = n_lat + (need_ctx ? NB * 8 * 2 : 0);
    const float* lp = cx.in(13);
    const float d1 = wave_sum(lp[lane] * lp[64 + lane]), d2 = wave_sum(lp[128 + lane] * lp[192 + lane]);
    const float lam_init = 0.8f - 0.6f * __expf(-0.3f * (float)layer);
    const float lam = __expf(d1) - __expf(d2) + lam_init;
    const float* sg = cx.in(14);
    const int krow = tid >> 3, kch = (tid & 7) ^ ((krow >> 1) & 7), vdim = tid >> 2, vch = (tid & 3) ^ ((vdim >> 2) & 3);
    const int pr = pi32(c);
    const unsigned xk = (pr >> 1) & 7, xv = (c >> 2) & 3;
    LAS unsigned char* qlds = cx.lds + 49152 + w * 4096 + lane * 16;
    for (int base_ = 0; base_ < n_tasks; base_ += gridDim.x) {
        const int task = base_ + ((base_ + (int)gridDim.x <= n_tasks) ? vbid : (int)blockIdx.x);
        if (task >= n_tasks) break;
        int b, head, tq0, nt;
        if (task < n_lat) { const int qb = task & 15; head = (task >> 4) & 7; b = task >> 7; tq0 = b * TPB + CTX + qb * 128 + w * 32; nt = TPB / 32; }
        else { const int u = task - n_lat; const int qb = u & 1; head = (u >> 1) & 7; b = u >> 4; tq0 = b * TPB + qb * 128 + w * 32; nt = CTX / 32; }
        const bf16* kg = cx.K() + (size_t)(b * TPB + krow) * D + head * 128 + kch * 8;
        const bf16* vg = cx.VT() + ((size_t)b * D + head * 128 + vdim) * TPB + vch * 8;
#define D_LOAD(it, buf) do { const int k0_ = 32 * (it); LAS unsigned char* b_ = cx.lds + (buf) * 16384 + tid * 16; \
                        glds16(kg + (size_t)k0_ * D, b_); glds16(kg + (size_t)k0_ * D + 64, b_ + 4096); \
                        glds16(vg + k0_, b_ + 8192); glds16(vg + (size_t)64 * TPB + k0_, b_ + 8192 + 4096); } while (0)
        __syncthreads();
        bf16x8 q1f[4];
        { const bf16* qp = cx.Q() + (size_t)(tq0 + c) * D + head * 128 + 8 * h;
#pragma unroll
          for (int s4 = 0; s4 < 4; ++s4) q1f[s4] = ldg8(qp + 64 + 16 * s4);
#pragma unroll
          for (int s4 = 0; s4 < 4; ++s4) asm volatile("" : "+v"(q1f[s4]));
#pragma unroll
          for (int s4 = 0; s4 < 4; ++s4) glds16(qp + 16 * s4, qlds + s4 * 1024); }
#pragma unroll
        for (int s = 0; s < 2; ++s) if (s < nt) D_LOAD(s, s);
        float m0 = NEG, l0 = 0.f, m1 = NEG, l1 = 0.f;
        f32x16 O0[4], O1[4];
#pragma unroll
        for (int db = 0; db < 4; ++db)
#pragma unroll
            for (int i = 0; i < 16; ++i) { O0[db][i] = 0.f; O1[db][i] = 0.f; }
        int stg = 0, istg = 2;
#pragma unroll 1
        for (int it = 0; it < nt; ++it) {
            if (it + 1 < nt) asm volatile("s_waitcnt vmcnt(4)" ::: "memory");
            else asm volatile("s_waitcnt vmcnt(0)" ::: "memory");
            __builtin_amdgcn_s_barrier();
            asm volatile("" ::: "memory");
            if (it + 2 < nt) D_LOAD(it + 2, istg);
            __builtin_amdgcn_sched_barrier(0);
            __builtin_amdgcn_iglp_opt(IGLP_ATT);
            LAS unsigned char* kb = cx.lds + stg * 16384; LAS unsigned char* vb = kb + 8192;
            f32x16 s0, s1;
#pragma unroll
            for (int i = 0; i < 16; ++i) { s0[i] = 0.f; s1[i] = 0.f; }
#pragma unroll
            for (int s4 = 0; s4 < 4; ++s4) {
                const unsigned co = (unsigned)(((2 * s4 + h) ^ xk) << 4);
                const bf16x8 k0f = *(LAS bf16x8*)(kb + pr * 128 + co), q0f = *(LAS bf16x8*)(qlds + s4 * 1024);
                s0 = MFMA(k0f, q0f, s0);
            }
#pragma unroll
            for (int s4 = 0; s4 < 4; ++s4) {
                const unsigned co = (unsigned)(((2 * s4 + h) ^ xk) << 4);
                const bf16x8 k1f = *(LAS bf16x8*)(kb + 4096 + pr * 128 + co);
                s1 = MFMA(k1f, q1f[s4], s1);
            }
            __builtin_amdgcn_sched_barrier(0);
            float a0; bf16x8 pf0[2];
            const bool r0 = softmax_tile<true>(s0, m0, l0, a0, pf0);
            float a1; bf16x8 pf1[2];
            const bool r1 = softmax_tile<true>(s1, m1, l1, a1, pf1);
            if (r0 || r1) {
#pragma unroll
                for (int db = 0; db < 4; ++db)
#pragma unroll
                    for (int i = 0; i < 16; ++i) { O0[db][i] *= a0; O1[db][i] *= a1; }
            }
            __builtin_amdgcn_s_setprio(1);
#pragma unroll
            for (int db = 0; db < 4; ++db) {
                bf16x8 vf[2];
#pragma unroll
                for (int k2 = 0; k2 < 2; ++k2) vf[k2] = *(LAS bf16x8*)(vb + (32 * db + c) * 64 + (((2 * k2 + h) ^ xv) << 4));
#pragma unroll
                for (int k2 = 0; k2 < 2; ++k2) { O0[db] = MFMA(vf[k2], pf0[k2], O0[db]); O1[db] = MFMA(vf[k2], pf1[k2], O1[db]); }
            }
            __builtin_amdgcn_s_setprio(0);
            asm volatile("" ::: "memory");
            stg = (stg == 2) ? 0 : stg + 1; istg = (istg == 2) ? 0 : istg + 1;
        }
#undef D_LOAD
        l0 += __shfl_xor(l0, 32); l1 += __shfl_xor(l1, 32);
        const int lane_e = __builtin_amdgcn_mbcnt_hi(~0u, __builtin_amdgcn_mbcnt_lo(~0u, 0u));
        const int c_e = lane_e & 31, h_e = lane_e >> 5;
        const float i0 = 1.f / l0, i1 = lam / l1;
        float ss = 0.f;
#pragma unroll
        for (int db = 0; db < 4; ++db)
#pragma unroll
            for (int i = 0; i < 16; ++i) { const float o = O0[db][i] * i0 - O1[db][i] * i1; O0[db][i] = o; ss += o * o; }
        ss += __shfl_xor(ss, 32);
        const float rn = rsqrtf(ss * (1.f / 128.f) + EPS) * (1.f - lam_init);
        bf16* orow = cx.O() + (size_t)(tq0 + c_e) * D + head * 128;
#pragma unroll
        for (int db = 0; db < 4; ++db)
#pragma unroll
            for (int g = 0; g < 4; ++g) {
                const int dim = 32 * db + 8 * g + 4 * h_e;
                const f32x4 gg = *(const f32x4*)(sg + dim);
                u32x2 wv; wv.x = pk2(O0[db][4 * g] * rn * gg[0], O0[db][4 * g + 1] * rn * gg[1]); wv.y = pk2(O0[db][4 * g + 2] * rn * gg[2], O0[db][4 * g + 3] * rn * gg[3]);
                *(u32x2*)(orow + dim) = wv;
            }
    }
}

DI void load_row(const float* row, f32x4 (&v)[4], int lane) {
#pragma unroll
    for (int j = 0; j < 4; ++j) v[j] = ((const f32x4*)row)[lane + 64 * j];
}
DI void load_row_bf16(const bf16* row, f32x4 (&v)[4], int lane) {
#pragma unroll
    for (int j = 0; j < 4; ++j) { const u32x2 a = ((const u32x2*)row)[lane + 64 * j];
        v[j][0] = __builtin_bit_cast(float, a.x << 16); v[j][1] = __builtin_bit_cast(float, a.x & 0xffff0000u);
        v[j][2] = __builtin_bit_cast(float, a.y << 16); v[j][3] = __builtin_bit_cast(float, a.y & 0xffff0000u); }
}
DI void norm_mod(f32x4 (&v)[4], const float* g, const float* sh, const float* sc, int lane) {
    float ss = 0.f;
#pragma unroll
    for (int j = 0; j < 4; ++j) ss += (v[j][0] * v[j][0] + v[j][1] * v[j][1]) + (v[j][2] * v[j][2] + v[j][3] * v[j][3]);
    const float rn = rsqrtf(wave_sum(ss) * (1.f / D) + EPS);
#pragma unroll
    for (int j = 0; j < 4; ++j) {
        const f32x4 gg = ((const f32x4*)g)[lane + 64 * j], s1 = ((const f32x4*)sc)[lane + 64 * j], s0 = ((const f32x4*)sh)[lane + 64 * j];
#pragma unroll
        for (int e = 0; e < 4; ++e) v[j][e] = (v[j][e] * rn * gg[e]) * (1.f + s1[e]) + s0[e];
    }
}
DI void store_row_bf16(bf16* row, const f32x4 (&v)[4], int lane) {
#pragma unroll
    for (int j = 0; j < 4; ++j) { u32x2 w; w.x = pk2(v[j][0], v[j][1]); w.y = pk2(v[j][2], v[j][3]); ((u32x2*)row)[lane + 64 * j] = w; }
}

struct ConvTask { const float* src; bf16* dst; int N, K; };
DI ConvTask prologue_task(const Ctx& cx, int item, int lane) {
    const int layer = item < 2048 ? 0 : (item < 4096 ? 1 : (item < 5376 ? 2 : 3));
    const int u = item - (layer == 0 ? 0 : (layer == 1 ? 2048 : (layer == 2 ? 4096 : 5376)));
    const int kind = layer % 3, NQ = (kind == 2) ? 1536 : 3072, nq = 16 * (NQ / 32);
    const float* W; bf16* WT; int N, kt, nt;
    if (u < nq) { W = (kind == 0) ? cx.in(9) + (size_t)(layer / 3) * D * 3072 : (kind == 1 ? cx.in(12) : cx.in(16)); WT = cx.wqkv(layer); N = NQ; kt = u / (NQ / 32); nt = u - kt * (NQ / 32); }
    else { const int v = u - nq; W = (kind == 0) ? cx.in(11) + (size_t)(layer / 3) * D * D : (kind == 1 ? cx.in(15) : cx.in(18)); WT = cx.wo(layer); N = D; kt = v >> 5; nt = v & 31; }
    ConvTask t;
    t.src = W + (size_t)(kt * 64 + (lane >> 3)) * N + nt * 32 + (lane & 7) * 4;
    t.dst = WT + (size_t)(nt * 32 + (lane >> 3)) * D + kt * 64 + (lane & 7) * 8;
    t.N = N; t.K = D;
    return t;
}
constexpr int PRO_NT = 7424;
DI void prologue_convert(const Ctx& cx, int first, int stride) {
    const int lane = cx.lane;
    LAS float* scr = (LAS float*)(cx.lds + 36864) + cx.wave * (64 * 33);
#define PV_LOAD(X, task) do { const ConvTask ct_ = prologue_task(cx, (task), lane); \
        _Pragma("unroll") for (int p = 0; p < 8; ++p) X[p] = *(const f32x4*)(ct_.src + (size_t)(8 * p) * ct_.N); } while (0)
#define PV_PROC(X, task) do { const ConvTask ct_ = prologue_task(cx, (task), lane); \
        _Pragma("unroll") for (int p = 0; p < 8; ++p) { LAS float* d = scr + ((lane >> 3) + 8 * p) * 33 + (lane & 7) * 4; d[0] = X[p][0]; d[1] = X[p][1]; d[2] = X[p][2]; d[3] = X[p][3]; } \
        asm volatile("s_waitcnt lgkmcnt(0)" ::: "memory"); \
        _Pragma("unroll") for (int p = 0; p < 4; ++p) { const LAS float* s = scr + ((lane & 7) * 8) * 33 + (lane >> 3) + 8 * p; \
            u32x4 o; o.x = pk2(s[0], s[33]); o.y = pk2(s[2 * 33], s[3 * 33]); o.z = pk2(s[4 * 33], s[5 * 33]); o.w = pk2(s[6 * 33], s[7 * 33]); \
            *(u32x4*)(ct_.dst + (size_t)(8 * p) * ct_.K) = o; } \
        asm volatile("s_waitcnt lgkmcnt(0)" ::: "memory"); } while (0)
    f32x4 xa[8], xb[8];
    int task = first;
    if (task < PRO_NT) PV_LOAD(xa, task);
#pragma unroll 1
    while (task < PRO_NT) {
        const int t2 = task + stride, t3 = t2 + stride;
        if (t2 < PRO_NT) PV_LOAD(xb, t2);
        PV_PROC(xa, task);
        if (t3 < PRO_NT) PV_LOAD(xa, t3);
        if (t2 < PRO_NT) PV_PROC(xb, t2);
        task = t3;
    }
#undef PV_LOAD
#undef PV_PROC
}

DI void phase_prologue(const Ctx& cx) {
    LAS float* condS = (LAS float*)cx.lds;
    const float* cin = cx.in(1); const float* cctx = cx.in(3);
    for (int i = cx.tid; i < 9 * 1024; i += NTHREADS) { const int rr = i >> 10, k = i & 1023; const float v = (rr < 8) ? cin[rr * 1024 + k] : cctx[k]; condS[i] = silu(v); }
    __syncthreads();
    const float* ada_w = cx.in(4); const float* ada_b = cx.in(5);
    LAS float* red16 = (LAS float*)(cx.lds + 9 * 1024 * 4);
    for (int task = blockIdx.x; task < 4 * 96; task += gridDim.x) {
        const int layer = task / 96, cc = task % 96, r = cx.lane >> 4, cq = cx.lane & 15;
        const float* W = ada_w + (size_t)layer * D * 6144 + cc * 64 + 4 * cq;
        float acc[9][4];
#pragma unroll
        for (int rr = 0; rr < 9; ++rr)
#pragma unroll
            for (int e = 0; e < 4; ++e) acc[rr][e] = 0.f;
        const int k0 = cx.wave * 256 + r;
#pragma unroll 1
        for (int kb = 0; kb < 256; kb += 64) {
            f32x4 wv[16];
#pragma unroll
            for (int i = 0; i < 16; ++i) wv[i] = *(const f32x4*)(W + (size_t)(k0 + kb + 4 * i) * 6144);
#pragma unroll
            for (int i = 0; i < 16; ++i) {
#pragma unroll
                for (int rr = 0; rr < 9; ++rr) { const float cv = condS[rr * 1024 + k0 + kb + 4 * i];
#pragma unroll
                    for (int e = 0; e < 4; ++e) acc[rr][e] += cv * wv[i][e]; }
            }
        }
#pragma unroll
        for (int rr = 0; rr < 9; ++rr) *(LAS f32x4*)(red16 + ((cx.wave * 4 + r) * 9 + rr) * 64 + 4 * cq) = f32x4{acc[rr][0], acc[rr][1], acc[rr][2], acc[rr][3]};
        __syncthreads();
        for (int i = cx.tid; i < 9 * 64; i += NTHREADS) {
            const int rr = i >> 6, ln = i & 63;
            float s = 0.f;
#pragma unroll
            for (int g = 0; g < 16; ++g) s += red16[(g * 9 + rr) * 64 + ln];
            cx.mod()[((size_t)layer * 9 + rr) * 6144 + cc * 64 + ln] = s + ada_b[layer * 6144 + cc * 64 + ln];
        }
        __syncthreads();
    }
    {
        const int ng = (4 * 96 < (int)gridDim.x) ? 4 * 96 : (int)gridDim.x;
        const int nslots = ng * 4 + ((int)gridDim.x - ng) * 4 * 3;
        const int gw = blockIdx.x * 4 + cx.wave;
        if ((int)blockIdx.x < ng) prologue_convert(cx, gw, nslots);
        else { const int s0 = ng * 4 + (gw - ng * 4) * 3; prologue_convert(cx, s0, nslots); prologue_convert(cx, s0 + 1, nslots); prologue_convert(cx, s0 + 2, nslots); }
    }
    {
        bf16* wr = cx.wr();
        for (int i = blockIdx.x * NTHREADS + cx.tid; i < DEPTH * D * 64; i += gridDim.x * NTHREADS) {
            const int rho = i & 63, k = (i >> 6) & 1023, layer = i >> 16;
            float v = 0.f;
            if (rho < 32) v = cx.in(21)[((size_t)layer * D + k) * 32 + rho];
            else if (rho < 36) v = cx.in(19)[((size_t)layer * D + k) * 4 + (rho - 32)];
            const unsigned hi = pk2(v, 0.f) & 0xffffu;
            const unsigned lo = pk2(v - bf2f((unsigned short)hi), 0.f) & 0xffffu;
            wr[((size_t)(layer * 2 + 0) * 64 + rho) * D + k] = (bf16)hi;
            wr[((size_t)(layer * 2 + 1) * 64 + rho) * D + k] = (bf16)lo;
        }
    }
    if (blockIdx.x == gridDim.x - 2) {
        for (int i = cx.tid; i < 2 * 16 * 512; i += NTHREADS) { const int s = i >> 9, e = i & 511; cx.rpbp()[i] = (e < 465) ? cx.in(10)[s * 465 + e] * LOG2E : 0.f; }
    }
    if (blockIdx.x == gridDim.x - 1) {
        for (int i = cx.tid; i < 64 * 16; i += NTHREADS) {
            const int pos = i >> 4, f = i & 15;
            const float tab4[4] = {1.f, 0.5623413251903491f, 0.31622776601683794f, 0.1778279410038923f};
            float inv = (f & 3) == 0 ? tab4[0] : ((f & 3) == 1 ? tab4[1] : ((f & 3) == 2 ? tab4[2] : tab4[3]));
            const int dec = f >> 2; inv *= (dec == 0 ? 1.f : (dec == 1 ? 0.1f : (dec == 2 ? 0.01f : 0.001f)));
            const float ang = (float)pos * inv;
            const double rev = (double)ang * 0.15915494309189535; const float fr = (float)(rev - (double)(long long)rev);
            cx.ropec()[i] = __builtin_amdgcn_cosf(fr); cx.ropes()[i] = __builtin_amdgcn_sinf(fr);
        }
    }
}

DI void phase_first_norm(const Ctx& cx) {
    const int gw = blockIdx.x * 4 + cx.wave, gstride = gridDim.x * 4;
    {
        for (int pair = (int)gridDim.x - 1 - (int)blockIdx.x; pair < DEPTH * 9; pair += (int)gridDim.x) {
            const int layer = pair / 9, row = pair % 9;
            const float* md = cx.mod() + ((size_t)layer * 9 + row) * 6144;
            const float* g = cx.in(7) + layer * D;
            float* gmo = cx.gm() + (size_t)pair * D;
            const float* wexp = cx.in(21) + (size_t)layer * D * 32; const float* wgrp = cx.in(19) + (size_t)layer * D * 4;
            float acc[36];
#pragma unroll
            for (int e = 0; e < 36; ++e) acc[e] = 0.f;
#pragma unroll
            for (int i = 0; i < 4; ++i) {
                const int k = cx.lane + 64 * (4 * cx.wave + i);
                gmo[k] = g[k] * (1.f + md[4096 + k]);
                const float sh = md[3072 + k];
                const f32x4* we = (const f32x4*)(wexp + (size_t)k * 32);
#pragma unroll
                for (int q = 0; q < 8; ++q) { const f32x4 w = we[q];
#pragma unroll
                    for (int e = 0; e < 4; ++e) acc[4 * q + e] += sh * w[e]; }
                const f32x4 wg = *(const f32x4*)(wgrp + (size_t)k * 4);
#pragma unroll
                for (int e = 0; e < 4; ++e) acc[32 + e] += sh * wg[e];
            }
#pragma unroll
            for (int e = 0; e < 36; ++e) acc[e] = wave_sum(acc[e]);
            LAS float* part = (LAS float*)cx.lds;
            if (cx.lane == 0) {
#pragma unroll
                for (int e = 0; e < 36; ++e) part[cx.wave * 36 + e] = acc[e];
            }
            __syncthreads();
            if (cx.tid < 36) {
                const float s = (part[cx.tid] + part[36 + cx.tid]) + (part[72 + cx.tid] + part[108 + cx.tid]);
                float* rco = cx.rc() + (size_t)pair * 64;
                rco[cx.tid] = s + (cx.tid < 32 ? cx.in(22)[layer * 32 + cx.tid] : cx.in(20)[layer * 4 + cx.tid - 32]);
            }
            __syncthreads();
        }
    }
#define P1_SRC(tt) ({ const int b_ = (tt) / TPB, j_ = (tt) - b_ * TPB; (j_ < CTX) ? cx.in(2) + (size_t)(b_ * CTX + j_) * D : cx.in(0) + (size_t)(b_ * SEQ + j_ - CTX) * D; })
    f32x4 nv[4];
    if (gw < T) load_row(P1_SRC(gw), nv, cx.lane);
    for (int t = gw; t < T; t += gstride) {
        const int b = t / TPB, j = t - b * TPB;
        f32x4 v[4];
#pragma unroll
        for (int q = 0; q < 4; ++q) v[q] = nv[q];
        if (t + gstride < T) load_row(P1_SRC(t + gstride), nv, cx.lane);
        store_row_bf16(cx.xres() + (size_t)t * D, v, cx.lane);
        const float* md = cx.mod() + (size_t)(j < CTX ? 8 : b) * 6144;
        norm_mod(v, cx.in(6), md, md + 1024, cx.lane);
        store_row_bf16(cx.H() + (size_t)t * D, v, cx.lane);
    }
#undef P1_SRC
}

DI void phase_norm_route(const Ctx& cx, int layer, bool last, bool dummy) {
    const int lane = cx.lane, c = lane & 31, h = lane >> 5, w = cx.wave;
    {
        int nhb = (T / 32) % (int)gridDim.x;
        if (4 * nhb >= (int)gridDim.x) nhb = 0;
        const int gw = ((int)blockIdx.x - nhb) * 4 + w, gstride = ((int)gridDim.x - nhb) * 4;
        for (int t = (gw < 0 ? T : gw); t < T; t += gstride) {
            const int b = t / TPB, j = t - b * TPB;
            if (last && j < CTX) continue;
            f32x4 v[4]; load_row_bf16(cx.xres() + (size_t)t * D, v, lane);
            const float* md = cx.mod() + ((size_t)layer * 9 + (j < CTX ? 8 : b)) * 6144;
            norm_mod(v, cx.in(7) + layer * D, md + 3072, md + 4096, lane);
            store_row_bf16(cx.H() + (size_t)t * D, v, lane);
        }
    }
    unsigned* cnt = cx.ctl() + CW_CNT + layer * 32 * 64 + (dummy ? 32 : 0);
    int* ltok_ = dummy ? (int*)cx.YP() : cx.ltok(); float* lw_ = dummy ? (float*)(cx.YP() + 4 * 1024 * 1024) : cx.lw();
    const bf16* whi = cx.wr() + (size_t)(layer * 2) * 64 * D + (size_t)c * D + 256 * w + 8 * h;
    LAS float* red = (LAS float*)cx.lds;
    LAS unsigned* hist = (LAS unsigned*)(cx.lds + 4 * 33 * 64 * 4);
    for (int task = blockIdx.x; task < T / 32; task += gridDim.x) {
        const int t0 = task * 32, b = t0 / TPB, j0 = t0 - b * TPB;
        if (last && j0 < CTX) continue;
        const int t = t0 + c, mrow = (j0 < CTX ? 8 : b);
        const bf16* xrow = cx.xres() + (size_t)t * D + 256 * w + 8 * h;
        const float* gmv = cx.gm() + ((size_t)layer * 9 + mrow) * D + 256 * w + 8 * h;
        float ss = 0.f;
        f32x16 acc0, acc1;
#pragma unroll
        for (int i = 0; i < 16; ++i) { acc0[i] = 0.f; acc1[i] = 0.f; }
        LAS unsigned char* park = cx.lds + w * 16384 + lane * 16;
#pragma unroll
        for (int s = 0; s < 16; ++s) glds16(xrow + 16 * s, park + s * 1024);
        asm volatile("s_waitcnt vmcnt(0)" ::: "memory");
#pragma unroll 4
        for (int s = 0; s < 16; ++s) {
            float x[8];
            { const u32x4 xq = *(LAS u32x4*)(park + s * 1024);
              const f32x4 a = {__builtin_bit_cast(float, xq.x << 16), __builtin_bit_cast(float, xq.x & 0xffff0000u), __builtin_bit_cast(float, xq.y << 16), __builtin_bit_cast(float, xq.y & 0xffff0000u)};
              const f32x4 bq = {__builtin_bit_cast(float, xq.z << 16), __builtin_bit_cast(float, xq.z & 0xffff0000u), __builtin_bit_cast(float, xq.w << 16), __builtin_bit_cast(float, xq.w & 0xffff0000u)};
              const f32x4 g0 = *(const f32x4*)(gmv + 16 * s), g1 = *(const f32x4*)(gmv + 16 * s + 4);
              ss += (a[0] * a[0] + a[1] * a[1]) + (a[2] * a[2] + a[3] * a[3]) + (bq[0] * bq[0] + bq[1] * bq[1]) + (bq[2] * bq[2] + bq[3] * bq[3]);
#pragma unroll
              for (int e = 0; e < 4; ++e) { x[e] = a[e] * g0[e]; x[4 + e] = bq[e] * g1[e]; } }
            u32x4 hi, lo;
            hi.x = pk2(x[0], x[1]); hi.y = pk2(x[2], x[3]); hi.z = pk2(x[4], x[5]); hi.w = pk2(x[6], x[7]);
            lo.x = pk2(x[0] - __builtin_bit_cast(float, hi.x << 16), x[1] - __builtin_bit_cast(float, hi.x & 0xffff0000u));
            lo.y = pk2(x[2] - __builtin_bit_cast(float, hi.y << 16), x[3] - __builtin_bit_cast(float, hi.y & 0xffff0000u));
            lo.z = pk2(x[4] - __builtin_bit_cast(float, hi.z << 16), x[5] - __builtin_bit_cast(float, hi.z & 0xffff0000u));
            lo.w = pk2(x[6] - __builtin_bit_cast(float, hi.w << 16), x[7] - __builtin_bit_cast(float, hi.w & 0xffff0000u));
            const bf16x8 bhi = __builtin_bit_cast(bf16x8, hi), blo = __builtin_bit_cast(bf16x8, lo);
            const bf16x8 ah0 = ldg8(whi + 16 * s), ah1 = ldg8(whi + 32 * D + 16 * s), al0 = ldg8(whi + 64 * D + 16 * s), al1 = ldg8(whi + 96 * D + 16 * s);
            acc0 = MFMA(ah0, bhi, acc0); acc0 = MFMA(al0, bhi, acc0); acc0 = MFMA(ah0, blo, acc0);
            acc1 = MFMA(ah1, bhi, acc1); acc1 = MFMA(al1, bhi, acc1); acc1 = MFMA(ah1, blo, acc1);
        }
        __syncthreads();
        LAS float* my = red + (size_t)w * 33 * 64 + lane;
#pragma unroll
        for (int i = 0; i < 16; ++i) { my[i * 64] = acc0[i]; my[(16 + i) * 64] = acc1[i]; }
        my[32 * 64] = ss;
        __syncthreads();
        if (w == 0) {
#pragma unroll
            for (int ww = 1; ww < 4; ++ww) {
                const LAS float* o = red + (size_t)ww * 33 * 64 + lane;
#pragma unroll
                for (int i = 0; i < 16; ++i) { acc0[i] += o[i * 64]; acc1[i] += o[(16 + i) * 64]; }
                ss += o[32 * 64];
            }
            ss += __shfl_xor(ss, 32);
            const float rn = rsqrtf(ss * (1.f / D) + EPS);
            const float* rcv = cx.rc() + ((size_t)layer * 9 + mrow) * 64;
            float gl[4];
#pragma unroll
            for (int g = 0; g < 4; ++g) gl[g] = __shfl(acc1[g], c) * rn + rcv[32 + g];
            int gi = 0; float gmx = gl[0];
#pragma unroll
            for (int g = 1; g < 4; ++g) if (gl[g] > gmx) { gmx = gl[g]; gi = g; }
            float gs = 0.f;
#pragma unroll
            for (int g = 0; g < 4; ++g) gs += __expf(gl[g] - gmx);
            const float gp = 1.f / gs;
            float mine[4], other[4], el[8];
#pragma unroll
            for (int e = 0; e < 4; ++e) {
                float xv = acc0[e];
#pragma unroll
                for (int g = 1; g < 4; ++g) xv = (gi == g) ? acc0[4 * g + e] : xv;
                mine[e] = xv * rn + rcv[gi * 8 + 4 * h + e];
            }
#pragma unroll
            for (int e = 0; e < 4; ++e) other[e] = __shfl_xor(mine[e], 32);
#pragma unroll
            for (int e = 0; e < 4; ++e) { el[e] = (h == 0) ? mine[e] : other[e]; el[4 + e] = (h == 0) ? other[e] : mine[e]; }
            int i1 = 0; float v1 = el[0];
#pragma unroll
            for (int e = 1; e < 8; ++e) if (el[e] > v1) { v1 = el[e]; i1 = e; }
            int i2 = 0; float v2 = -3.0e38f;
#pragma unroll
            for (int e = 0; e < 8; ++e) if (e != i1 && el[e] > v2) { v2 = el[e]; i2 = e; }
            const float ex = __expf(v2 - v1);
            const float w1 = gp / (1.f + ex), w2 = gp * ex / (1.f + ex);
            if (h == 0) {
                const int e1 = gi * 8 + i1, e2 = gi * 8 + i2;
                hist[c] = 0u;
                asm volatile("s_waitcnt lgkmcnt(0)" ::: "memory");
                const unsigned r1 = __hip_atomic_fetch_add(&hist[e1], 1u, __ATOMIC_RELAXED, __HIP_MEMORY_SCOPE_WORKGROUP);
                const unsigned r2 = __hip_atomic_fetch_add(&hist[e2], 1u, __ATOMIC_RELAXED, __HIP_MEMORY_SCOPE_WORKGROUP);
                asm volatile("s_waitcnt lgkmcnt(0)" ::: "memory");
                const unsigned n = hist[c];
                unsigned bs = 0u;
                if (n) bs = atomicAdd(&cnt[c * 64], n);
                hist[32 + c] = bs;
                asm volatile("s_waitcnt lgkmcnt(0)" ::: "memory");
                const unsigned s1 = hist[32 + e1] + r1, s2 = hist[32 + e2] + r2;
                ltok_[(size_t)e1 * LCAP + s1] = t * 2;     lw_[(size_t)e1 * LCAP + s1] = w1;
                ltok_[(size_t)e2 * LCAP + s2] = t * 2 + 1; lw_[(size_t)e2 * LCAP + s2] = w2;
            }
        }
        __syncthreads();
    }
}

DI ConvTask conv_task(const Ctx& cx, int layer, int task, int lane) {
    const int e = task / 768, u = task - e * 768, which = u >> 8, v = u & 255;
    const float* W; bf16* WT; int K, N, kt, nt;
    if (which == 0) { W = cx.in(23) + ((size_t)layer * NEXP + e) * D * DEXP; WT = cx.wmg() + (size_t)e * DEXP * D; K = D; N = DEXP; kt = v >> 4; nt = v & 15; }
    else if (which == 1) { W = cx.in(24) + ((size_t)layer * NEXP + e) * D * DEXP; WT = cx.wmu() + (size_t)e * DEXP * D; K = D; N = DEXP; kt = v >> 4; nt = v & 15; }
    else { W = cx.in(25) + ((size_t)layer * NEXP + e) * DEXP * D; WT = cx.wmd() + (size_t)e * D * DEXP; K = DEXP; N = D; kt = v >> 5; nt = v & 31; }
    ConvTask t;
    t.src = W + (size_t)(kt * 64 + (lane >> 3)) * N + nt * 32 + (lane & 7) * 4;
    t.dst = WT + (size_t)(nt * 32 + (lane >> 3)) * K + kt * 64 + (lane & 7) * 8;
    t.N = N; t.K = K;
    return t;
}
DI void moe_convert(const Ctx& cx, int layer) {
    const int gw = blockIdx.x * 4 + cx.wave, nw = gridDim.x * 4;
    const int lane = cx.lane;
    constexpr int NT = NEXP * 768;
    LAS float* scr = (LAS float*)(cx.lds + 36864) + cx.wave * (64 * 33);
#define CV_LOAD(X, task) do { const ConvTask ct_ = conv_task(cx, layer, (task), lane); \
        _Pragma("unroll") for (int p = 0; p < 8; ++p) X[p] = *(const f32x4*)(ct_.src + (size_t)(8 * p) * ct_.N); } while (0)
#define CV_PROC(X, task) do { const ConvTask ct_ = conv_task(cx, layer, (task), lane); \
        _Pragma("unroll") for (int p = 0; p < 8; ++p) { LAS float* d = scr + ((lane >> 3) + 8 * p) * 33 + (lane & 7) * 4; d[0] = X[p][0]; d[1] = X[p][1]; d[2] = X[p][2]; d[3] = X[p][3]; } \
        asm volatile("s_waitcnt lgkmcnt(0)" ::: "memory"); \
        _Pragma("unroll") for (int p = 0; p < 4; ++p) { const LAS float* s = scr + ((lane & 7) * 8) * 33 + (lane >> 3) + 8 * p; \
            u32x4 o; o.x = pk2(s[0], s[33]); o.y = pk2(s[2 * 33], s[3 * 33]); o.z = pk2(s[4 * 33], s[5 * 33]); o.w = pk2(s[6 * 33], s[7 * 33]); \
            *(u32x4*)(ct_.dst + (size_t)(8 * p) * ct_.K) = o; } \
        asm volatile("s_waitcnt lgkmcnt(0)" ::: "memory"); } while (0)
    int nheavy = ((T / 32) % (int)gridDim.x) * 4;
    if (2 * nheavy >= nw) nheavy = 0;
    const bool heavy = gw < nheavy;
    const int S = nw - nheavy, base = gw - nheavy;
#define CV_ITEM(j) (heavy ? NT : base + S * (j))
    f32x4 xa[8], xb[8];
    int j = 0, task = CV_ITEM(0);
    if (task < NT) CV_LOAD(xa, task);
#pragma unroll 1
    while (task < NT) {
        const int t2 = CV_ITEM(j + 1), t3 = CV_ITEM(j + 2);
        if (t2 < NT) CV_LOAD(xb, t2);
        CV_PROC(xa, task);
        if (t3 < NT) CV_LOAD(xa, t3);
        if (t2 < NT) CV_PROC(xb, t2);
        task = t3; j += 2;
    }
#undef CV_ITEM
#undef CV_LOAD
#undef CV_PROC
}

DI void phase_combine(const Ctx& cx, int layer, bool last, bool dummy) {
    const int gw = blockIdx.x * 4 + cx.wave, gstride = gridDim.x * 4;
    for (int t = gw; t < T; t += gstride) {
        const int b = t / TPB, j = t - b * TPB;
        if (last && j < CTX) continue;
        bf16* xr = cx.xres() + (size_t)t * D;
        f32x4 v[4]; load_row_bf16(xr, v, cx.lane);
        const int mr = (j < CTX) ? 8 : b;
        const float* g2 = cx.mod() + ((size_t)layer * 9 + mr) * 6144 + 5120;
        const bf16* y0 = cx.YP() + (size_t)(2 * t) * D; const bf16* y1 = y0 + D;
#pragma unroll
        for (int jj = 0; jj < 4; ++jj) {
            const u32x2 a = ((const u32x2*)y0)[cx.lane + 64 * jj], bq = ((const u32x2*)y1)[cx.lane + 64 * jj];
            const f32x4 gg = ((const f32x4*)g2)[cx.lane + 64 * jj];
            float ya[4] = {bf2f((unsigned short)(a.x & 0xffff)), bf2f((unsigned short)(a.x >> 16)), bf2f((unsigned short)(a.y & 0xffff)), bf2f((unsigned short)(a.y >> 16))};
            float yb[4] = {bf2f((unsigned short)(bq.x & 0xffff)), bf2f((unsigned short)(bq.x >> 16)), bf2f((unsigned short)(bq.y & 0xffff)), bf2f((unsigned short)(bq.y >> 16))};
#pragma unroll
            for (int e = 0; e < 4; ++e) v[jj][e] += gg[e] * (ya[e] + yb[e]);
        }
        if (!last) {
            bf16* xw = dummy ? cx.Q() + (size_t)t * D : xr;
            store_row_bf16(xw, v, cx.lane);
            const float* md = cx.mod() + ((size_t)(layer + 1) * 9 + mr) * 6144;
            norm_mod(v, cx.in(6) + (layer + 1) * D, md, md + 1024, cx.lane);
            store_row_bf16(cx.H() + (size_t)t * D, v, cx.lane);
        } else {
            float ss = 0.f;
#pragma unroll
            for (int jj = 0; jj < 4; ++jj) ss += (v[jj][0] * v[jj][0] + v[jj][1] * v[jj][1]) + (v[jj][2] * v[jj][2] + v[jj][3] * v[jj][3]);
            const float rn = rsqrtf(wave_sum(ss) * (1.f / D) + EPS);
            float* orow = cx.out() + (size_t)(b * SEQ + j - CTX) * D;
#pragma unroll
            for (int jj = 0; jj < 4; ++jj) {
                const f32x4 gg = ((const f32x4*)cx.in(8))[cx.lane + 64 * jj];
                f32x4 o;
#pragma unroll
                for (int e = 0; e < 4; ++e) o[e] = v[jj][e] * rn * gg[e];
                ((f32x4*)orow)[cx.lane + 64 * jj] = o;
            }
        }
    }
}

DI void moe_directory(const Ctx& cx, int layer, LAS int* s_off, LAS int* s_toff) {
    if (cx.tid < 64) {
        const unsigned* cnt = cx.ctl() + CW_CNT + layer * 32 * 64;
        const int e = cx.lane;
        const int c = (e < NEXP) ? (int)cnt[e * 64] : 0;
        int o = c, to = (c + 127) >> 7;
#pragma unroll
        for (int d = 1; d < NEXP; d <<= 1) { const int a = __shfl_up(o, d), b2 = __shfl_up(to, d); if (e >= d) { o += a; to += b2; } }
        if (e < NEXP) { s_off[e + 1] = o; s_toff[e + 1] = to; }
        if (e == 0) { s_off[0] = 0; s_toff[0] = 0; }
    }
    __syncthreads();
}

__global__ void __launch_bounds__(NTHREADS, 2) fwd_kernel(Params p) {
    extern __shared__ __attribute__((aligned(16))) unsigned char lds_raw[];
    Ctx cx;
    cx.pp = (ParamsPtr)__builtin_amdgcn_kernarg_segment_ptr();
    cx.lds = (LAS unsigned char*)lds_raw;
    cx.tid = threadIdx.x; cx.lane = cx.tid & 63; cx.wave = __builtin_amdgcn_readfirstlane(cx.tid >> 6);
    volatile LAS unsigned* misc = (volatile LAS unsigned*)(cx.lds + LDS_MISC);
    LAS int* s_off = (LAS int*)(cx.lds + LDS_MISC + 64);
    LAS int* s_toff = (LAS int*)(cx.lds + LDS_MISC + 64 + 160);
    if (cx.tid < 2) misc[cx.tid] = 0u;
    __syncthreads();
    if (cx.pp->ph_hi - cx.pp->ph_lo > 1) (void)xcd_barrier_post((unsigned*)(cx.pp->ws + WS_CTL) + CW_BAR, misc);
    bool again_ = false;
    for (int ph = cx.pp->ph_lo; ; ) {
        asm volatile("" : "+s"(cx.pp));
        { int tid_ = threadIdx.x; asm volatile("" : "+v"(tid_)); cx.tid = tid_; cx.lane = tid_ & 63; cx.wave = __builtin_amdgcn_readfirstlane(tid_ >> 6); }
        if (ph == 0) phase_prologue(cx);
        else if (ph == 1) phase_first_norm(cx);
        else {
            const int layer = (ph - 2) / 7, sub = (ph - 2) % 7, kind = layer % 3;
#ifdef PROBE_REP
            const bool dummy = !again_ && ((PROBE_REP >> ph) & 1ull);
#else
            const bool dummy = false;
#endif
            const bool last = (layer == DEPTH - 1);
            const int vbid = (gridDim.x & 7) ? (int)blockIdx.x : (int)((blockIdx.x & 7) * (gridDim.x >> 3) + (blockIdx.x >> 3));
            if (sub == 0) {
                QkvOp op; op.A = cx.H(); op.kind = kind; op.Q = cx.Q(); op.Kb = cx.K(); op.VT = cx.VT(); op.rc = cx.ropec(); op.rs = cx.ropes();
                op.Wt = cx.wqkv(layer);
                if (kind == 2) { op.N = 1536; op.kw = 256; op.voff = 1280; op.vw = 256; }
                else { op.N = 3072; op.kw = D; op.voff = 2048; op.vw = D; }
                const int ntn = op.N / 128, ntiles = (T / 128) * ntn;
                for (int tile = blockIdx.x; tile < ntiles; tile += gridDim.x) {
                    op.m0 = (tile / ntn) * 128; op.n0 = (tile % ntn) * 128;
                    gemm_tile<2, 2, 64>(op, cx.lds, cx.tid);
                }
            } else if (sub == 1) {
                if (kind == 1) attn_block_da(cx, layer, !last, vbid); else attn_block_nasw(cx, kind, layer, !last, vbid);
            } else if (sub == 2) {
                OutOp op; op.A = cx.O(); op.xres = cx.xres(); op.xdst = dummy ? cx.Q() : cx.xres(); op.modl = cx.mod() + (size_t)layer * 9 * 6144;
                op.Wt = cx.wo(layer);
                for (int tile = vbid; tile < 1024; tile += gridDim.x) {
                    int mt = tile >> 3;
                    if (last) mt = (mt >> 4) * 18 + 2 + (mt & 15);
                    op.m0 = mt * 128; op.n0 = (tile & 7) * 128;
                    gemm_tile<2, 2, 64>(op, cx.lds, cx.tid);
                }
                if (!last) for (int u = blockIdx.x; u < 256; u += gridDim.x) {
                    op.m0 = 128 * 128 + (u >> 3) * 64; op.n0 = (u & 7) * 128;
                    gemm_tile<1, 2, 64>(op, cx.lds, cx.tid);
                }
            } else if (sub == 3) {
                if (blockIdx.x & 1) { moe_convert(cx, layer); __syncthreads(); }
                phase_norm_route(cx, layer, last, dummy);
                if (!(blockIdx.x & 1)) { __syncthreads(); moe_convert(cx, layer); }
#ifdef PROBE_CONV2
                moe_convert(cx, layer);
#endif
            } else if (sub == 4) {
                moe_directory(cx, layer, s_off, s_toff);
                const int ntiles = s_toff[NEXP] * 8;
                int ecur = 0;
                for (int tile = vbid; tile < ntiles; tile += gridDim.x) {
                    const int rtg = tile >> 3; int e = ecur;
                    while (s_toff[e + 1] <= rtg) ++e;
                    ecur = e;
                    GateUpOp op; op.H = cx.H(); op.cnt = s_off[e + 1] - s_off[e]; op.r0 = (rtg - s_toff[e]) * 128; op.f0 = (tile & 7) * 64;
                    op.WgT = cx.wmg() + (size_t)e * DEXP * D; op.WuT = cx.wmu() + (size_t)e * DEXP * D;
                    op.ltok = cx.ltok() + (size_t)e * LCAP; op.act = cx.ACT() + (size_t)s_off[e] * DEXP;
                    gemm_tile<2, 2, 64>(op, cx.lds, cx.tid);
                }
            } else if (sub == 5) {
                moe_directory(cx, layer, s_off, s_toff);
                const int ntiles = s_toff[NEXP] * 8;
                DownOp op, nop; op.yp = cx.YP(); nop.yp = op.yp;
#define F_SET(o, tl) do { const int rtg_ = (tl) >> 3; int e_ = ecur; while (s_toff[e_ + 1] <= rtg_) ++e_; ecur = e_; \
                    (o).cnt = s_off[e_ + 1] - s_off[e_]; (o).r0 = (rtg_ - s_toff[e_]) * 128; (o).n0 = ((tl) & 7) * 128; \
                    (o).act = cx.ACT() + (size_t)s_off[e_] * DEXP; (o).WdT = cx.wmd() + (size_t)e_ * D * DEXP; \
                    (o).ltok = cx.ltok() + (size_t)e_ * LCAP; (o).lw = cx.lw() + (size_t)e_ * LCAP; } while (0)
                int tile = vbid, ecur = 0; bool first = true;
                if (tile < ntiles) F_SET(op, tile);
                while (tile < ntiles) {
                    const int nt_ = tile + gridDim.x; const bool hn = nt_ < ntiles;
                    if (hn) F_SET(nop, nt_); else nop = op;
                    gemm_tile_x<2, 2, 64, true>(op, nop, hn, first, cx.lds, cx.tid);
                    op = nop; tile = nt_; first = false;
                }
#undef F_SET
            } else {
                phase_combine(cx, layer, last, dummy);
            }
        }
#ifdef PROBE_REP
        if (!again_ && ((PROBE_REP >> ph) & 1ull)) again_ = true; else { again_ = false; ++ph; }
#else
        ++ph;
#endif
        if (ph >= cx.pp->ph_hi) break;
        { XcdBarrier bar; bar.bar = cx.ctl() + CW_BAR; bar.x = xb_xcc_id(); bar.st = (volatile LAS unsigned*)(cx.lds + LDS_MISC); xcd_barrier(bar);
#ifdef PROBE_BAR2
          xcd_barrier(bar);
#endif
        }
    }
}

extern "C" void kernel_launch(void* const* d_in, const int* in_sizes, int n_in, void* d_out, int out_size, void* d_ws, size_t ws_size, hipStream_t stream) {
    static int grid = 0;
    if (grid == 0) {
        if (n_in != 26 || ws_size < WS_END) { fprintf(stderr, "kernel_launch: unexpected inputs (n_in %d) or workspace %zu < %zu\n", n_in, ws_size, (size_t)WS_END); grid = -1; return; }
        int dev = 0, cus = 0, per_cu = 0;
        (void)hipGetDevice(&dev);
        (void)hipDeviceGetAttribute(&cus, hipDeviceAttributeMultiprocessorCount, dev);
        if (hipFuncSetAttribute((const void*)fwd_kernel, hipFuncAttributeMaxDynamicSharedMemorySize, LDS_BYTES) != hipSuccess) { fprintf(stderr, "kernel_launch: hipFuncSetAttribute failed\n"); grid = -1; return; }
        if (hipOccupancyMaxActiveBlocksPerMultiprocessor(&per_cu, (const void*)fwd_kernel, NTHREADS, LDS_BYTES) != hipSuccess || per_cu < 1) { fprintf(stderr, "kernel_launch: occupancy query failed (%d)\n", per_cu); per_cu = 1; }
        (void)hipGetLastError();
        if (per_cu > 2) per_cu = 2;
        grid = cus * per_cu;
        fprintf(stderr, "kernel_launch: %d CUs x %d blocks\n", cus, per_cu);
    }
    if (grid < 0) return;
    (void)hipMemsetAsync((char*)d_ws + WS_CTL, 0, CTL_BYTES, stream);
    Params p{};
    for (int i = 0; i < 26; ++i) p.in[i] = (const float*)d_in[i];
    p.out = (float*)d_out; p.ws = (unsigned char*)d_ws;
#if ONE_LAUNCH
    p.ph_lo = 0; p.ph_hi = NPHASES;
    hipLaunchKernelGGL(fwd_kernel, dim3(grid), dim3(NTHREADS), LDS_BYTES, stream, p);
#else
    for (int ph = 0; ph < NPHASES; ++ph) {
        p.ph_lo = ph; p.ph_hi = ph + 1;
        hipLaunchKernelGGL(fwd_kernel, dim3(grid), dim3(NTHREADS), LDS_BYTES, stream, p);
    }
#endif
}
```

```cpp
#include <hip/hip_runtime.h>
#include <cstdio>
#include <cstdint>

#ifndef ONE_LAUNCH
#define ONE_LAUNCH 1
#define PROBE_REP 0ull
#ifndef IGLP_ATT
#define IGLP_ATT 3
#endif


#endif

#define DI __device__ __forceinline__
#define LAS __attribute__((address_space(3)))
typedef unsigned short bf16;
typedef short bf16x8 __attribute__((ext_vector_type(8)));
typedef float f32x16 __attribute__((ext_vector_type(16)));
typedef float f32x4 __attribute__((ext_vector_type(4)));
typedef float f32x2 __attribute__((ext_vector_type(2)));
typedef unsigned u32x4 __attribute__((ext_vector_type(4)));
typedef unsigned u32x2 __attribute__((ext_vector_type(2)));
typedef __bf16 bf16x2_t __attribute__((ext_vector_type(2)));
#define MFMA(a, b, c) __builtin_amdgcn_mfma_f32_32x32x16_bf16((a), (b), (c), 0, 0, 0)

constexpr int D = 1024, NB = 8, SEQ = 2048, CTX = 256, DEPTH = 4;
constexpr int TPB = CTX + SEQ;
constexpr int T = NB * TPB;
constexpr int NEXP = 32, DEXP = 512;
constexpr int LCAP = T;
constexpr float EPS = 1e-6f;
constexpr float LOG2E = 1.4426950408889634f;
constexpr float SM_C = 0.125f * LOG2E;
constexpr float NEG = -1e30f;

constexpr size_t MiB = 1u << 20;
constexpr size_t WS_CTL = 0, CTL_BYTES = 65536;
constexpr size_t WS_MOD = 1 * MiB;
constexpr size_t WS_ROPE = 2 * MiB;
constexpr size_t WS_LTOK = 3 * MiB;
constexpr size_t WS_LW = 6 * MiB;
constexpr size_t WS_WR = 9 * MiB;
constexpr size_t WS_WQKV = 416 * MiB;
constexpr size_t WS_WO = 440 * MiB;
constexpr size_t WS_GM = 10 * MiB;
constexpr size_t WS_RC = 11 * MiB;
constexpr size_t WS_RPB = 12 * MiB;
constexpr size_t WS_XRES = 16 * MiB;
constexpr size_t WS_H = 96 * MiB;
constexpr size_t WS_Q = 136 * MiB;
constexpr size_t WS_K = 176 * MiB;
constexpr size_t WS_VT = 216 * MiB;
constexpr size_t WS_O = 256 * MiB;
constexpr size_t WS_ACT = 296 * MiB;
constexpr size_t WS_YP = 336 * MiB;
constexpr size_t WS_WMG = 448 * MiB;
constexpr size_t WS_WMU = 480 * MiB;
constexpr size_t WS_WMD = 512 * MiB;
constexpr size_t WS_END = 544 * MiB;
constexpr int CW_BAR = 0;
constexpr int CW_CNT = 8192;

constexpr int NTHREADS = 256;
constexpr int LDS_GEMM = 73728;
constexpr int LDS_MISC = LDS_GEMM;
constexpr int LDS_BYTES = LDS_GEMM + 1024;
constexpr int NPHASES = 2 + 7 * DEPTH;

struct Params {
    const float* in[26];
    float* out;
    unsigned char* ws;
    int ph_lo, ph_hi;
};

DI unsigned pk2(float lo, float hi) { f32x2 v = {lo, hi}; bf16x2_t r = __builtin_convertvector(v, bf16x2_t); return __builtin_bit_cast(unsigned, r); }
DI float bf2f(unsigned short u) { return __builtin_bit_cast(float, (unsigned)u << 16); }
DI float wave_sum(float v) {
#pragma unroll
    for (int o = 1; o < 64; o <<= 1) v += __shfl_xor(v, o);
    return v;
}
DI float fexp2(float x) { return __builtin_amdgcn_exp2f(x); }
DI float silu(float v) { return v / (1.f + __expf(-v)); }
DI bf16x8 ldg8(const bf16* p) { return *(const bf16x8*)p; }
DI void glds16(const void* g, LAS unsigned char* l) {
    __builtin_amdgcn_global_load_lds((const unsigned*)g, (LAS unsigned*)l, 16, 0, 0);
}
DI int pi32(int r) { return (r & 0x13) | ((r & 4) << 1) | ((r & 8) >> 1); }

#define XB_TMO      128
#define XB_XCNT(j)  (256  + 64 * (j))
#define XB_XSUB(j)  (1280 + 64 * (j))
#define XB_XGEN(j)  (2304 + 64 * (j))
#define XB_TOP      3328
#define XB_TOPGEN   3392
#define XCD_BAR_WORDS 3456
#define XB_SPIN_CAP (1u << 20)
DI unsigned xb_ld(unsigned* p) { return __hip_atomic_load(p, __ATOMIC_RELAXED, __HIP_MEMORY_SCOPE_AGENT); }
DI unsigned xb_add(unsigned* p, unsigned v) { return __hip_atomic_fetch_add(p, v, __ATOMIC_RELAXED, __HIP_MEMORY_SCOPE_AGENT); }
DI unsigned xb_xcc_id() { return (unsigned)__builtin_amdgcn_s_getreg((3 << 11) | 20) & 0xFu; }
#define XB_SPIN(cond, bar) do { unsigned _sp = 0; while (cond) { __builtin_amdgcn_s_sleep(1); \
    if ((++_sp & 255u) == 0u) { if (xb_ld(&(bar)[XB_TMO])) break; if (_sp > XB_SPIN_CAP) { atomicAdd(&(bar)[XB_TMO], 1u); break; } } } } while (0)
struct XcdBarrier { unsigned* bar; unsigned x; volatile LAS unsigned* st; };
DI XcdBarrier xcd_barrier_post(unsigned* bar, volatile LAS unsigned* st) {
    XcdBarrier b; b.bar = bar; b.x = xb_xcc_id(); b.st = st;
    if (threadIdx.x == 0) (void)xb_add(&bar[XB_XCNT(b.x)], 1u);
    return b;
}
DI void xcd_barrier_complete(unsigned* bar, unsigned x, unsigned& nloc, unsigned& nx) {
    const unsigned G = gridDim.x * gridDim.y * gridDim.z;
    unsigned sum, cnt, mine, sp = 0u;
    for (;;) {
        sum = 0u; cnt = 0u; mine = 0u;
#pragma unroll
        for (unsigned j = 0; j < 16; ++j) { const unsigned c = xb_ld(&bar[XB_XCNT(j)]); sum += c; cnt += (c > 0u) ? 1u : 0u; mine = (j == x) ? c : mine; }
        if (sum == G) break;
        __builtin_amdgcn_s_sleep(1);
        if ((++sp & 255u) == 0u) { if (xb_ld(&bar[XB_TMO])) break; if (sp > XB_SPIN_CAP) { atomicAdd(&bar[XB_TMO], 1u); break; } }
    }
    nloc = mine > 0u ? mine : 1u; nx = cnt > 0u ? cnt : 1u;
}
DI void xcd_barrier(const XcdBarrier& b) {
    asm volatile("s_waitcnt vmcnt(0)" ::: "memory");
    __syncthreads();
    if (threadIdx.x == 0) {
        unsigned* bar = b.bar;
        __builtin_amdgcn_s_waitcnt(0);
        unsigned nloc = b.st[0], nx = b.st[1];
        if (nloc == 0u) { xcd_barrier_complete(bar, b.x, nloc, nx); b.st[0] = nloc; b.st[1] = nx; }
        const unsigned old = xb_add(&bar[XB_XSUB(b.x)], 1u);
        const unsigned gen = old / nloc;
        if (old + 1u == (gen + 1u) * nloc) {
            __builtin_amdgcn_fence(__ATOMIC_RELEASE, "agent");
            asm volatile("s_waitcnt vmcnt(0)" ::: "memory");
            const unsigned og = xb_add(&bar[XB_TOP], 1u);
            const unsigned tg = og / nx;
            if (og + 1u == (tg + 1u) * nx) xb_add(&bar[XB_TOPGEN], 1u);
            else XB_SPIN(xb_ld(&bar[XB_TOPGEN]) == tg, bar);
            __builtin_amdgcn_fence(__ATOMIC_ACQUIRE, "agent");
            xb_add(&bar[XB_XGEN(b.x)], 1u);
            asm volatile("s_waitcnt vmcnt(0)" ::: "memory");
        } else {
            XB_SPIN(xb_ld(&bar[XB_XGEN(b.x)]) == gen, bar);
            __builtin_amdgcn_fence(__ATOMIC_ACQUIRE, "agent");
            asm volatile("s_waitcnt vmcnt(0)" ::: "memory");
        }
    }
    __syncthreads();
}

typedef const __attribute__((address_space(4))) Params* ParamsPtr;
struct Ctx {
    ParamsPtr pp;
    LAS unsigned char* lds;
    int tid, lane, wave;
    DI const float* in(int i) const { return pp->in[i]; }
    DI float* out() const { return pp->out; }
    DI unsigned char* ws() const { return pp->ws; }
    DI unsigned* ctl() const { return (unsigned*)(ws() + WS_CTL); }
    DI float* mod() const { return (float*)(ws() + WS_MOD); }
    DI float* ropec() const { return (float*)(ws() + WS_ROPE); }
    DI float* ropes() const { return (float*)(ws() + WS_ROPE) + 1024; }
    DI int* ltok() const { return (int*)(ws() + WS_LTOK); }
    DI float* lw() const { return (float*)(ws() + WS_LW); }
    DI bf16* wr() const { return (bf16*)(ws() + WS_WR); }
    DI bf16* wqkv(int layer) const { return (bf16*)(ws() + WS_WQKV) + (size_t)layer * 3072 * D; }
    DI bf16* wmg() const { return (bf16*)(ws() + WS_WMG); }
    DI bf16* wmu() const { return (bf16*)(ws() + WS_WMU); }
    DI bf16* wmd() const { return (bf16*)(ws() + WS_WMD); }
    DI bf16* wo(int layer) const { return (bf16*)(ws() + WS_WO) + (size_t)layer * D * D; }
    DI float* gm() const { return (float*)(ws() + WS_GM); }
    DI float* rc() const { return (float*)(ws() + WS_RC); }
    DI float* rpbp() const { return (float*)(ws() + WS_RPB); }
    DI bf16* xres() const { return (bf16*)(ws() + WS_XRES); }
    DI bf16* H() const { return (bf16*)(ws() + WS_H); }
    DI bf16* Q() const { return (bf16*)(ws() + WS_Q); }
    DI bf16* K() const { return (bf16*)(ws() + WS_K); }
    DI bf16* VT() const { return (bf16*)(ws() + WS_VT); }
    DI bf16* O() const { return (bf16*)(ws() + WS_O); }
    DI bf16* ACT() const { return (bf16*)(ws() + WS_ACT); }
    DI bf16* YP() const { return (bf16*)(ws() + WS_YP); }
};

DI int mod_row(int t) { const int b = t / TPB; return (t - b * TPB) < CTX ? 8 : b; }

template <int MI, int NSTG, int BK, bool CHAIN, class Op>
DI void gemm_tile_x(const Op& op, const Op& nop, bool has_next, bool first, LAS unsigned char* lds, int tid) {
    constexpr int BM = 64 * MI, RB = BK * 2  , STG = (BM + 128) * RB, APC = BM * RB / 4096, BPC = 128 * RB / 4096, LPT = APC + BPC, KS = BK / 16, RPP = 4096 / RB  ;
    const int lane = tid & 63, wave = tid >> 6, wm = wave & 1, wn = wave >> 1;
    const int r = lane & 31, h = lane >> 5;
    const int K = op.K(), nk = K / BK;
    const int srow = (BK == 32) ? (tid >> 2) : (tid >> 3);
    const int sch = (BK == 32) ? ((tid & 3) ^ ((tid >> 4) & 3)) : ((tid & 7) ^ ((tid >> 4) & 7));
    const bf16* ap[APC]; const bf16* bpt[BPC];
#pragma unroll
    for (int i = 0; i < APC; ++i) ap[i] = op.arow(srow + RPP * i) + sch * 8;
#pragma unroll
    for (int i = 0; i < BPC; ++i) bpt[i] = op.brow_ptr(srow + RPP * i) + sch * 8;
    const unsigned xs = (BK == 32) ? ((r >> 2) & 3) : ((r >> 1) & 7);
    unsigned a_rd[MI], b_rd[2];
#pragma unroll
    for (int mi = 0; mi < MI; ++mi) a_rd[mi] = (32 * MI * wm + 32 * mi + r) * RB;
#pragma unroll
    for (int ni = 0; ni < 2; ++ni) b_rd[ni] = BM * RB + (op.brow(wn, ni) + r) * RB;

    f32x16 acc[2][MI];
#pragma unroll
    for (int ni = 0; ni < 2; ++ni)
#pragma unroll
        for (int mi = 0; mi < MI; ++mi)
#pragma unroll
            for (int i = 0; i < 16; ++i) acc[ni][mi][i] = 0.f;
    typename Op::template Pre<MI> pre;
    op.template prefetch<MI>(pre, wm, wn, r, h);

#define G_ISSUE(kt, stg) do { LAS unsigned char* s_ = lds + (stg) * STG + tid * 16; \
        _Pragma("unroll") for (int i = 0; i < APC; ++i) glds16(ap[i] + (kt) * BK, s_ + i * 4096); \
        _Pragma("unroll") for (int i = 0; i < BPC; ++i) glds16(bpt[i] + (kt) * BK, s_ + BM * RB + i * 4096); } while (0)

    if (!CHAIN || first) {
        __syncthreads();
#pragma unroll
        for (int s = 0; s < NSTG - 1; ++s) if (s < nk) G_ISSUE(s, s);
    }
    int stg = 0, istg = NSTG - 1;
    for (int kt = 0; kt < nk; ++kt) {
        if (kt + NSTG - 2 < nk) asm volatile("s_waitcnt vmcnt(%0)" :: "n"((NSTG - 2) * LPT) : "memory");
        else asm volatile("s_waitcnt vmcnt(0)" ::: "memory");
        __builtin_amdgcn_s_barrier();
        asm volatile("" ::: "memory");
        if (kt + NSTG - 1 < nk) G_ISSUE(kt + NSTG - 1, istg);
        __builtin_amdgcn_sched_barrier(0);
        LAS unsigned char* base = lds + stg * STG;
        __builtin_amdgcn_iglp_opt(1);
#pragma unroll
        for (int s = 0; s < KS; ++s) {
            const unsigned co = (unsigned)(((2 * s + h) ^ xs) << 4);
            bf16x8 af[MI], bfr[2];
#pragma unroll
            for (int mi = 0; mi < MI; ++mi) af[mi] = *(LAS bf16x8*)(base + a_rd[mi] + co);
#pragma unroll
            for (int ni = 0; ni < 2; ++ni) bfr[ni] = *(LAS bf16x8*)(base + b_rd[ni] + co);
#pragma unroll
            for (int ni = 0; ni < 2; ++ni)
#pragma unroll
                for (int mi = 0; mi < MI; ++mi) acc[ni][mi] = MFMA(bfr[ni], af[mi], acc[ni][mi]);
        }
        asm volatile("" ::: "memory");
        stg = (stg + 1 == NSTG) ? 0 : stg + 1; istg = (istg + 1 == NSTG) ? 0 : istg + 1;
    }
#undef G_ISSUE
    if (CHAIN) {
        __syncthreads();
        if (has_next) {
#pragma unroll
            for (int s = 0; s < NSTG - 1; ++s) if (s < nk) {
                LAS unsigned char* s_ = lds + s * STG + tid * 16;
#pragma unroll
                for (int i = 0; i < APC; ++i) glds16(nop.arow(srow + RPP * i) + sch * 8 + s * BK, s_ + i * 4096);
#pragma unroll
                for (int i = 0; i < BPC; ++i) glds16(nop.brow_ptr(srow + RPP * i) + sch * 8 + s * BK, s_ + BM * RB + i * 4096);
            }
        }
        __builtin_amdgcn_sched_barrier(0);
    }
    if (Op::kLdsEpi) {
        if (!CHAIN) __syncthreads();
        else asm volatile("s_waitcnt vmcnt(0)" ::: "memory");
        op.template epi_lds<MI>(acc, pre, wm, wn, r, h, lds + 32768 + wave * 8704);
    } else op.template epi<MI>(acc, pre, wm, wn, r, h);
}
template <int MI, int NSTG, int BK, class Op>
DI void gemm_tile(const Op& op, LAS unsigned char* lds, int tid) { gemm_tile_x<MI, NSTG, BK, false>(op, op, false, true, lds, tid); }

struct QkvOp {
    static constexpr bool kLdsEpi = false;
    template <int MI, class P> DI void epi_lds(f32x16 (&)[2][MI], const P&, int, int, int, int, LAS unsigned char*) const {}
    template <int MI> struct Pre {};
    template <int MI> DI void prefetch(Pre<MI>&, int, int, int, int) const {}
    const bf16* A; const bf16* Wt; int N, m0, n0, kind, kw, voff, vw;
    bf16* Q; bf16* Kb; bf16* VT; const float* rc; const float* rs;
    DI int K() const { return D; }
    DI const bf16* arow(int ml) const { return A + (size_t)(m0 + ml) * D; }
    DI const bf16* brow_ptr(int nl) const { return Wt + (size_t)(n0 + nl) * D; }
    DI int brow(int wn, int ni) const { return 64 * wn + 32 * ni; }
    template <int MI> DI void epi(f32x16 (&acc)[2][MI], const Pre<MI>& pre, int wm, int wn, int c, int h) const {
#pragma unroll
        for (int ni = 0; ni < 2; ++ni)
#pragma unroll
            for (int mi = 0; mi < MI; ++mi) {
                const int nb = n0 + 64 * wn + 32 * ni;
                const int t = m0 + 32 * MI * wm + 32 * mi + c;
                const int b = t / TPB, j = t - b * TPB;
                f32x16 v = acc[ni][mi];
                if (nb < voff) {
                    if (kind != 0 && j >= CTX) {
                        const int s = j - CTX;
                        const int pos = ((nb >> 5) & 1) ? (s & 63) : (s >> 6);
#pragma unroll
                        for (int g = 0; g < 2; ++g)
#pragma unroll
                            for (int e = 0; e < 4; ++e) {
                                const int i = 4 * g + e, d = e + 8 * g + 4 * h;
                                const float cs = rc[pos * 16 + d], sn = rs[pos * 16 + d];
                                const float x1 = v[i], x2 = v[i + 8];
                                v[i] = x1 * cs - x2 * sn; v[i + 8] = x2 * cs + x1 * sn;
                            }
                    }
                    bf16* dst = (nb < D) ? (Q + (size_t)t * D + nb) : (Kb + (size_t)t * kw + (nb - D));
#pragma unroll
                    for (int g = 0; g < 4; ++g) {
                        u32x2 w; w.x = pk2(v[4 * g], v[4 * g + 1]); w.y = pk2(v[4 * g + 2], v[4 * g + 3]);
                        *(u32x2*)(dst + 8 * g + 4 * h) = w;
                    }
                } else {
                    const unsigned off0 = (unsigned)((b * vw + (nb - voff) + 4 * h) * TPB + j);
#pragma unroll
                    for (int i = 0; i < 16; ++i)
                        VT[off0 + (unsigned)(((i & 3) + 8 * (i >> 2)) * TPB)] = (bf16)(pk2(v[i], 0.f) & 0xffffu);
                }
            }
    }
};

struct OutOp {
    static constexpr bool kLdsEpi = true;
    const bf16* A; const bf16* Wt; int m0, n0; const bf16* xres; bf16* xdst; const float* modl;
    template <int MI> struct Pre { u32x4 x[MI][4]; };
    DI int K() const { return D; }
    DI const bf16* arow(int ml) const { return A + (size_t)(m0 + ml) * D; }
    DI const bf16* brow_ptr(int nl) const { return Wt + (size_t)(n0 + nl) * D; }
    DI int brow(int wn, int ni) const { return 64 * wn + 32 * ni; }
    template <int MI> DI void prefetch(Pre<MI>& pre, int wm, int wn, int c, int h) const {
        const int lane = c + 32 * h, col = n0 + 64 * wn + 8 * (lane & 7);
#pragma unroll
        for (int mi = 0; mi < MI; ++mi)
#pragma unroll
            for (int p = 0; p < 4; ++p) { const int t = m0 + 32 * MI * wm + 32 * mi + ((lane + 64 * p) >> 3); pre.x[mi][p] = *(const u32x4*)(xres + (size_t)t * D + col); }
    }
    template <int MI> DI void epi(f32x16 (&)[2][MI], const Pre<MI>&, int, int, int, int) const {}
    template <int MI> DI void epi_lds(f32x16 (&acc)[2][MI], const Pre<MI>& pre, int wm, int wn, int c, int h, LAS unsigned char* wl) const {
        const int lane = c + 32 * h, col = n0 + 64 * wn + 8 * (lane & 7);
        const float* gp = modl + mod_row(m0) * 6144 + 2048 + col;
        const f32x4 g0 = *(const f32x4*)gp, g1 = *(const f32x4*)(gp + 4);
#pragma unroll
        for (int mi = 0; mi < MI; ++mi) {
#pragma unroll
            for (int ni = 0; ni < 2; ++ni)
#pragma unroll
                for (int g = 0; g < 4; ++g) {
                    f32x4 v = {acc[ni][mi][4 * g], acc[ni][mi][4 * g + 1], acc[ni][mi][4 * g + 2], acc[ni][mi][4 * g + 3]};
                    *(LAS f32x4*)(wl + c * 272 + (32 * ni + 8 * g + 4 * h) * 4) = v;
                }
            asm volatile("s_waitcnt lgkmcnt(0)" ::: "memory");
#pragma unroll
            for (int p = 0; p < 4; ++p) {
                const int q = lane + 64 * p, row = q >> 3;
                const f32x4 a0 = *(LAS f32x4*)(wl + row * 272 + (q & 7) * 32), a1 = *(LAS f32x4*)(wl + row * 272 + (q & 7) * 32 + 16);
                const u32x4 xv = pre.x[mi][p];
                u32x4 o;
                o.x = pk2(__builtin_bit_cast(float, xv.x << 16) + g0[0] * a0[0], __builtin_bit_cast(float, xv.x & 0xffff0000u) + g0[1] * a0[1]);
                o.y = pk2(__builtin_bit_cast(float, xv.y << 16) + g0[2] * a0[2], __builtin_bit_cast(float, xv.y & 0xffff0000u) + g0[3] * a0[3]);
                o.z = pk2(__builtin_bit_cast(float, xv.z << 16) + g1[0] * a1[0], __builtin_bit_cast(float, xv.z & 0xffff0000u) + g1[1] * a1[1]);
                o.w = pk2(__builtin_bit_cast(float, xv.w << 16) + g1[2] * a1[2], __builtin_bit_cast(float, xv.w & 0xffff0000u) + g1[3] * a1[3]);
                const int t = m0 + 32 * MI * wm + 32 * mi + row;
                *(u32x4*)(xdst + (size_t)t * D + col) = o;
            }
            asm volatile("s_waitcnt lgkmcnt(0)" ::: "memory");
        }
    }
};

struct GateUpOp {
    static constexpr bool kLdsEpi = false;
    template <int MI, class P> DI void epi_lds(f32x16 (&)[2][MI], const P&, int, int, int, int, LAS unsigned char*) const {}
    template <int MI> struct Pre {};
    template <int MI> DI void prefetch(Pre<MI>&, int, int, int, int) const {}
    const bf16* H; const bf16* WgT; const bf16* WuT; const int* ltok; int cnt, r0, f0; bf16* act;
    DI int K() const { return D; }
    DI const bf16* arow(int ml) const { int p = r0 + ml; p = p < cnt ? p : cnt - 1; return H + (size_t)(ltok[p] >> 1) * D; }
    DI const bf16* brow_ptr(int nl) const { return (nl < 64) ? (WgT + (size_t)(f0 + nl) * D) : (WuT + (size_t)(f0 + nl - 64) * D); }
    DI int brow(int wn, int ni) const { return 64 * ni + 32 * wn; }
    template <int MI> DI void epi(f32x16 (&acc)[2][MI], const Pre<MI>& pre, int wm, int wn, int c, int h) const {
#pragma unroll
        for (int mi = 0; mi < MI; ++mi) {
            const int p = r0 + 32 * MI * wm + 32 * mi + c;
            if (p < cnt) {
                bf16* dst = act + (size_t)p * DEXP + f0 + 32 * wn + 4 * h;
#pragma unroll
                for (int g = 0; g < 4; ++g) {
                    float o[4];
#pragma unroll
                    for (int e = 0; e < 4; ++e) { const float a = acc[0][mi][4 * g + e], u = acc[1][mi][4 * g + e]; o[e] = silu(a) * u; }
                    u32x2 w; w.x = pk2(o[0], o[1]); w.y = pk2(o[2], o[3]);
                    *(u32x2*)(dst + 8 * g) = w;
                }
            }
        }
    }
};

struct DownOp {
    static constexpr bool kLdsEpi = true;
    template <int MI> struct Pre { int tk[MI][4]; float w[MI]; };
    const bf16* act; const bf16* WdT; const int* ltok; const float* lw; int cnt, r0, n0; bf16* yp;
    DI int K() const { return DEXP; }
    DI const bf16* arow(int ml) const { int p = r0 + ml; p = p < cnt ? p : cnt - 1; return act + (size_t)p * DEXP; }
    DI const bf16* brow_ptr(int nl) const { return WdT + (size_t)(n0 + nl) * DEXP; }
    DI int brow(int wn, int ni) const { return 64 * wn + 32 * ni; }
    template <int MI> DI void prefetch(Pre<MI>& pre, int wm, int wn, int c, int h) const {
        const int lane = c + 32 * h;
#pragma unroll
        for (int mi = 0; mi < MI; ++mi) {
            const int pw = r0 + 32 * MI * wm + 32 * mi + c;
            pre.w[mi] = lw[pw < cnt ? pw : cnt - 1];
#pragma unroll
            for (int p = 0; p < 4; ++p) { const int pr = r0 + 32 * MI * wm + 32 * mi + ((lane + 64 * p) >> 3); pre.tk[mi][p] = ltok[pr < cnt ? pr : cnt - 1]; }
        }
    }
    template <int MI> DI void epi(f32x16 (&)[2][MI], const Pre<MI>&, int, int, int, int) const {}
    template <int MI> DI void epi_lds(f32x16 (&acc)[2][MI], const Pre<MI>& pre, int wm, int wn, int c, int h, LAS unsigned char* wl) const {
        const int lane = c + 32 * h;
#pragma unroll
        for (int mi = 0; mi < MI; ++mi) {
            const float w = pre.w[mi];
#pragma unroll
            for (int ni = 0; ni < 2; ++ni)
#pragma unroll
                for (int g = 0; g < 4; ++g) {
                    u32x2 o; o.x = pk2(w * acc[ni][mi][4 * g], w * acc[ni][mi][4 * g + 1]); o.y = pk2(w * acc[ni][mi][4 * g + 2], w * acc[ni][mi][4 * g + 3]);
                    *(LAS u32x2*)(wl + c * 144 + (32 * ni + 8 * g + 4 * h) * 2) = o;
                }
            asm volatile("s_waitcnt lgkmcnt(0)" ::: "memory");
#pragma unroll
            for (int p = 0; p < 4; ++p) {
                const int q = lane + 64 * p, row = q >> 3;
                const u32x4 v = *(LAS u32x4*)(wl + row * 144 + (q & 7) * 16);
                if (r0 + 32 * MI * wm + 32 * mi + row < cnt) *(u32x4*)(yp + (size_t)pre.tk[mi][p] * D + n0 + 64 * wn + 8 * (q & 7)) = v;
            }
            asm volatile("s_waitcnt lgkmcnt(0)" ::: "memory");
        }
    }
};

DI void transpose_tile(const float* W, int K, int N, bf16* Wt, int tile, LAS float* scr, int tid) {
    const int ntn = N / 64, k0 = (tile / ntn) * 64, n0 = (tile % ntn) * 64;
#pragma unroll 4
    for (int i = 0; i < 16; ++i) { const int kk = (tid >> 6) + 4 * i; scr[kk * 65 + (tid & 63)] = W[(size_t)(k0 + kk) * N + n0 + (tid & 63)]; }
    __syncthreads();
#pragma unroll
    for (int i = 0; i < 2; ++i) {
        const int q = tid + 256 * i, n = q >> 3, kc = q & 7;
        const LAS float* s = scr + (8 * kc) * 65 + n;
        u32x4 o; o.x = pk2(s[0], s[65]); o.y = pk2(s[2 * 65], s[3 * 65]); o.z = pk2(s[4 * 65], s[5 * 65]); o.w = pk2(s[6 * 65], s[7 * 65]);
        *(u32x4*)(Wt + (size_t)(n0 + n) * K + k0 + 8 * kc) = o;
    }
    __syncthreads();
}

DI f32x16 qk_tile(const bf16x8 (&qf)[4], const bf16* kp) {
    f32x16 s;
#pragma unroll
    for (int i = 0; i < 16; ++i) s[i] = 0.f;
    bf16x8 kf[4];
#pragma unroll
    for (int s4 = 0; s4 < 4; ++s4) kf[s4] = ldg8(kp + 16 * s4);
#pragma unroll
    for (int s4 = 0; s4 < 4; ++s4) s = MFMA(kf[s4], qf[s4], s);
    return s;
}
constexpr float RS_THR = 6.0f;
template <bool RAW>
DI bool softmax_tile(f32x16& s, float& m, float& l, float& alpha, bf16x8 (&pf)[2]) {
    float mx = s[0];
#pragma unroll
    for (int i = 1; i < 16; ++i) mx = fmaxf(mx, s[i]);
    mx = fmaxf(mx, __shfl_xor(mx, 32));
    if (RAW) mx *= SM_C;
    const bool resc = !__all(mx <= m + RS_THR);
    alpha = 1.f;
    if (resc) { const float mn = fmaxf(m, mx); alpha = fexp2(m - mn); m = mn; }
    float ps = 0.f;
#pragma unroll
    for (int i = 0; i < 16; ++i) { s[i] = RAW ? fexp2(__builtin_fmaf(s[i], SM_C, -m)) : fexp2(s[i] - m); ps += s[i]; }
    l = l * alpha + ps;
#pragma unroll
    for (int k2 = 0; k2 < 2; ++k2) {
        u32x4 w; w.x = pk2(s[8 * k2], s[8 * k2 + 1]); w.y = pk2(s[8 * k2 + 2], s[8 * k2 + 3]); w.z = pk2(s[8 * k2 + 4], s[8 * k2 + 5]); w.w = pk2(s[8 * k2 + 6], s[8 * k2 + 7]);
        pf[k2] = __builtin_bit_cast(bf16x8, w);
    }
    return resc;
}
template <int NDB>
DI void pv_tile(f32x16 (&O)[NDB], const bf16x8 (&pf)[2], const bf16* vp, float alpha) {
    bf16x8 vf[NDB][2];
#pragma unroll
    for (int db = 0; db < NDB; ++db)
#pragma unroll
        for (int k2 = 0; k2 < 2; ++k2) vf[db][k2] = ldg8(vp + (size_t)db * 32 * TPB + 16 * k2);
#pragma unroll
    for (int db = 0; db < NDB; ++db) {
#pragma unroll
        for (int i = 0; i < 16; ++i) O[db][i] *= alpha;
#pragma unroll
        for (int k2 = 0; k2 < 2; ++k2) O[db] = MFMA(vf[db][k2], pf[k2], O[db]);
    }
}
template <int NDB>
DI void store_o(const f32x16 (&O)[NDB], float inv, bf16* orow, int h) {
#pragma unroll
    for (int db = 0; db < NDB; ++db)
#pragma unroll
        for (int g = 0; g < 4; ++g) {
            u32x2 w; w.x = pk2(O[db][4 * g] * inv, O[db][4 * g + 1] * inv); w.y = pk2(O[db][4 * g + 2] * inv, O[db][4 * g + 3] * inv);
            *(u32x2*)(orow + 32 * db + 8 * g + 4 * h) = w;
        }
}

DI unsigned swz128(int row, int ch) { return (unsigned)(row * 128 + ((ch ^ ((row >> 1) & 7)) << 4)); }

template <bool RAW>
DI bool softmax_tile2(f32x16& sa, f32x16& sb, float& m, float& l, float& alpha, bf16x8 (&pf)[4]) {
    float mx = fmaxf(sa[0], sb[0]);
#pragma unroll
    for (int i = 1; i < 16; ++i) mx = fmaxf(mx, fmaxf(sa[i], sb[i]));
    mx = fmaxf(mx, __shfl_xor(mx, 32));
    if (RAW) mx *= SM_C;
    const bool resc = !__all(mx <= m + RS_THR);
    alpha = 1.f;
    if (resc) { const float mn = fmaxf(m, mx); alpha = fexp2(m - mn); m = mn; }
    float ps = 0.f;
#pragma unroll
    for (int i = 0; i < 16; ++i) {
        sa[i] = RAW ? fexp2(__builtin_fmaf(sa[i], SM_C, -m)) : fexp2(sa[i] - m);
        sb[i] = RAW ? fexp2(__builtin_fmaf(sb[i], SM_C, -m)) : fexp2(sb[i] - m);
        ps += sa[i] + sb[i];
    }
    l = l * alpha + ps;
#pragma unroll
    for (int k2 = 0; k2 < 2; ++k2) {
        u32x4 w; w.x = pk2(sa[8 * k2], sa[8 * k2 + 1]); w.y = pk2(sa[8 * k2 + 2], sa[8 * k2 + 3]); w.z = pk2(sa[8 * k2 + 4], sa[8 * k2 + 5]); w.w = pk2(sa[8 * k2 + 6], sa[8 * k2 + 7]);
        pf[k2] = __builtin_bit_cast(bf16x8, w);
        u32x4 v; v.x = pk2(sb[8 * k2], sb[8 * k2 + 1]); v.y = pk2(sb[8 * k2 + 2], sb[8 * k2 + 3]); v.z = pk2(sb[8 * k2 + 4], sb[8 * k2 + 5]); v.w = pk2(sb[8 * k2 + 6], sb[8 * k2 + 7]);
        pf[2 + k2] = __builtin_bit_cast(bf16x8, v);
    }
    return resc;
}

DI void attn_block_nasw(const Ctx& cx, int kind, int layer, bool need_ctx, int vbid) {
    const int tid = cx.tid, lane = cx.lane, w = cx.wave, c = lane & 31, h = lane >> 5;
    const int kw = (kind == 0) ? D : 256, vw = kw;
    const int n_lat = 2048, n_tasks = n_lat + (need_ctx ? 256 : 0);
    const float* rpb = cx.rpbp() + (size_t)(layer / 3) * 16 * 512;
    const float* sinks = cx.in(17);
    const int srow = tid >> 3, sch = (tid & 7) ^ ((srow >> 1) & 7);
    const int pr = pi32(c);
    const unsigned xk = (pr >> 1) & 7, xv = (c >> 1) & 7;
    LAS float* rpbs = (LAS float*)(cx.lds + 49152);
    LAS unsigned char* qreg = cx.lds + 51200 + w * 4096 + lane * 16;
    for (int base_ = 0; base_ < n_tasks; base_ += gridDim.x) {
        const int task = base_ + ((base_ + (int)gridDim.x <= n_tasks) ? vbid : (int)blockIdx.x);
        if (task >= n_tasks) break;
        int b, kmap, head, tq0, nt, rlo = 0, r0w = 0, rg = 0, qh = 0, p0 = 0, kb_lo = 0;
        const bool lat = task < n_lat;
        if (kind == 0) {
            if (lat) {
                const int rp = task & 15; head = (task >> 4) & 15; b = task >> 8; rg = 2 * rp + (c >> 4); qh = 0;
                tq0 = b * TPB + CTX + rg * 64 + 16 * w + (c & 15) - c;
                int a0 = 2 * rp - 4; a0 = a0 < 0 ? 0 : (a0 > 24 ? 24 : a0);
                int a1 = 2 * rp - 3; a1 = a1 < 0 ? 0 : (a1 > 24 ? 24 : a1);
                rlo = a0; nt = 4 + (a1 + 8 - a0); r0w = (c >> 4) ? a1 : a0;
            } else { const int u = task - n_lat; const int qb = u & 1; head = (u >> 1) & 15; b = u >> 5; tq0 = b * TPB + qb * 128 + w * 32; nt = 4; }
            kmap = head;
        } else {
            if (lat) {
                const int qb = task & 63; kmap = (task >> 6) & 3; b = task >> 8; p0 = qb * 32; tq0 = b * TPB + CTX + p0;
                int lo = p0 - 128; lo = lo < 0 ? 0 : lo; kb_lo = lo & ~63;
                int hi = p0 + 160; hi = hi > SEQ ? SEQ : hi; hi = (hi + 63) & ~63; nt = 4 + (hi - kb_lo) / 64;
            } else { const int u = task - n_lat; const int qb = u & 7; kmap = (u >> 3) & 3; b = u >> 5; tq0 = b * TPB + qb * 32; nt = 4; }
            head = kmap * 4 + w;
        }
#define KEY0(it) ((it) < 4 ? 64 * (it) : (kind == 0 ? CTX + (rlo + (it) - 4) * 64 : CTX + kb_lo + ((it) - 4) * 64))
        const bf16* kg = cx.K() + (size_t)(b * TPB + srow) * kw + kmap * 64 + sch * 8;
        const bf16* vg = cx.VT() + ((size_t)b * vw + kmap * 64 + srow) * TPB + sch * 8;
#define A_LOAD(it, buf) do { const int k0_ = KEY0(it); LAS unsigned char* b_ = cx.lds + (buf) * 16384 + tid * 16; \
                        glds16(kg + (size_t)k0_ * kw, b_); glds16(kg + (size_t)(k0_ + 32) * kw, b_ + 4096); \
                        glds16(vg + k0_, b_ + 8192); glds16(vg + (size_t)32 * TPB + k0_, b_ + 8192 + 4096); } while (0)
        __syncthreads();
        float m = NEG, l = 0.f;
        if (kind == 2) { m = sinks[head] * LOG2E; l = (h == 0) ? 1.f : 0.f; asm volatile("" : "+v"(m)); }
        { const bf16* qp = cx.Q() + (size_t)(tq0 + c) * D + head * 64 + 8 * h;
#pragma unroll
          for (int s4 = 0; s4 < 4; ++s4) glds16(qp + 16 * s4, qreg + s4 * 1024); }
        if (kind == 0 && lat && tid < 128) glds16(rpb + head * 512 + tid * 4, (LAS unsigned char*)rpbs + tid * 16);
#pragma unroll
        for (int s = 0; s < 2; ++s) if (s < nt) A_LOAD(s, s);
        f32x16 O[2];
#pragma unroll
        for (int db = 0; db < 2; ++db)
#pragma unroll
            for (int i = 0; i < 16; ++i) O[db][i] = 0.f;
        const int qc = 16 * w + (c & 15); int c0 = qc - 8; c0 = c0 < 0 ? 0 : (c0 > 48 ? 48 : c0);
        int kbase = 16 * w - 8; kbase = kbase < 0 ? 0 : (kbase > 32 ? 32 : kbase);
        const unsigned xkn = ((kbase + pr) >> 1) & 7;
        const int qpos = p0 + c;
        bf16x8 qf[4];
        int stg = 0, istg = 2;
#pragma unroll 1
        for (int it = 0; it < nt; ++it) {
            if (it + 1 < nt) asm volatile("s_waitcnt vmcnt(4)" ::: "memory");
            else asm volatile("s_waitcnt vmcnt(0)" ::: "memory");
            __builtin_amdgcn_s_barrier();
            asm volatile("" ::: "memory");
            if (it + 2 < nt) A_LOAD(it + 2, istg);
            __builtin_amdgcn_sched_barrier(0);
            if (it == 0) {
#pragma unroll
                for (int s4 = 0; s4 < 4; ++s4) qf[s4] = *(LAS bf16x8*)(qreg + s4 * 1024);
            }
            LAS unsigned char* kb = cx.lds + stg * 16384; LAS unsigned char* vb = kb + 8192;
            if (kind == 0 && it >= 4) {
                const int ry = rlo + it - 4;
                f32x16 sa;
#pragma unroll
                for (int i = 0; i < 16; ++i) sa[i] = 0.f;
#pragma unroll
                for (int s4 = 0; s4 < 4; ++s4) {
                    const bf16x8 ka = *(LAS bf16x8*)(kb + (kbase + pr) * 128 + (((2 * s4 + h) ^ xkn) << 4));
                    sa = MFMA(ka, qf[s4], sa);
                }
                const bool rowok = (ry >= r0w) && (ry <= r0w + 7);
                int dyi = ry - rg + 7; dyi = dyi < 0 ? 0 : (dyi > 14 ? 14 : dyi);
                const LAS float* rrow = rpbs + dyi * 31;
                int dwin = rowok ? (kbase + 8 * h - c0) : 0x40000000;
                int dci = kbase + 8 * h - qc + 15;
                asm volatile("" : "+v"(dwin), "+v"(dci));
#pragma unroll
                for (int i = 0; i < 16; ++i) {
                    const int off = (i & 7) + 16 * (i >> 3);
                    int ci = dci + off; ci = ci < 0 ? 0 : (ci > 30 ? 30 : ci);
                    const bool ok = (unsigned)(dwin + off) < 16u;
                    sa[i] = ok ? __builtin_fmaf(sa[i], SM_C, rrow[ci]) : NEG;
                }
                float alpha; bf16x8 pf[2];
                const bool resc = softmax_tile<false>(sa, m, l, alpha, pf);
                if (resc) {
#pragma unroll
                    for (int db = 0; db < 2; ++db)
#pragma unroll
                        for (int i = 0; i < 16; ++i) O[db][i] *= alpha;
                }
                const int kb8 = kbase >> 3;
#pragma unroll
                for (int db = 0; db < 2; ++db)
#pragma unroll
                    for (int k2 = 0; k2 < 2; ++k2) {
                        const bf16x8 vf = *(LAS bf16x8*)(vb + (32 * db + c) * 128 + (((kb8 + 2 * k2 + h) ^ xv) << 4));
                        O[db] = MFMA(vf, pf[k2], O[db]);
                    }
            } else {
                f32x16 sa, sb;
#pragma unroll
                for (int i = 0; i < 16; ++i) { sa[i] = 0.f; sb[i] = 0.f; }
#pragma unroll
                for (int s4 = 0; s4 < 4; ++s4) {
                    const unsigned co = (unsigned)(((2 * s4 + h) ^ xk) << 4);
                    const bf16x8 ka = *(LAS bf16x8*)(kb + pr * 128 + co), kb2 = *(LAS bf16x8*)(kb + (32 + pr) * 128 + co);
                    sa = MFMA(ka, qf[s4], sa); sb = MFMA(kb2, qf[s4], sb);
                }
                bool resc; float alpha; bf16x8 pf[4];
                if (it < 4) {
                    resc = softmax_tile2<true>(sa, sb, m, l, alpha, pf);
                } else {
                    const int kb0 = kb_lo + (it - 4) * 64;
                    if (kb0 < p0 - 97 || kb0 > p0 + 65) {
                        int dq = kb0 + 8 * h - qpos + 128; asm volatile("" : "+v"(dq));
#pragma unroll
                        for (int i = 0; i < 16; ++i) {
                            const int off = (i & 7) + 16 * (i >> 3);
                            sa[i] = ((unsigned)(dq + off) <= 256u) ? sa[i] : NEG;
                            sb[i] = ((unsigned)(dq + off + 32) <= 256u) ? sb[i] : NEG;
                        }
                    }
                    resc = softmax_tile2<true>(sa, sb, m, l, alpha, pf);
                }
                if (resc) {
#pragma unroll
                    for (int db = 0; db < 2; ++db)
#pragma unroll
                        for (int i = 0; i < 16; ++i) O[db][i] *= alpha;
                }
#pragma unroll
                for (int db = 0; db < 2; ++db) {
#pragma unroll
                    for (int k4 = 0; k4 < 4; ++k4) {
                        const bf16x8 vf = *(LAS bf16x8*)(vb + (32 * db + c) * 128 + (((2 * k4 + h) ^ xv) << 4));
                        O[db] = MFMA(vf, pf[k4], O[db]);
                    }
                }
            }
            asm volatile("" ::: "memory");
            stg = (stg == 2) ? 0 : stg + 1; istg = (istg == 2) ? 0 : istg + 1;
        }
#undef KEY0
#undef A_LOAD
        l += __shfl_xor(l, 32);
        store_o<2>(O, 1.f / l, cx.O() + (size_t)(tq0 + c) * D + head * 64, h);
    }
}

DI void attn_block_da(const Ctx& cx, int layer, bool need_ctx, int vbid) {
    const int tid = cx.tid, lane = cx.lane, w = cx.wave, c = lane & 31, h = lane >> 5;
    const int n_lat = NB * 8 * 16, n_tasks = n_lat + (need_ctx ? NB * 8 * 2 : 0);
    const float* lp = cx.in(13);
    const float d1 = wave_sum(lp[lane] * lp[64 + lane]), d2 = wave_sum(lp[128 + lane] * lp[192 + lane]);
    const float lam_init = 0.8f - 0.6f * __expf(-0.3f * (float)layer);
    const float lam = __expf(d1) - __expf(d2) + lam_init;
    const float* sg = cx.in(14);
    const int krow = tid >> 3, kch = (tid & 7) ^ ((krow >> 1) & 7), vdim = tid >> 2, vch = (tid & 3) ^ ((vdim >> 2) & 3);
    const int pr = pi32(c);
    const unsigned xk = (pr >> 1) & 7, xv = (c >> 2) & 3;
    LAS unsigned char* qlds = cx.lds + 49152 + w * 4096 + lane * 16;
    for (int base_ = 0; base_ < n_tasks; base_ += gridDim.x) {
        const int task = base_ + ((base_ + (int)gridDim.x <= n_tasks) ? vbid : (int)blockIdx.x);
        if (task >= n_tasks) break;
        int b, head, tq0, nt;
        if (task < n_lat) { const int qb = task & 15; head = (task >> 4) & 7; b = task >> 7; tq0 = b * TPB + CTX + qb * 128 + w * 32; nt = TPB / 32; }
        else { const int u = task - n_lat; const int qb = u & 1; head = (u >> 1) & 7; b = u >> 4; tq0 = b * TPB + qb * 128 + w * 32; nt = CTX / 32; }
        const bf16* kg = cx.K() + (size_t)(b * TPB + krow) * D + head * 128 + kch * 8;
        const bf16* vg = cx.VT() + ((size_t)b * D + head * 128 + vdim) * TPB + vch * 8;
#define D_LOAD(it, buf) do { const int k0_ = 32 * (it); LAS unsigned char* b_ = cx.lds + (buf) * 16384 + tid * 16; \
                        glds16(kg + (size_t)k0_ * D, b_); glds16(kg + (size_t)k0_ * D + 64, b_ + 4096); \
                        glds16(vg + k0_, b_ + 8192); glds16(vg + (size_t)64 * TPB + k0_, b_ + 8192 + 4096); } while (0)
        __syncthreads();
        bf16x8 q1f[4];
        { const bf16* qp = cx.Q() + (size_t)(tq0 + c) * D + head * 128 + 8 * h;
#pragma unroll
          for (int s4 = 0; s4 < 4; ++s4) q1f[s4] = ldg8(qp + 64 + 16 * s4);
#pragma unroll
          for (int s4 = 0; s4 < 4; ++s4) asm volatile("" : "+v"(q1f[s4]));
#pragma unroll
          for (int s4 = 0; s4 < 4; ++s4) glds16(qp + 16 * s4, qlds + s4 * 1024); }
#pragma unroll
        for (int s = 0; s < 2; ++s) if (s < nt) D_LOAD(s, s);
        float m0 = NEG, l0 = 0.f, m1 = NEG, l1 = 0.f;
        f32x16 O0[4], O1[4];
#pragma unroll
        for (int db = 0; db < 4; ++db)
#pragma unroll
            for (int i = 0; i < 16; ++i) { O0[db][i] = 0.f; O1[db][i] = 0.f; }
        int stg = 0, istg = 2;
#pragma unroll 1
        for (int it = 0; it < nt; ++it) {
            if (it + 1 < nt) asm volatile("s_waitcnt vmcnt(4)" ::: "memory");
            else asm volatile("s_waitcnt vmcnt(0)" ::: "memory");
            __builtin_amdgcn_s_barrier();
            asm volatile("" ::: "memory");
            if (it + 2 < nt) D_LOAD(it + 2, istg);
            __builtin_amdgcn_sched_barrier(0);
            __builtin_amdgcn_iglp_opt(IGLP_ATT);
            LAS unsigned char* kb = cx.lds + stg * 16384; LAS unsigned char* vb = kb + 8192;
            f32x16 s0, s1;
#pragma unroll
            for (int i = 0; i < 16; ++i) { s0[i] = 0.f; s1[i] = 0.f; }
#pragma unroll
            for (int s4 = 0; s4 < 4; ++s4) {
                const unsigned co = (unsigned)(((2 * s4 + h) ^ xk) << 4);
                const bf16x8 k0f = *(LAS bf16x8*)(kb + pr * 128 + co), q0f = *(LAS bf16x8*)(qlds + s4 * 1024);
                s0 = MFMA(k0f, q0f, s0);
            }
#pragma unroll
            for (int s4 = 0; s4 < 4; ++s4) {
                const unsigned co = (unsigned)(((2 * s4 + h) ^ xk) << 4);
                const bf16x8 k1f = *(LAS bf16x8*)(kb + 4096 + pr * 128 + co);
                s1 = MFMA(k1f, q1f[s4], s1);
            }
            __builtin_amdgcn_sched_barrier(0);
            float a0; bf16x8 pf0[2];
            const bool r0 = softmax_tile<true>(s0, m0, l0, a0, pf0);
            float a1; bf16x8 pf1[2];
            const bool r1 = softmax_tile<true>(s1, m1, l1, a1, pf1);
            if (r0 || r1) {
#pragma unroll
                for (int db = 0; db < 4; ++db)
#pragma unroll
                    for (int i = 0; i < 16; ++i) { O0[db][i] *= a0; O1[db][i] *= a1; }
            }
            __builtin_amdgcn_s_setprio(1);
#pragma unroll
            for (int db = 0; db < 4; ++db) {
                bf16x8 vf[2];
#pragma unroll
                for (int k2 = 0; k2 < 2; ++k2) vf[k2] = *(LAS bf16x8*)(vb + (32 * db + c) * 64 + (((2 * k2 + h) ^ xv) << 4));
#pragma unroll
                for (int k2 = 0; k2 < 2; ++k2) { O0[db] = MFMA(vf[k2], pf0[k2], O0[db]); O1[db] = MFMA(vf[k2], pf1[k2], O1[db]); }
            }
            __builtin_amdgcn_s_setprio(0);
            asm volatile("" ::: "memory");
            stg = (stg == 2) ? 0 : stg + 1; istg = (istg == 2) ? 0 : istg + 1;
        }
#undef D_LOAD
        l0 += __shfl_xor(l0, 32); l1 += __shfl_xor(l1, 32);
        const int lane_e = __builtin_amdgcn_mbcnt_hi(~0u, __builtin_amdgcn_mbcnt_lo(~0u, 0u));
        const int c_e = lane_e & 31, h_e = lane_e >> 5;
        const float i0 = 1.f / l0, i1 = lam / l1;
        float ss = 0.f;
#pragma unroll
        for (int db = 0; db < 4; ++db)
#pragma unroll
            for (int i = 0; i < 16; ++i) { const float o = O0[db][i] * i0 - O1[db][i] * i1; O0[db][i] = o; ss += o * o; }
        ss += __shfl_xor(ss, 32);
        const float rn = rsqrtf(ss * (1.f / 128.f) + EPS) * (1.f - lam_init);
        bf16* orow = cx.O() + (size_t)(tq0 + c_e) * D + head * 128;
#pragma unroll
        for (int db = 0; db < 4; ++db)
#pragma unroll
            for (int g = 0; g < 4; ++g) {
                const int dim = 32 * db + 8 * g + 4 * h_e;
                const f32x4 gg = *(const f32x4*)(sg + dim);
                u32x2 wv; wv.x = pk2(O0[db][4 * g] * rn * gg[0], O0[db][4 * g + 1] * rn * gg[1]); wv.y = pk2(O0[db][4 * g + 2] * rn * gg[2], O0[db][4 * g + 3] * rn * gg[3]);
                *(u32x2*)(orow + dim) = wv;
            }
    }
}

DI void load_row(const float* row, f32x4 (&v)[4], int lane) {
#pragma unroll
    for (int j = 0; j < 4; ++j) v[j] = ((const f32x4*)row)[lane + 64 * j];
}
DI void load_row_bf16(const bf16* row, f32x4 (&v)[4], int lane) {
#pragma unroll
    for (int j = 0; j < 4; ++j) { const u32x2 a = ((const u32x2*)row)[lane + 64 * j];
        v[j][0] = __builtin_bit_cast(float, a.x << 16); v[j][1] = __builtin_bit_cast(float, a.x & 0xffff0000u);
        v[j][2] = __builtin_bit_cast(float, a.y << 16); v[j][3] = __builtin_bit_cast(float, a.y & 0xffff0000u); }
}
DI void norm_mod(f32x4 (&v)[4], const float* g, const float* sh, const float* sc, int lane) {
    float ss = 0.f;
#pragma unroll
    for (int j = 0; j < 4; ++j) ss += (v[j][0] * v[j][0] + v[j][1] * v[j][1]) + (v[j][2] * v[j][2] + v[j][3] * v[j][3]);
    const float rn = rsqrtf(wave_sum(ss) * (1.f / D) + EPS);
#pragma unroll
    for (int j = 0; j < 4; ++j) {
        const f32x4 gg = ((const f32x4*)g)[lane + 64 * j], s1 = ((const f32x4*)sc)[lane + 64 * j], s0 = ((const f32x4*)sh)[lane + 64 * j];
#pragma unroll
        for (int e = 0; e < 4; ++e) v[j][e] = (v[j][e] * rn * gg[e]) * (1.f + s1[e]) + s0[e];
    }
}
DI void store_row_bf16(bf16* row, const f32x4 (&v)[4], int lane) {
#pragma unroll
    for (int j = 0; j < 4; ++j) { u32x2 w; w.x = pk2(v[j][0], v[j][1]); w.y = pk2(v[j][2], v[j][3]); ((u32x2*)row)[lane + 64 * j] = w; }
}

struct ConvTask { const float* src; bf16* dst; int N, K; };
DI ConvTask prologue_task(const Ctx& cx, int item, int lane) {
    const int layer = item < 2048 ? 0 : (item < 4096 ? 1 : (item < 5376 ? 2 : 3));
    const int u = item - (layer == 0 ? 0 : (layer == 1 ? 2048 : (layer == 2 ? 4096 : 5376)));
    const int kind = layer % 3, NQ = (kind == 2) ? 1536 : 3072, nq = 16 * (NQ / 32);
    const float* W; bf16* WT; int N, kt, nt;
    if (u < nq) { W = (kind == 0) ? cx.in(9) + (size_t)(layer / 3) * D * 3072 : (kind == 1 ? cx.in(12) : cx.in(16)); WT = cx.wqkv(layer); N = NQ; kt = u / (NQ / 32); nt = u - kt * (NQ / 32); }
    else { const int v = u - nq; W = (kind == 0) ? cx.in(11) + (size_t)(layer / 3) * D * D : (kind == 1 ? cx.in(15) : cx.in(18)); WT = cx.wo(layer); N = D; kt = v >> 5; nt = v & 31; }
    ConvTask t;
    t.src = W + (size_t)(kt * 64 + (lane >> 3)) * N + nt * 32 + (lane & 7) * 4;
    t.dst = WT + (size_t)(nt * 32 + (lane >> 3)) * D + kt * 64 + (lane & 7) * 8;
    t.N = N; t.K = D;
    return t;
}
constexpr int PRO_NT = 7424;
DI void prologue_convert(const Ctx& cx, int first, int stride) {
    const int lane = cx.lane;
    LAS float* scr = (LAS float*)(cx.lds + 36864) + cx.wave * (64 * 33);
#define PV_LOAD(X, task) do { const ConvTask ct_ = prologue_task(cx, (task), lane); \
        _Pragma("unroll") for (int p = 0; p < 8; ++p) X[p] = *(const f32x4*)(ct_.src + (size_t)(8 * p) * ct_.N); } while (0)
#define PV_PROC(X, task) do { const ConvTask ct_ = prologue_task(cx, (task), lane); \
        _Pragma("unroll") for (int p = 0; p < 8; ++p) { LAS float* d = scr + ((lane >> 3) + 8 * p) * 33 + (lane & 7) * 4; d[0] = X[p][0]; d[1] = X[p][1]; d[2] = X[p][2]; d[3] = X[p][3]; } \
        asm volatile("s_waitcnt lgkmcnt(0)" ::: "memory"); \
        _Pragma("unroll") for (int p = 0; p < 4; ++p) { const LAS float* s = scr + ((lane & 7) * 8) * 33 + (lane >> 3) + 8 * p; \
            u32x4 o; o.x = pk2(s[0], s[33]); o.y = pk2(s[2 * 33], s[3 * 33]); o.z = pk2(s[4 * 33], s[5 * 33]); o.w = pk2(s[6 * 33], s[7 * 33]); \
            *(u32x4*)(ct_.dst + (size_t)(8 * p) * ct_.K) = o; } \
        asm volatile("s_waitcnt lgkmcnt(0)" ::: "memory"); } while (0)
    f32x4 xa[8], xb[8];
    int task = first;
    if (task < PRO_NT) PV_LOAD(xa, task);
#pragma unroll 1
    while (task < PRO_NT) {
        const int t2 = task + stride, t3 = t2 + stride;
        if (t2 < PRO_NT) PV_LOAD(xb, t2);
        PV_PROC(xa, task);
        if (t3 < PRO_NT) PV_LOAD(xa, t3);
        if (t2 < PRO_NT) PV_PROC(xb, t2);
        task = t3;
    }
#undef PV_LOAD
#undef PV_PROC
}

DI void phase_prologue(const Ctx& cx) {
    LAS float* condS = (LAS float*)cx.lds;
    const float* cin = cx.in(1); const float* cctx = cx.in(3);
    for (int i = cx.tid; i < 9 * 1024; i += NTHREADS) { const int rr = i >> 10, k = i & 1023; const float v = (rr < 8) ? cin[rr * 1024 + k] : cctx[k]; condS[i] = silu(v); }
    __syncthreads();
    const float* ada_w = cx.in(4); const float* ada_b = cx.in(5);
    LAS float* red16 = (LAS float*)(cx.lds + 9 * 1024 * 4);
    for (int task = blockIdx.x; task < 4 * 96; task += gridDim.x) {
        const int layer = task / 96, cc = task % 96, r = cx.lane >> 4, cq = cx.lane & 15;
        const float* W = ada_w + (size_t)layer * D * 6144 + cc * 64 + 4 * cq;
        float acc[9][4];
#pragma unroll
        for (int rr = 0; rr < 9; ++rr)
#pragma unroll
            for (int e = 0; e < 4; ++e) acc[rr][e] = 0.f;
        const int k0 = cx.wave * 256 + r;
#pragma unroll 1
        for (int kb = 0; kb < 256; kb += 64) {
            f32x4 wv[16];
#pragma unroll
            for (int i = 0; i < 16; ++i) wv[i] = *(const f32x4*)(W + (size_t)(k0 + kb + 4 * i) * 6144);
#pragma unroll
            for (int i = 0; i < 16; ++i) {
#pragma unroll
                for (int rr = 0; rr < 9; ++rr) { const float cv = condS[rr * 1024 + k0 + kb + 4 * i];
#pragma unroll
                    for (int e = 0; e < 4; ++e) acc[rr][e] += cv * wv[i][e]; }
            }
        }
#pragma unroll
        for (int rr = 0; rr < 9; ++rr) *(LAS f32x4*)(red16 + ((cx.wave * 4 + r) * 9 + rr) * 64 + 4 * cq) = f32x4{acc[rr][0], acc[rr][1], acc[rr][2], acc[rr][3]};
        __syncthreads();
        for (int i = cx.tid; i < 9 * 64; i += NTHREADS) {
            const int rr = i >> 6, ln = i & 63;
            float s = 0.f;
#pragma unroll
            for (int g = 0; g < 16; ++g) s += red16[(g * 9 + rr) * 64 + ln];
            cx.mod()[((size_t)layer * 9 + rr) * 6144 + cc * 64 + ln] = s + ada_b[layer * 6144 + cc * 64 + ln];
        }
        __syncthreads();
    }
    {
        const int ng = (4 * 96 < (int)gridDim.x) ? 4 * 96 : (int)gridDim.x;
        const int nslots = ng * 4 + ((int)gridDim.x - ng) * 4 * 3;
        const int gw = blockIdx.x * 4 + cx.wave;
        if ((int)blockIdx.x < ng) prologue_convert(cx, gw, nslots);
        else { const int s0 = ng * 4 + (gw - ng * 4) * 3; prologue_convert(cx, s0, nslots); prologue_convert(cx, s0 + 1, nslots); prologue_convert(cx, s0 + 2, nslots); }
    }
    {
        bf16* wr = cx.wr();
        for (int i = blockIdx.x * NTHREADS + cx.tid; i < DEPTH * D * 64; i += gridDim.x * NTHREADS) {
            const int rho = i & 63, k = (i >> 6) & 1023, layer = i >> 16;
            float v = 0.f;
            if (rho < 32) v = cx.in(21)[((size_t)layer * D + k) * 32 + rho];
            else if (rho < 36) v = cx.in(19)[((size_t)layer * D + k) * 4 + (rho - 32)];
            const unsigned hi = pk2(v, 0.f) & 0xffffu;
            const unsigned lo = pk2(v - bf2f((unsigned short)hi), 0.f) & 0xffffu;
            wr[((size_t)(layer * 2 + 0) * 64 + rho) * D + k] = (bf16)hi;
            wr[((size_t)(layer * 2 + 1) * 64 + rho) * D + k] = (bf16)lo;
        }
    }
    for (int i = blockIdx.x * NTHREADS + cx.tid; i < 2 * 16 * 512; i += gridDim.x * NTHREADS) { const int s = i >> 9, e = i & 511; cx.rpbp()[i] = (e < 465) ? cx.in(10)[s * 465 + e] * LOG2E : 0.f; }
    if (blockIdx.x == gridDim.x - 1) {
        for (int i = cx.tid; i < 64 * 16; i += NTHREADS) {
            const int pos = i >> 4, f = i & 15;
            const float tab4[4] = {1.f, 0.5623413251903491f, 0.31622776601683794f, 0.1778279410038923f};
            float inv = (f & 3) == 0 ? tab4[0] : ((f & 3) == 1 ? tab4[1] : ((f & 3) == 2 ? tab4[2] : tab4[3]));
            const int dec = f >> 2; inv *= (dec == 0 ? 1.f : (dec == 1 ? 0.1f : (dec == 2 ? 0.01f : 0.001f)));
            const float ang = (float)pos * inv;
            const double rev = (double)ang * 0.15915494309189535; const float fr = (float)(rev - (double)(long long)rev);
            cx.ropec()[i] = __builtin_amdgcn_cosf(fr); cx.ropes()[i] = __builtin_amdgcn_sinf(fr);
        }
    }
}

DI void phase_first_norm(const Ctx& cx) {
    const int gw = blockIdx.x * 4 + cx.wave, gstride = gridDim.x * 4;
    {
        for (int pair = (int)gridDim.x - 1 - (int)blockIdx.x; pair < DEPTH * 9; pair += (int)gridDim.x) {
            const int layer = pair / 9, row = pair % 9;
            const float* md = cx.mod() + ((size_t)layer * 9 + row) * 6144;
            const float* g = cx.in(7) + layer * D;
            float* gmo = cx.gm() + (size_t)pair * D;
            const float* wexp = cx.in(21) + (size_t)layer * D * 32; const float* wgrp = cx.in(19) + (size_t)layer * D * 4;
            float acc[36];
#pragma unroll
            for (int e = 0; e < 36; ++e) acc[e] = 0.f;
#pragma unroll
            for (int i = 0; i < 4; ++i) {
                const int k = cx.lane + 64 * (4 * cx.wave + i);
                gmo[k] = g[k] * (1.f + md[4096 + k]);
                const float sh = md[3072 + k];
                const f32x4* we = (const f32x4*)(wexp + (size_t)k * 32);
#pragma unroll
                for (int q = 0; q < 8; ++q) { const f32x4 w = we[q];
#pragma unroll
                    for (int e = 0; e < 4; ++e) acc[4 * q + e] += sh * w[e]; }
                const f32x4 wg = *(const f32x4*)(wgrp + (size_t)k * 4);
#pragma unroll
                for (int e = 0; e < 4; ++e) acc[32 + e] += sh * wg[e];
            }
#pragma unroll
            for (int e = 0; e < 36; ++e) acc[e] = wave_sum(acc[e]);
            LAS float* part = (LAS float*)cx.lds;
            if (cx.lane == 0) {
#pragma unroll
                for (int e = 0; e < 36; ++e) part[cx.wave * 36 + e] = acc[e];
            }
            __syncthreads();
            if (cx.tid < 36) {
                const float s = (part[cx.tid] + part[36 + cx.tid]) + (part[72 + cx.tid] + part[108 + cx.tid]);
                float* rco = cx.rc() + (size_t)pair * 64;
                rco[cx.tid] = s + (cx.tid < 32 ? cx.in(22)[layer * 32 + cx.tid] : cx.in(20)[layer * 4 + cx.tid - 32]);
            }
            __syncthreads();
        }
    }
#define P1_SRC(tt) ({ const int b_ = (tt) / TPB, j_ = (tt) - b_ * TPB; (j_ < CTX) ? cx.in(2) + (size_t)(b_ * CTX + j_) * D : cx.in(0) + (size_t)(b_ * SEQ + j_ - CTX) * D; })
    f32x4 nv[4];
    if (gw < T) load_row(P1_SRC(gw), nv, cx.lane);
    for (int t = gw; t < T; t += gstride) {
        const int b = t / TPB, j = t - b * TPB;
        f32x4 v[4];
#pragma unroll
        for (int q = 0; q < 4; ++q) v[q] = nv[q];
        if (t + gstride < T) load_row(P1_SRC(t + gstride), nv, cx.lane);
        store_row_bf16(cx.xres() + (size_t)t * D, v, cx.lane);
        const float* md = cx.mod() + (size_t)(j < CTX ? 8 : b) * 6144;
        norm_mod(v, cx.in(6), md, md + 1024, cx.lane);
        store_row_bf16(cx.H() + (size_t)t * D, v, cx.lane);
    }
#undef P1_SRC
}

DI void phase_norm_route(const Ctx& cx, int layer, bool last, bool dummy) {
    const int lane = cx.lane, c = lane & 31, h = lane >> 5, w = cx.wave;
    {
        int nhb = (T / 32) % (int)gridDim.x;
        if (4 * nhb >= (int)gridDim.x) nhb = 0;
        const int gw = ((int)blockIdx.x - nhb) * 4 + w, gstride = ((int)gridDim.x - nhb) * 4;
        for (int t = (gw < 0 ? T : gw); t < T; t += gstride) {
            const int b = t / TPB, j = t - b * TPB;
            if (last && j < CTX) continue;
            f32x4 v[4]; load_row_bf16(cx.xres() + (size_t)t * D, v, lane);
            const float* md = cx.mod() + ((size_t)layer * 9 + (j < CTX ? 8 : b)) * 6144;
            norm_mod(v, cx.in(7) + layer * D, md + 3072, md + 4096, lane);
            store_row_bf16(cx.H() + (size_t)t * D, v, lane);
        }
    }
    unsigned* cnt = cx.ctl() + CW_CNT + layer * 32 * 64 + (dummy ? 32 : 0);
    int* ltok_ = dummy ? (int*)cx.YP() : cx.ltok(); float* lw_ = dummy ? (float*)(cx.YP() + 4 * 1024 * 1024) : cx.lw();
    const bf16* whi = cx.wr() + (size_t)(layer * 2) * 64 * D + (size_t)c * D + 256 * w + 8 * h;
    LAS float* red = (LAS float*)cx.lds;
    LAS unsigned* hist = (LAS unsigned*)(cx.lds + 4 * 33 * 64 * 4);
    for (int task = blockIdx.x; task < T / 32; task += gridDim.x) {
        const int t0 = task * 32, b = t0 / TPB, j0 = t0 - b * TPB;
        if (last && j0 < CTX) continue;
        const int t = t0 + c, mrow = (j0 < CTX ? 8 : b);
        const bf16* xrow = cx.xres() + (size_t)t * D + 256 * w + 8 * h;
        const float* gmv = cx.gm() + ((size_t)layer * 9 + mrow) * D + 256 * w + 8 * h;
        float ss = 0.f;
        f32x16 acc0, acc1;
#pragma unroll
        for (int i = 0; i < 16; ++i) { acc0[i] = 0.f; acc1[i] = 0.f; }
        LAS unsigned char* park = cx.lds + w * 16384 + lane * 16;
#pragma unroll
        for (int s = 0; s < 16; ++s) glds16(xrow + 16 * s, park + s * 1024);
        asm volatile("s_waitcnt vmcnt(0)" ::: "memory");
#pragma unroll 4
        for (int s = 0; s < 16; ++s) {
            float x[8];
            { const u32x4 xq = *(LAS u32x4*)(park + s * 1024);
              const f32x4 a = {__builtin_bit_cast(float, xq.x << 16), __builtin_bit_cast(float, xq.x & 0xffff0000u), __builtin_bit_cast(float, xq.y << 16), __builtin_bit_cast(float, xq.y & 0xffff0000u)};
              const f32x4 bq = {__builtin_bit_cast(float, xq.z << 16), __builtin_bit_cast(float, xq.z & 0xffff0000u), __builtin_bit_cast(float, xq.w << 16), __builtin_bit_cast(float, xq.w & 0xffff0000u)};
              const f32x4 g0 = *(const f32x4*)(gmv + 16 * s), g1 = *(const f32x4*)(gmv + 16 * s + 4);
              ss += (a[0] * a[0] + a[1] * a[1]) + (a[2] * a[2] + a[3] * a[3]) + (bq[0] * bq[0] + bq[1] * bq[1]) + (bq[2] * bq[2] + bq[3] * bq[3]);
#pragma unroll
              for (int e = 0; e < 4; ++e) { x[e] = a[e] * g0[e]; x[4 + e] = bq[e] * g1[e]; } }
            u32x4 hi, lo;
            hi.x = pk2(x[0], x[1]); hi.y = pk2(x[2], x[3]); hi.z = pk2(x[4], x[5]); hi.w = pk2(x[6], x[7]);
            lo.x = pk2(x[0] - __builtin_bit_cast(float, hi.x << 16), x[1] - __builtin_bit_cast(float, hi.x & 0xffff0000u));
            lo.y = pk2(x[2] - __builtin_bit_cast(float, hi.y << 16), x[3] - __builtin_bit_cast(float, hi.y & 0xffff0000u));
            lo.z = pk2(x[4] - __builtin_bit_cast(float, hi.z << 16), x[5] - __builtin_bit_cast(float, hi.z & 0xffff0000u));
            lo.w = pk2(x[6] - __builtin_bit_cast(float, hi.w << 16), x[7] - __builtin_bit_cast(float, hi.w & 0xffff0000u));
            const bf16x8 bhi = __builtin_bit_cast(bf16x8, hi), blo = __builtin_bit_cast(bf16x8, lo);
            const bf16x8 ah0 = ldg8(whi + 16 * s), ah1 = ldg8(whi + 32 * D + 16 * s), al0 = ldg8(whi + 64 * D + 16 * s), al1 = ldg8(whi + 96 * D + 16 * s);
            acc0 = MFMA(ah0, bhi, acc0); acc0 = MFMA(al0, bhi, acc0); acc0 = MFMA(ah0, blo, acc0);
            acc1 = MFMA(ah1, bhi, acc1); acc1 = MFMA(al1, bhi, acc1); acc1 = MFMA(ah1, blo, acc1);
        }
        __syncthreads();
        LAS float* my = red + (size_t)w * 33 * 64 + lane;
#pragma unroll
        for (int i = 0; i < 16; ++i) { my[i * 64] = acc0[i]; my[(16 + i) * 64] = acc1[i]; }
        my[32 * 64] = ss;
        __syncthreads();
        if (w == 0) {
#pragma unroll
            for (int ww = 1; ww < 4; ++ww) {
                const LAS float* o = red + (size_t)ww * 33 * 64 + lane;
#pragma unroll
                for (int i = 0; i < 16; ++i) { acc0[i] += o[i * 64]; acc1[i] += o[(16 + i) * 64]; }
                ss += o[32 * 64];
            }
            ss += __shfl_xor(ss, 32);
            const float rn = rsqrtf(ss * (1.f / D) + EPS);
            const float* rcv = cx.rc() + ((size_t)layer * 9 + mrow) * 64;
            float gl[4];
#pragma unroll
            for (int g = 0; g < 4; ++g) gl[g] = __shfl(acc1[g], c) * rn + rcv[32 + g];
            int gi = 0; float gmx = gl[0];
#pragma unroll
            for (int g = 1; g < 4; ++g) if (gl[g] > gmx) { gmx = gl[g]; gi = g; }
            float gs = 0.f;
#pragma unroll
            for (int g = 0; g < 4; ++g) gs += __expf(gl[g] - gmx);
            const float gp = 1.f / gs;
            float mine[4], other[4], el[8];
#pragma unroll
            for (int e = 0; e < 4; ++e) {
                float xv = acc0[e];
#pragma unroll
                for (int g = 1; g < 4; ++g) xv = (gi == g) ? acc0[4 * g + e] : xv;
                mine[e] = xv * rn + rcv[gi * 8 + 4 * h + e];
            }
#pragma unroll
            for (int e = 0; e < 4; ++e) other[e] = __shfl_xor(mine[e], 32);
#pragma unroll
            for (int e = 0; e < 4; ++e) { el[e] = (h == 0) ? mine[e] : other[e]; el[4 + e] = (h == 0) ? other[e] : mine[e]; }
            int i1 = 0; float v1 = el[0];
#pragma unroll
            for (int e = 1; e < 8; ++e) if (el[e] > v1) { v1 = el[e]; i1 = e; }
            int i2 = 0; float v2 = -3.0e38f;
#pragma unroll
            for (int e = 0; e < 8; ++e) if (e != i1 && el[e] > v2) { v2 = el[e]; i2 = e; }
            const float ex = __expf(v2 - v1);
            const float w1 = gp / (1.f + ex), w2 = gp * ex / (1.f + ex);
            if (h == 0) {
                const int e1 = gi * 8 + i1, e2 = gi * 8 + i2;
                hist[c] = 0u;
                asm volatile("s_waitcnt lgkmcnt(0)" ::: "memory");
                const unsigned r1 = __hip_atomic_fetch_add(&hist[e1], 1u, __ATOMIC_RELAXED, __HIP_MEMORY_SCOPE_WORKGROUP);
                const unsigned r2 = __hip_atomic_fetch_add(&hist[e2], 1u, __ATOMIC_RELAXED, __HIP_MEMORY_SCOPE_WORKGROUP);
                asm volatile("s_waitcnt lgkmcnt(0)" ::: "memory");
                const unsigned n = hist[c];
                unsigned bs = 0u;
                if (n) bs = atomicAdd(&cnt[c * 64], n);
                hist[32 + c] = bs;
                asm volatile("s_waitcnt lgkmcnt(0)" ::: "memory");
                const unsigned s1 = hist[32 + e1] + r1, s2 = hist[32 + e2] + r2;
                ltok_[(size_t)e1 * LCAP + s1] = t * 2;     lw_[(size_t)e1 * LCAP + s1] = w1;
                ltok_[(size_t)e2 * LCAP + s2] = t * 2 + 1; lw_[(size_t)e2 * LCAP + s2] = w2;
            }
        }
        __syncthreads();
    }
}

DI ConvTask conv_task(const Ctx& cx, int layer, int task, int lane) {
    const int e = task / 768, u = task - e * 768, which = u >> 8, v = u & 255;
    const float* W; bf16* WT; int K, N, kt, nt;
    if (which == 0) { W = cx.in(23) + ((size_t)layer * NEXP + e) * D * DEXP; WT = cx.wmg() + (size_t)e * DEXP * D; K = D; N = DEXP; kt = v >> 4; nt = v & 15; }
    else if (which == 1) { W = cx.in(24) + ((size_t)layer * NEXP + e) * D * DEXP; WT = cx.wmu() + (size_t)e * DEXP * D; K = D; N = DEXP; kt = v >> 4; nt = v & 15; }
    else { W = cx.in(25) + ((size_t)layer * NEXP + e) * DEXP * D; WT = cx.wmd() + (size_t)e * D * DEXP; K = DEXP; N = D; kt = v >> 5; nt = v & 31; }
    ConvTask t;
    t.src = W + (size_t)(kt * 64 + (lane >> 3)) * N + nt * 32 + (lane & 7) * 4;
    t.dst = WT + (size_t)(nt * 32 + (lane >> 3)) * K + kt * 64 + (lane & 7) * 8;
    t.N = N; t.K = K;
    return t;
}
DI void moe_convert(const Ctx& cx, int layer) {
    const int gw = blockIdx.x * 4 + cx.wave, nw = gridDim.x * 4;
    const int lane = cx.lane;
    constexpr int NT = NEXP * 768;
    LAS float* scr = (LAS float*)(cx.lds + 36864) + cx.wave * (64 * 33);
#define CV_LOAD(X, task) do { const ConvTask ct_ = conv_task(cx, layer, (task), lane); \
        _Pragma("unroll") for (int p = 0; p < 8; ++p) X[p] = *(const f32x4*)(ct_.src + (size_t)(8 * p) * ct_.N); } while (0)
#define CV_PROC(X, task) do { const ConvTask ct_ = conv_task(cx, layer, (task), lane); \
        _Pragma("unroll") for (int p = 0; p < 8; ++p) { LAS float* d = scr + ((lane >> 3) + 8 * p) * 33 + (lane & 7) * 4; d[0] = X[p][0]; d[1] = X[p][1]; d[2] = X[p][2]; d[3] = X[p][3]; } \
        asm volatile("s_waitcnt lgkmcnt(0)" ::: "memory"); \
        _Pragma("unroll") for (int p = 0; p < 4; ++p) { const LAS float* s = scr + ((lane & 7) * 8) * 33 + (lane >> 3) + 8 * p; \
            u32x4 o; o.x = pk2(s[0], s[33]); o.y = pk2(s[2 * 33], s[3 * 33]); o.z = pk2(s[4 * 33], s[5 * 33]); o.w = pk2(s[6 * 33], s[7 * 33]); \
            *(u32x4*)(ct_.dst + (size_t)(8 * p) * ct_.K) = o; } \
        asm volatile("s_waitcnt lgkmcnt(0)" ::: "memory"); } while (0)
    int nheavy = ((T / 32) % (int)gridDim.x) * 4;
    if (2 * nheavy >= nw) nheavy = 0;
    const bool heavy = gw < nheavy;
    const int S = nw - nheavy, base = gw - nheavy;
#define CV_ITEM(j) (heavy ? NT : base + S * (j))
    f32x4 xa[8], xb[8];
    int j = 0, task = CV_ITEM(0);
    if (task < NT) CV_LOAD(xa, task);
#pragma unroll 1
    while (task < NT) {
        const int t2 = CV_ITEM(j + 1), t3 = CV_ITEM(j + 2);
        if (t2 < NT) CV_LOAD(xb, t2);
        CV_PROC(xa, task);
        if (t3 < NT) CV_LOAD(xa, t3);
        if (t2 < NT) CV_PROC(xb, t2);
        task = t3; j += 2;
    }
#undef CV_ITEM
#undef CV_LOAD
#undef CV_PROC
}

DI void phase_combine(const Ctx& cx, int layer, bool last, bool dummy) {
    const int gw = blockIdx.x * 4 + cx.wave, gstride = gridDim.x * 4;
    for (int t = gw; t < T; t += gstride) {
        const int b = t / TPB, j = t - b * TPB;
        if (last && j < CTX) continue;
        bf16* xr = cx.xres() + (size_t)t * D;
        f32x4 v[4]; load_row_bf16(xr, v, cx.lane);
        const int mr = (j < CTX) ? 8 : b;
        const float* g2 = cx.mod() + ((size_t)layer * 9 + mr) * 6144 + 5120;
        const bf16* y0 = cx.YP() + (size_t)(2 * t) * D; const bf16* y1 = y0 + D;
#pragma unroll
        for (int jj = 0; jj < 4; ++jj) {
            const u32x2 a = ((const u32x2*)y0)[cx.lane + 64 * jj], bq = ((const u32x2*)y1)[cx.lane + 64 * jj];
            const f32x4 gg = ((const f32x4*)g2)[cx.lane + 64 * jj];
            float ya[4] = {bf2f((unsigned short)(a.x & 0xffff)), bf2f((unsigned short)(a.x >> 16)), bf2f((unsigned short)(a.y & 0xffff)), bf2f((unsigned short)(a.y >> 16))};
            float yb[4] = {bf2f((unsigned short)(bq.x & 0xffff)), bf2f((unsigned short)(bq.x >> 16)), bf2f((unsigned short)(bq.y & 0xffff)), bf2f((unsigned short)(bq.y >> 16))};
#pragma unroll
            for (int e = 0; e < 4; ++e) v[jj][e] += gg[e] * (ya[e] + yb[e]);
        }
        if (!last) {
            bf16* xw = dummy ? cx.Q() + (size_t)t * D : xr;
            store_row_bf16(xw, v, cx.lane);
            const float* md = cx.mod() + ((size_t)(layer + 1) * 9 + mr) * 6144;
            norm_mod(v, cx.in(6) + (layer + 1) * D, md, md + 1024, cx.lane);
            store_row_bf16(cx.H() + (size_t)t * D, v, cx.lane);
        } else {
            float ss = 0.f;
#pragma unroll
            for (int jj = 0; jj < 4; ++jj) ss += (v[jj][0] * v[jj][0] + v[jj][1] * v[jj][1]) + (v[jj][2] * v[jj][2] + v[jj][3] * v[jj][3]);
            const float rn = rsqrtf(wave_sum(ss) * (1.f / D) + EPS);
            float* orow = cx.out() + (size_t)(b * SEQ + j - CTX) * D;
#pragma unroll
            for (int jj = 0; jj < 4; ++jj) {
                const f32x4 gg = ((const f32x4*)cx.in(8))[cx.lane + 64 * jj];
                f32x4 o;
#pragma unroll
                for (int e = 0; e < 4; ++e) o[e] = v[jj][e] * rn * gg[e];
                ((f32x4*)orow)[cx.lane + 64 * jj] = o;
            }
        }
    }
}

DI void moe_directory(const Ctx& cx, int layer, LAS int* s_off, LAS int* s_toff) {
    if (cx.tid < 64) {
        const unsigned* cnt = cx.ctl() + CW_CNT + layer * 32 * 64;
        const int e = cx.lane;
        const int c = (e < NEXP) ? (int)cnt[e * 64] : 0;
        int o = c, to = (c + 127) >> 7;
#pragma unroll
        for (int d = 1; d < NEXP; d <<= 1) { const int a = __shfl_up(o, d), b2 = __shfl_up(to, d); if (e >= d) { o += a; to += b2; } }
        if (e < NEXP) { s_off[e + 1] = o; s_toff[e + 1] = to; }
        if (e == 0) { s_off[0] = 0; s_toff[0] = 0; }
    }
    __syncthreads();
}

__global__ void __launch_bounds__(NTHREADS, 2) fwd_kernel(Params p) {
    extern __shared__ __attribute__((aligned(16))) unsigned char lds_raw[];
    Ctx cx;
    cx.pp = (ParamsPtr)__builtin_amdgcn_kernarg_segment_ptr();
    cx.lds = (LAS unsigned char*)lds_raw;
    cx.tid = threadIdx.x; cx.lane = cx.tid & 63; cx.wave = __builtin_amdgcn_readfirstlane(cx.tid >> 6);
    volatile LAS unsigned* misc = (volatile LAS unsigned*)(cx.lds + LDS_MISC);
    LAS int* s_off = (LAS int*)(cx.lds + LDS_MISC + 64);
    LAS int* s_toff = (LAS int*)(cx.lds + LDS_MISC + 64 + 160);
    if (cx.tid < 2) misc[cx.tid] = 0u;
    __syncthreads();
    if (cx.pp->ph_hi - cx.pp->ph_lo > 1) (void)xcd_barrier_post((unsigned*)(cx.pp->ws + WS_CTL) + CW_BAR, misc);
    bool again_ = false;
    for (int ph = cx.pp->ph_lo; ; ) {
        asm volatile("" : "+s"(cx.pp));
        { int tid_ = threadIdx.x; asm volatile("" : "+v"(tid_)); cx.tid = tid_; cx.lane = tid_ & 63; cx.wave = __builtin_amdgcn_readfirstlane(tid_ >> 6); }
        if (ph == 0) phase_prologue(cx);
        else if (ph == 1) phase_first_norm(cx);
        else {
            const int layer = (ph - 2) / 7, sub = (ph - 2) % 7, kind = layer % 3;
#ifdef PROBE_REP
            const bool dummy = !again_ && ((PROBE_REP >> ph) & 1ull);
#else
            const bool dummy = false;
#endif
            const bool last = (layer == DEPTH - 1);
            const int vbid = (gridDim.x & 7) ? (int)blockIdx.x : (int)((blockIdx.x & 7) * (gridDim.x >> 3) + (blockIdx.x >> 3));
            if (sub == 0) {
                QkvOp op; op.A = cx.H(); op.kind = kind; op.Q = cx.Q(); op.Kb = cx.K(); op.VT = cx.VT(); op.rc = cx.ropec(); op.rs = cx.ropes();
                op.Wt = cx.wqkv(layer);
                if (kind == 2) { op.N = 1536; op.kw = 256; op.voff = 1280; op.vw = 256; }
                else { op.N = 3072; op.kw = D; op.voff = 2048; op.vw = D; }
                const int ntn = op.N / 128, ntiles = (T / 128) * ntn;
                for (int tile = blockIdx.x; tile < ntiles; tile += gridDim.x) {
                    op.m0 = (tile / ntn) * 128; op.n0 = (tile % ntn) * 128;
                    gemm_tile<2, 2, 64>(op, cx.lds, cx.tid);
                }
            } else if (sub == 1) {
                if (kind == 1) attn_block_da(cx, layer, !last, vbid); else attn_block_nasw(cx, kind, layer, !last, vbid);
            } else if (sub == 2) {
                OutOp op; op.A = cx.O(); op.xres = cx.xres(); op.xdst = dummy ? cx.Q() : cx.xres(); op.modl = cx.mod() + (size_t)layer * 9 * 6144;
                op.Wt = cx.wo(layer);
                for (int tile = vbid; tile < 1024; tile += gridDim.x) {
                    int mt = tile >> 3;
                    if (last) mt = (mt >> 4) * 18 + 2 + (mt & 15);
                    op.m0 = mt * 128; op.n0 = (tile & 7) * 128;
                    gemm_tile<2, 2, 64>(op, cx.lds, cx.tid);
                }
                if (!last) for (int u = blockIdx.x; u < 256; u += gridDim.x) {
                    op.m0 = 128 * 128 + (u >> 3) * 64; op.n0 = (u & 7) * 128;
                    gemm_tile<1, 2, 64>(op, cx.lds, cx.tid);
                }
            } else if (sub == 3) {
                if (blockIdx.x & 1) { moe_convert(cx, layer); __syncthreads(); }
                phase_norm_route(cx, layer, last, dummy);
                if (!(blockIdx.x & 1)) { __syncthreads(); moe_convert(cx, layer); }
#ifdef PROBE_CONV2
                moe_convert(cx, layer);
#endif
            } else if (sub == 4) {
                moe_directory(cx, layer, s_off, s_toff);
                const int ntiles = s_toff[NEXP] * 8;
                int ecur = 0;
                for (int tile = vbid; tile < ntiles; tile += gridDim.x) {
                    const int rtg = tile >> 3; int e = ecur;
                    while (s_toff[e + 1] <= rtg) ++e;
                    ecur = e;
                    GateUpOp op; op.H = cx.H(); op.cnt = s_off[e + 1] - s_off[e]; op.r0 = (rtg - s_toff[e]) * 128; op.f0 = (tile & 7) * 64;
                    op.WgT = cx.wmg() + (size_t)e * DEXP * D; op.WuT = cx.wmu() + (size_t)e * DEXP * D;
                    op.ltok = cx.ltok() + (size_t)e * LCAP; op.act = cx.ACT() + (size_t)s_off[e] * DEXP;
                    gemm_tile<2, 2, 64>(op, cx.lds, cx.tid);
                }
            } else if (sub == 5) {
                moe_directory(cx, layer, s_off, s_toff);
                const int ntiles = s_toff[NEXP] * 8;
                DownOp op, nop; op.yp = cx.YP(); nop.yp = op.yp;
#define F_SET(o, tl) do { const int rtg_ = (tl) >> 3; int e_ = ecur; while (s_toff[e_ + 1] <= rtg_) ++e_; ecur = e_; \
                    (o).cnt = s_off[e_ + 1] - s_off[e_]; (o).r0 = (rtg_ - s_toff[e_]) * 128; (o).n0 = ((tl) & 7) * 128; \
                    (o).act = cx.ACT() + (size_t)s_off[e_] * DEXP; (o).WdT = cx.wmd() + (size_t)e_ * D * DEXP; \
                    (o).ltok = cx.ltok() + (size_t)e_ * LCAP; (o).lw = cx.lw() + (size_t)e_ * LCAP; } while (0)
                int tile = vbid, ecur = 0; bool first = true;
                if (tile < ntiles) F_SET(op, tile);
                while (tile < ntiles) {
                    const int nt_ = tile + gridDim.x; const bool hn = nt_ < ntiles;
                    if (hn) F_SET(nop, nt_); else nop = op;
                    gemm_tile_x<2, 2, 64, true>(op, nop, hn, first, cx.lds, cx.tid);
                    op = nop; tile = nt_; first = false;
                }
#undef F_SET
            } else {
                phase_combine(cx, layer, last, dummy);
            }
        }
#ifdef PROBE_REP
        if (!again_ && ((PROBE_REP >> ph) & 1ull)) again_ = true; else { again_ = false; ++ph; }
#else
        ++ph;
#endif
        if (ph >= cx.pp->ph_hi) break;
        { XcdBarrier bar; bar.bar = cx.ctl() + CW_BAR; bar.x = xb_xcc_id(); bar.st = (volatile LAS unsigned*)(cx.lds + LDS_MISC); xcd_barrier(bar);
#ifdef PROBE_BAR2
          xcd_barrier(bar);
#endif
        }
    }
}

extern "C" void kernel_launch(void* const* d_in, const int* in_sizes, int n_in, void* d_out, int out_size, void* d_ws, size_t ws_size, hipStream_t stream) {
    static int grid = 0;
    if (grid == 0) {
        if (n_in != 26 || ws_size < WS_END) { fprintf(stderr, "kernel_launch: unexpected inputs (n_in %d) or workspace %zu < %zu\n", n_in, ws_size, (size_t)WS_END); grid = -1; return; }
        int dev = 0, cus = 0, per_cu = 0;
        (void)hipGetDevice(&dev);
        (void)hipDeviceGetAttribute(&cus, hipDeviceAttributeMultiprocessorCount, dev);
        if (hipFuncSetAttribute((const void*)fwd_kernel, hipFuncAttributeMaxDynamicSharedMemorySize, LDS_BYTES) != hipSuccess) { fprintf(stderr, "kernel_launch: hipFuncSetAttribute failed\n"); grid = -1; return; }
        if (hipOccupancyMaxActiveBlocksPerMultiprocessor(&per_cu, (const void*)fwd_kernel, NTHREADS, LDS_BYTES) != hipSuccess || per_cu < 1) { fprintf(stderr, "kernel_launch: occupancy query failed (%d)\n", per_cu); per_cu = 1; }
        (void)hipGetLastError();
        if (per_cu > 2) per_cu = 2;
        grid = cus * per_cu;
        fprintf(stderr, "kernel_launch: %d CUs x %d blocks\n", cus, per_cu);
    }
    if (grid < 0) return;
    (void)hipMemsetAsync((char*)d_ws + WS_CTL, 0, CTL_BYTES, stream);
    Params p{};
    for (int i = 0; i < 26; ++i) p.in[i] = (const float*)d_in[i];
    p.out = (float*)d_out; p.ws = (unsigned char*)d_ws;
#if ONE_LAUNCH
    p.ph_lo = 0; p.ph_hi = NPHASES;
    hipLaunchKernelGGL(fwd_kernel, dim3(grid), dim3(NTHREADS), LDS_BYTES, stream, p);
#else
    for (int ph = 0; ph < NPHASES; ++ph) {
        p.ph_lo = ph; p.ph_hi = ph + 1;
        hipLaunchKernelGGL(fwd_kernel, dim3(grid), dim3(NTHREADS), LDS_BYTES, stream, p);
    }
#endif
}
```

```cpp
#include <hip/hip_runtime.h>
#include <cstdio>
#include <cstdint>

#ifndef ONE_LAUNCH
#define ONE_LAUNCH 1
#define PROBE_REP 0ull
#ifndef IGLP_ATT
#define IGLP_ATT 3
#endif


#endif

#define DI __device__ __forceinline__
#define LAS __attribute__((address_space(3)))
typedef unsigned short bf16;
typedef short bf16x8 __attribute__((ext_vector_type(8)));
typedef float f32x16 __attribute__((ext_vector_type(16)));
typedef float f32x4 __attribute__((ext_vector_type(4)));
typedef float f32x2 __attribute__((ext_vector_type(2)));
typedef unsigned u32x4 __attribute__((ext_vector_type(4)));
typedef unsigned u32x2 __attribute__((ext_vector_type(2)));
typedef __bf16 bf16x2_t __attribute__((ext_vector_type(2)));
#define MFMA(a, b, c) __builtin_amdgcn_mfma_f32_32x32x16_bf16((a), (b), (c), 0, 0, 0)

constexpr int D = 1024, NB = 8, SEQ = 2048, CTX = 256, DEPTH = 4;
constexpr int TPB = CTX + SEQ;
constexpr int T = NB * TPB;
constexpr int NEXP = 32, DEXP = 512;
constexpr int LCAP = T;
constexpr float EPS = 1e-6f;
constexpr float LOG2E = 1.4426950408889634f;
constexpr float SM_C = 0.125f * LOG2E;
constexpr float NEG = -1e30f;

constexpr size_t MiB = 1u << 20;
constexpr size_t WS_CTL = 0, CTL_BYTES = 65536;
constexpr size_t WS_MOD = 1 * MiB;
constexpr size_t WS_ROPE = 2 * MiB;
constexpr size_t WS_LTOK = 3 * MiB;
constexpr size_t WS_LW = 6 * MiB;
constexpr size_t WS_WR = 9 * MiB;
constexpr size_t WS_WQKV = 416 * MiB;
constexpr size_t WS_WO = 440 * MiB;
constexpr size_t WS_GM = 10 * MiB;
constexpr size_t WS_RC = 11 * MiB;
constexpr size_t WS_RPB = 12 * MiB;
constexpr size_t WS_XRES = 16 * MiB;
constexpr size_t WS_H = 96 * MiB;
constexpr size_t WS_Q = 136 * MiB;
constexpr size_t WS_K = 176 * MiB;
constexpr size_t WS_VT = 216 * MiB;
constexpr size_t WS_O = 256 * MiB;
constexpr size_t WS_ACT = 296 * MiB;
constexpr size_t WS_YP = 336 * MiB;
constexpr size_t WS_WMG = 448 * MiB;
constexpr size_t WS_WMU = 480 * MiB;
constexpr size_t WS_WMD = 512 * MiB;
constexpr size_t WS_END = 544 * MiB;
constexpr int CW_BAR = 0;
constexpr int CW_CNT = 8192;

constexpr int NTHREADS = 256;
constexpr int LDS_GEMM = 73728;
constexpr int LDS_MISC = LDS_GEMM;
constexpr int LDS_BYTES = LDS_GEMM + 1024;
constexpr int NPHASES = 2 + 7 * DEPTH;

struct Params {
    const float* in[26];
    float* out;
    unsigned char* ws;
    int ph_lo, ph_hi;
};

DI unsigned pk2(float lo, float hi) { f32x2 v = {lo, hi}; bf16x2_t r = __builtin_convertvector(v, bf16x2_t); return __builtin_bit_cast(unsigned, r); }
DI float bf2f(unsigned short u) { return __builtin_bit_cast(float, (unsigned)u << 16); }
DI float wave_sum(float v) {
#pragma unroll
    for (int o = 1; o < 64; o <<= 1) v += __shfl_xor(v, o);
    return v;
}
DI float fexp2(float x) { return __builtin_amdgcn_exp2f(x); }
DI float silu(float v) { return v * __builtin_amdgcn_rcpf(1.f + __expf(-v)); }
DI bf16x8 ldg8(const bf16* p) { return *(const bf16x8*)p; }
DI void glds16(const void* g, LAS unsigned char* l) {
    __builtin_amdgcn_global_load_lds((const unsigned*)g, (LAS unsigned*)l, 16, 0, 0);
}
DI int pi32(int r) { return (r & 0x13) | ((r & 4) << 1) | ((r & 8) >> 1); }

#define XB_TMO      128
#define XB_XCNT(j)  (256  + 64 * (j))
#define XB_XSUB(j)  (1280 + 64 * (j))
#define XB_XGEN(j)  (2304 + 64 * (j))
#define XB_TOP      3328
#define XB_TOPGEN   3392
#define XCD_BAR_WORDS 3456
#define XB_SPIN_CAP (1u << 20)
DI unsigned xb_ld(unsigned* p) { return __hip_atomic_load(p, __ATOMIC_RELAXED, __HIP_MEMORY_SCOPE_AGENT); }
DI unsigned xb_add(unsigned* p, unsigned v) { return __hip_atomic_fetch_add(p, v, __ATOMIC_RELAXED, __HIP_MEMORY_SCOPE_AGENT); }
DI unsigned xb_xcc_id() { return (unsigned)__builtin_amdgcn_s_getreg((3 << 11) | 20) & 0xFu; }
#define XB_SPIN(cond, bar) do { unsigned _sp = 0; while (cond) { __builtin_amdgcn_s_sleep(1); \
    if ((++_sp & 255u) == 0u) { if (xb_ld(&(bar)[XB_TMO])) break; if (_sp > XB_SPIN_CAP) { atomicAdd(&(bar)[XB_TMO], 1u); break; } } } } while (0)
struct XcdBarrier { unsigned* bar; unsigned x; volatile LAS unsigned* st; };
DI XcdBarrier xcd_barrier_post(unsigned* bar, volatile LAS unsigned* st) {
    XcdBarrier b; b.bar = bar; b.x = xb_xcc_id(); b.st = st;
    if (threadIdx.x == 0) (void)xb_add(&bar[XB_XCNT(b.x)], 1u);
    return b;
}
DI void xcd_barrier_complete(unsigned* bar, unsigned x, unsigned& nloc, unsigned& nx) {
    const unsigned G = gridDim.x * gridDim.y * gridDim.z;
    unsigned sum, cnt, mine, sp = 0u;
    for (;;) {
        sum = 0u; cnt = 0u; mine = 0u;
#pragma unroll
        for (unsigned j = 0; j < 16; ++j) { const unsigned c = xb_ld(&bar[XB_XCNT(j)]); sum += c; cnt += (c > 0u) ? 1u : 0u; mine = (j == x) ? c : mine; }
        if (sum == G) break;
        __builtin_amdgcn_s_sleep(1);
        if ((++sp & 255u) == 0u) { if (xb_ld(&bar[XB_TMO])) break; if (sp > XB_SPIN_CAP) { atomicAdd(&bar[XB_TMO], 1u); break; } }
    }
    nloc = mine > 0u ? mine : 1u; nx = cnt > 0u ? cnt : 1u;
}
DI void xcd_barrier(const XcdBarrier& b) {
    asm volatile("s_waitcnt vmcnt(0)" ::: "memory");
    __syncthreads();
    if (threadIdx.x == 0) {
        unsigned* bar = b.bar;
        __builtin_amdgcn_s_waitcnt(0);
        unsigned nloc = b.st[0], nx = b.st[1];
        if (nloc == 0u) { xcd_barrier_complete(bar, b.x, nloc, nx); b.st[0] = nloc; b.st[1] = nx; }
        const unsigned old = xb_add(&bar[XB_XSUB(b.x)], 1u);
        const unsigned gen = old / nloc;
        if (old + 1u == (gen + 1u) * nloc) {
            __builtin_amdgcn_fence(__ATOMIC_RELEASE, "agent");
            asm volatile("s_waitcnt vmcnt(0)" ::: "memory");
            const unsigned og = xb_add(&bar[XB_TOP], 1u);
            const unsigned tg = og / nx;
            if (og + 1u == (tg + 1u) * nx) xb_add(&bar[XB_TOPGEN], 1u);
            else XB_SPIN(xb_ld(&bar[XB_TOPGEN]) == tg, bar);
            __builtin_amdgcn_fence(__ATOMIC_ACQUIRE, "agent");
            xb_add(&bar[XB_XGEN(b.x)], 1u);
            asm volatile("s_waitcnt vmcnt(0)" ::: "memory");
        } else {
            XB_SPIN(xb_ld(&bar[XB_XGEN(b.x)]) == gen, bar);
            __builtin_amdgcn_fence(__ATOMIC_ACQUIRE, "agent");
            asm volatile("s_waitcnt vmcnt(0)" ::: "memory");
        }
    }
    __syncthreads();
}

typedef const __attribute__((address_space(4))) Params* ParamsPtr;
struct Ctx {
    ParamsPtr pp;
    LAS unsigned char* lds;
    int tid, lane, wave;
    DI const float* in(int i) const { return pp->in[i]; }
    DI float* out() const { return pp->out; }
    DI unsigned char* ws() const { return pp->ws; }
    DI unsigned* ctl() const { return (unsigned*)(ws() + WS_CTL); }
    DI float* mod() const { return (float*)(ws() + WS_MOD); }
    DI float* ropec() const { return (float*)(ws() + WS_ROPE); }
    DI float* ropes() const { return (float*)(ws() + WS_ROPE) + 1024; }
    DI int* ltok() const { return (int*)(ws() + WS_LTOK); }
    DI float* lw() const { return (float*)(ws() + WS_LW); }
    DI bf16* wr() const { return (bf16*)(ws() + WS_WR); }
    DI bf16* wqkv(int layer) const { return (bf16*)(ws() + WS_WQKV) + (size_t)layer * 3072 * D; }
    DI bf16* wmg() const { return (bf16*)(ws() + WS_WMG); }
    DI bf16* wmu() const { return (bf16*)(ws() + WS_WMU); }
    DI bf16* wmd() const { return (bf16*)(ws() + WS_WMD); }
    DI bf16* wo(int layer) const { return (bf16*)(ws() + WS_WO) + (size_t)layer * D * D; }
    DI float* gm() const { return (float*)(ws() + WS_GM); }
    DI float* rc() const { return (float*)(ws() + WS_RC); }
    DI float* rpbp() const { return (float*)(ws() + WS_RPB); }
    DI bf16* xres() const { return (bf16*)(ws() + WS_XRES); }
    DI bf16* H() const { return (bf16*)(ws() + WS_H); }
    DI bf16* Q() const { return (bf16*)(ws() + WS_Q); }
    DI bf16* K() const { return (bf16*)(ws() + WS_K); }
    DI bf16* VT() const { return (bf16*)(ws() + WS_VT); }
    DI bf16* O() const { return (bf16*)(ws() + WS_O); }
    DI bf16* ACT() const { return (bf16*)(ws() + WS_ACT); }
    DI bf16* YP() const { return (bf16*)(ws() + WS_YP); }
};

DI int mod_row(int t) { const int b = t / TPB; return (t - b * TPB) < CTX ? 8 : b; }

template <int MI, int NSTG, int BK, bool CHAIN, class Op>
DI void gemm_tile_x(const Op& op, const Op& nop, bool has_next, bool first, LAS unsigned char* lds, int tid) {
    constexpr int BM = 64 * MI, RB = BK * 2  , STG = (BM + 128) * RB, APC = BM * RB / 4096, BPC = 128 * RB / 4096, LPT = APC + BPC, KS = BK / 16, RPP = 4096 / RB  ;
    const int lane = tid & 63, wave = tid >> 6, wm = wave & 1, wn = wave >> 1;
    const int r = lane & 31, h = lane >> 5;
    const int K = op.K(), nk = K / BK;
    const int srow = (BK == 32) ? (tid >> 2) : (tid >> 3);
    const int sch = (BK == 32) ? ((tid & 3) ^ ((tid >> 4) & 3)) : ((tid & 7) ^ ((tid >> 4) & 7));
    const bf16* ap[APC]; const bf16* bpt[BPC];
#pragma unroll
    for (int i = 0; i < APC; ++i) ap[i] = op.arow(srow + RPP * i) + sch * 8;
#pragma unroll
    for (int i = 0; i < BPC; ++i) bpt[i] = op.brow_ptr(srow + RPP * i) + sch * 8;
    const unsigned xs = (BK == 32) ? ((r >> 2) & 3) : ((r >> 1) & 7);
    unsigned a_rd[MI], b_rd[2];
#pragma unroll
    for (int mi = 0; mi < MI; ++mi) a_rd[mi] = (32 * MI * wm + 32 * mi + r) * RB;
#pragma unroll
    for (int ni = 0; ni < 2; ++ni) b_rd[ni] = BM * RB + (op.brow(wn, ni) + r) * RB;

    f32x16 acc[2][MI];
#pragma unroll
    for (int ni = 0; ni < 2; ++ni)
#pragma unroll
        for (int mi = 0; mi < MI; ++mi)
#pragma unroll
            for (int i = 0; i < 16; ++i) acc[ni][mi][i] = 0.f;
    typename Op::template Pre<MI> pre;
    op.template prefetch<MI>(pre, wm, wn, r, h);

#define G_ISSUE(kt, stg) do { LAS unsigned char* s_ = lds + (stg) * STG + tid * 16; \
        _Pragma("unroll") for (int i = 0; i < APC; ++i) glds16(ap[i] + (kt) * BK, s_ + i * 4096); \
        _Pragma("unroll") for (int i = 0; i < BPC; ++i) glds16(bpt[i] + (kt) * BK, s_ + BM * RB + i * 4096); } while (0)

    if (!CHAIN || first) {
        __syncthreads();
#pragma unroll
        for (int s = 0; s < NSTG - 1; ++s) if (s < nk) G_ISSUE(s, s);
    }
    int stg = 0, istg = NSTG - 1;
    for (int kt = 0; kt < nk; ++kt) {
        if (kt + NSTG - 2 < nk) asm volatile("s_waitcnt vmcnt(%0)" :: "n"((NSTG - 2) * LPT) : "memory");
        else asm volatile("s_waitcnt vmcnt(0)" ::: "memory");
        __builtin_amdgcn_s_barrier();
        asm volatile("" ::: "memory");
        if (kt + NSTG - 1 < nk) G_ISSUE(kt + NSTG - 1, istg);
        __builtin_amdgcn_sched_barrier(0);
        LAS unsigned char* base = lds + stg * STG;
        __builtin_amdgcn_iglp_opt(1);
#pragma unroll
        for (int s = 0; s < KS; ++s) {
            const unsigned co = (unsigned)(((2 * s + h) ^ xs) << 4);
            bf16x8 af[MI], bfr[2];
#pragma unroll
            for (int mi = 0; mi < MI; ++mi) af[mi] = *(LAS bf16x8*)(base + a_rd[mi] + co);
#pragma unroll
            for (int ni = 0; ni < 2; ++ni) bfr[ni] = *(LAS bf16x8*)(base + b_rd[ni] + co);
#pragma unroll
            for (int ni = 0; ni < 2; ++ni)
#pragma unroll
                for (int mi = 0; mi < MI; ++mi) acc[ni][mi] = MFMA(bfr[ni], af[mi], acc[ni][mi]);
        }
        asm volatile("" ::: "memory");
        stg = (stg + 1 == NSTG) ? 0 : stg + 1; istg = (istg + 1 == NSTG) ? 0 : istg + 1;
    }
#undef G_ISSUE
    if (CHAIN) {
        __syncthreads();
        if (has_next) {
#pragma unroll
            for (int s = 0; s < NSTG - 1; ++s) if (s < nk) {
                LAS unsigned char* s_ = lds + s * STG + tid * 16;
#pragma unroll
                for (int i = 0; i < APC; ++i) glds16(nop.arow(srow + RPP * i) + sch * 8 + s * BK, s_ + i * 4096);
#pragma unroll
                for (int i = 0; i < BPC; ++i) glds16(nop.brow_ptr(srow + RPP * i) + sch * 8 + s * BK, s_ + BM * RB + i * 4096);
            }
        }
        __builtin_amdgcn_sched_barrier(0);
    }
    if (Op::kLdsEpi) {
        __syncthreads();
        op.template epi_lds<MI>(acc, pre, wm, wn, r, h, lds + (CHAIN ? 32768 : 0) + wave * 8704);
    } else op.template epi<MI>(acc, pre, wm, wn, r, h);
}
template <int MI, int NSTG, int BK, class Op>
DI void gemm_tile(const Op& op, LAS unsigned char* lds, int tid) { gemm_tile_x<MI, NSTG, BK, false>(op, op, false, true, lds, tid); }

struct QkvOp {
    template <int MI, class P> DI void epi_lds(f32x16 (&acc)[2][MI], const P&, int wm, int wn, int c, int h, LAS unsigned char* wl) const {
        const int lane = c + 32 * h;
        const int nb0 = n0 + 64 * wn;
        const int t0 = m0 + 32 * MI * wm;
        if (nb0 < voff) {
#pragma unroll
            for (int mi = 0; mi < MI; ++mi) {
                const int t = t0 + 32 * mi + c;
                const int b = t / TPB, j = t - b * TPB;
#pragma unroll
                for (int ni = 0; ni < 2; ++ni) {
                    const int nb = nb0 + 32 * ni;
                    f32x16 v = acc[ni][mi];
                    if (kind != 0 && j >= CTX) {
                        const int s = j - CTX;
                        const int pos = ((nb >> 5) & 1) ? (s & 63) : (s >> 6);
#pragma unroll
                        for (int g = 0; g < 2; ++g) {
                            const f32x4 cs4 = *(LAS const f32x4*)(rl + pos * 16 + 8 * g + 4 * h), sn4 = *(LAS const f32x4*)(rl + 1024 + pos * 16 + 8 * g + 4 * h);
#pragma unroll
                            for (int e = 0; e < 4; ++e) {
                                const int i = 4 * g + e;
                                const float x1 = v[i], x2 = v[i + 8];
                                v[i] = x1 * cs4[e] - x2 * sn4[e]; v[i + 8] = x2 * cs4[e] + x1 * sn4[e];
                            }
                        }
                    }
#pragma unroll
                    for (int g = 0; g < 4; ++g) {
                        u32x2 w; w.x = pk2(v[4 * g], v[4 * g + 1]); w.y = pk2(v[4 * g + 2], v[4 * g + 3]);
                        *(LAS u32x2*)(wl + c * 144 + (32 * ni + 8 * g + 4 * h) * 2) = w;
                    }
                }
                asm volatile("s_waitcnt lgkmcnt(0)" ::: "memory");
                bf16* dbase = (nb0 < D) ? (Q + nb0) : (Kb + (nb0 - D));
                const int dstride = (nb0 < D) ? D : kw;
#pragma unroll
                for (int p = 0; p < 4; ++p) {
                    const int q = lane + 64 * p, row = q >> 3;
                    const u32x4 o = *(LAS u32x4*)(wl + row * 144 + (q & 7) * 16);
                    *(u32x4*)(dbase + (size_t)(t0 + 32 * mi + row) * dstride + 8 * (q & 7)) = o;
                }
                asm volatile("s_waitcnt lgkmcnt(0)" ::: "memory");
            }
        } else {
#pragma unroll
            for (int ni = 0; ni < 2; ++ni)
#pragma unroll
                for (int mi = 0; mi < MI; ++mi)
#pragma unroll
                    for (int i = 0; i < 16; ++i) {
                        const int dim = 32 * ni + (i & 3) + 8 * (i >> 2) + 4 * h;
                        *(LAS unsigned short*)(wl + dim * 136 + (32 * mi + c) * 2) = (unsigned short)(pk2(acc[ni][mi][i], 0.f) & 0xffffu);
                    }
            asm volatile("s_waitcnt lgkmcnt(0)" ::: "memory");
            const int b = t0 / TPB, j0 = t0 - b * TPB;
            bf16* vbase = VT + ((size_t)b * vw + (nb0 - voff)) * TPB + j0;
#pragma unroll
            for (int p = 0; p < MI * 4; ++p) {
                const int q = lane + 64 * p, dim = q / (4 * MI), ch = q - dim * (4 * MI);
                const u32x2 lo = *(LAS u32x2*)(wl + dim * 136 + ch * 16), hi = *(LAS u32x2*)(wl + dim * 136 + ch * 16 + 8);
                u32x4 o; o.x = lo.x; o.y = lo.y; o.z = hi.x; o.w = hi.y;
                *(u32x4*)(vbase + (size_t)dim * TPB + 8 * ch) = o;
            }
            asm volatile("s_waitcnt lgkmcnt(0)" ::: "memory");
        }
    }
    static constexpr bool kLdsEpi = true;
    template <int MI> struct Pre {};
    template <int MI> DI void prefetch(Pre<MI>&, int, int, int, int) const {}
    const bf16* A; const bf16* Wt; int N, m0, n0, kind, kw, voff, vw;
    bf16* Q; bf16* Kb; bf16* VT; const float* rc; const float* rs; LAS const float* rl;
    DI int K() const { return D; }
    DI const bf16* arow(int ml) const { return A + (size_t)(m0 + ml) * D; }
    DI const bf16* brow_ptr(int nl) const { return Wt + (size_t)(n0 + nl) * D; }
    DI int brow(int wn, int ni) const { return 64 * wn + 32 * ni; }
    template <int MI> DI void epi(f32x16 (&acc)[2][MI], const Pre<MI>& pre, int wm, int wn, int c, int h) const {
#pragma unroll
        for (int ni = 0; ni < 2; ++ni)
#pragma unroll
            for (int mi = 0; mi < MI; ++mi) {
                const int nb = n0 + 64 * wn + 32 * ni;
                const int t = m0 + 32 * MI * wm + 32 * mi + c;
                const int b = t / TPB, j = t - b * TPB;
                f32x16 v = acc[ni][mi];
                if (nb < voff) {
                    if (kind != 0 && j >= CTX) {
                        const int s = j - CTX;
                        const int pos = ((nb >> 5) & 1) ? (s & 63) : (s >> 6);
#pragma unroll
                        for (int g = 0; g < 2; ++g)
#pragma unroll
                            for (int e = 0; e < 4; ++e) {
                                const int i = 4 * g + e, d = e + 8 * g + 4 * h;
                                const float cs = rc[pos * 16 + d], sn = rs[pos * 16 + d];
                                const float x1 = v[i], x2 = v[i + 8];
                                v[i] = x1 * cs - x2 * sn; v[i + 8] = x2 * cs + x1 * sn;
                            }
                    }
                    bf16* dst = (nb < D) ? (Q + (size_t)t * D + nb) : (Kb + (size_t)t * kw + (nb - D));
#pragma unroll
                    for (int g = 0; g < 4; ++g) {
                        u32x2 w; w.x = pk2(v[4 * g], v[4 * g + 1]); w.y = pk2(v[4 * g + 2], v[4 * g + 3]);
                        *(u32x2*)(dst + 8 * g + 4 * h) = w;
                    }
                } else {
                    const unsigned off0 = (unsigned)((b * vw + (nb - voff) + 4 * h) * TPB + j);
#pragma unroll
                    for (int i = 0; i < 16; ++i)
                        VT[off0 + (unsigned)(((i & 3) + 8 * (i >> 2)) * TPB)] = (bf16)(pk2(v[i], 0.f) & 0xffffu);
                }
            }
    }
};

struct OutOp {
    static constexpr bool kLdsEpi = true;
    const bf16* A; const bf16* Wt; int m0, n0; const bf16* xres; bf16* xdst; const float* modl;
    template <int MI> struct Pre { u32x4 x[MI][4]; f32x4 g0, g1; };
    DI int K() const { return D; }
    DI const bf16* arow(int ml) const { return A + (size_t)(m0 + ml) * D; }
    DI const bf16* brow_ptr(int nl) const { return Wt + (size_t)(n0 + nl) * D; }
    DI int brow(int wn, int ni) const { return 64 * wn + 32 * ni; }
    template <int MI> DI void prefetch(Pre<MI>& pre, int wm, int wn, int c, int h) const {
        const int lane = c + 32 * h, col = n0 + 64 * wn + 8 * (lane & 7);
#pragma unroll
        for (int mi = 0; mi < MI; ++mi)
#pragma unroll
            for (int p = 0; p < 4; ++p) { const int t = m0 + 32 * MI * wm + 32 * mi + ((lane + 64 * p) >> 3); pre.x[mi][p] = *(const u32x4*)(xres + (size_t)t * D + col); }
        const float* gp = modl + mod_row(m0) * 6144 + 2048 + col;
        pre.g0 = *(const f32x4*)gp; pre.g1 = *(const f32x4*)(gp + 4);
    }
    template <int MI> DI void epi(f32x16 (&)[2][MI], const Pre<MI>&, int, int, int, int) const {}
    template <int MI> DI void epi_lds(f32x16 (&acc)[2][MI], const Pre<MI>& pre, int wm, int wn, int c, int h, LAS unsigned char* wl) const {
        const int lane = c + 32 * h, col = n0 + 64 * wn + 8 * (lane & 7);
        const f32x4 g0 = pre.g0, g1 = pre.g1;
#pragma unroll
        for (int mi = 0; mi < MI; ++mi) {
#pragma unroll
            for (int ni = 0; ni < 2; ++ni)
#pragma unroll
                for (int g = 0; g < 4; ++g) {
                    f32x4 v = {acc[ni][mi][4 * g], acc[ni][mi][4 * g + 1], acc[ni][mi][4 * g + 2], acc[ni][mi][4 * g + 3]};
                    *(LAS f32x4*)(wl + c * 272 + (32 * ni + 8 * g + 4 * h) * 4) = v;
                }
            asm volatile("s_waitcnt lgkmcnt(0)" ::: "memory");
#pragma unroll
            for (int p = 0; p < 4; ++p) {
                const int q = lane + 64 * p, row = q >> 3;
                const f32x4 a0 = *(LAS f32x4*)(wl + row * 272 + (q & 7) * 32), a1 = *(LAS f32x4*)(wl + row * 272 + (q & 7) * 32 + 16);
                const u32x4 xv = pre.x[mi][p];
                u32x4 o;
                o.x = pk2(__builtin_bit_cast(float, xv.x << 16) + g0[0] * a0[0], __builtin_bit_cast(float, xv.x & 0xffff0000u) + g0[1] * a0[1]);
                o.y = pk2(__builtin_bit_cast(float, xv.y << 16) + g0[2] * a0[2], __builtin_bit_cast(float, xv.y & 0xffff0000u) + g0[3] * a0[3]);
                o.z = pk2(__builtin_bit_cast(float, xv.z << 16) + g1[0] * a1[0], __builtin_bit_cast(float, xv.z & 0xffff0000u) + g1[1] * a1[1]);
                o.w = pk2(__builtin_bit_cast(float, xv.w << 16) + g1[2] * a1[2], __builtin_bit_cast(float, xv.w & 0xffff0000u) + g1[3] * a1[3]);
                const int t = m0 + 32 * MI * wm + 32 * mi + row;
                *(u32x4*)(xdst + (size_t)t * D + col) = o;
            }
            asm volatile("s_waitcnt lgkmcnt(0)" ::: "memory");
        }
    }
};

struct GateUpOp {
    static constexpr bool kLdsEpi = true;
    template <int MI, class P> DI void epi_lds(f32x16 (&acc)[2][MI], const P&, int wm, int wn, int c, int h, LAS unsigned char* wl) const {
        const int wave = wm + 2 * wn, tid = wave * 64 + c + 32 * h;
        LAS unsigned char* st = wl - wave * 8704;
#pragma unroll
        for (int mi = 0; mi < MI; ++mi) {
            const int row = 32 * MI * wm + 32 * mi + c;
#pragma unroll
            for (int g = 0; g < 4; ++g) {
                float o[4];
#pragma unroll
                for (int e = 0; e < 4; ++e) { const float a = acc[0][mi][4 * g + e], u = acc[1][mi][4 * g + e]; o[e] = silu(a) * u; }
                u32x2 w; w.x = pk2(o[0], o[1]); w.y = pk2(o[2], o[3]);
                *(LAS u32x2*)(st + row * 144 + (32 * wn + 8 * g + 4 * h) * 2) = w;
            }
        }
        __syncthreads();
#pragma unroll
        for (int p = 0; p < MI * 2; ++p) {
            const int q = tid + 256 * p, row = q >> 3, ch = q & 7;
            const u32x4 v = *(LAS u32x4*)(st + row * 144 + ch * 16);
            if (r0 + row < cnt) *(u32x4*)(act + (size_t)(r0 + row) * DEXP + f0 + 8 * ch) = v;
        }
    }
    template <int MI> struct Pre {};
    template <int MI> DI void prefetch(Pre<MI>&, int, int, int, int) const {}
    const bf16* H; const bf16* WgT; const bf16* WuT; const int* ltok; int cnt, r0, f0; bf16* act;
    DI int K() const { return D; }
    DI const bf16* arow(int ml) const { int p = r0 + ml; p = p < cnt ? p : cnt - 1; return H + (size_t)(ltok[p] >> 1) * D; }
    DI const bf16* brow_ptr(int nl) const { return (nl < 64) ? (WgT + (size_t)(f0 + nl) * D) : (WuT + (size_t)(f0 + nl - 64) * D); }
    DI int brow(int wn, int ni) const { return 64 * ni + 32 * wn; }
    template <int MI> DI void epi(f32x16 (&acc)[2][MI], const Pre<MI>& pre, int wm, int wn, int c, int h) const {
#pragma unroll
        for (int mi = 0; mi < MI; ++mi) {
            const int p = r0 + 32 * MI * wm + 32 * mi + c;
            if (p < cnt) {
                bf16* dst = act + (size_t)p * DEXP + f0 + 32 * wn + 4 * h;
#pragma unroll
                for (int g = 0; g < 4; ++g) {
                    float o[4];
#pragma unroll
                    for (int e = 0; e < 4; ++e) { const float a = acc[0][mi][4 * g + e], u = acc[1][mi][4 * g + e]; o[e] = silu(a) * u; }
                    u32x2 w; w.x = pk2(o[0], o[1]); w.y = pk2(o[2], o[3]);
                    *(u32x2*)(dst + 8 * g) = w;
                }
            }
        }
    }
};

struct DownOp {
    static constexpr bool kLdsEpi = true;
    template <int MI> struct Pre { int tk[MI][4]; float w[MI]; };
    const bf16* act; const bf16* WdT; const int* ltok; const float* lw; int cnt, r0, n0; bf16* yp;
    DI int K() const { return DEXP; }
    DI const bf16* arow(int ml) const { int p = r0 + ml; p = p < cnt ? p : cnt - 1; return act + (size_t)p * DEXP; }
    DI const bf16* brow_ptr(int nl) const { return WdT + (size_t)(n0 + nl) * DEXP; }
    DI int brow(int wn, int ni) const { return 64 * wn + 32 * ni; }
    template <int MI> DI void prefetch(Pre<MI>& pre, int wm, int wn, int c, int h) const {
        const int lane = c + 32 * h;
#pragma unroll
        for (int mi = 0; mi < MI; ++mi) {
            const int pw = r0 + 32 * MI * wm + 32 * mi + c;
            pre.w[mi] = lw[pw < cnt ? pw : cnt - 1];
#pragma unroll
            for (int p = 0; p < 4; ++p) { const int pr = r0 + 32 * MI * wm + 32 * mi + ((lane + 64 * p) >> 3); pre.tk[mi][p] = ltok[pr < cnt ? pr : cnt - 1]; }
        }
    }
    template <int MI> DI void epi(f32x16 (&)[2][MI], const Pre<MI>&, int, int, int, int) const {}
    template <int MI> DI void epi_lds(f32x16 (&acc)[2][MI], const Pre<MI>& pre, int wm, int wn, int c, int h, LAS unsigned char* wl) const {
        const int lane = c + 32 * h;
#pragma unroll
        for (int mi = 0; mi < MI; ++mi) {
            const float w = pre.w[mi];
#pragma unroll
            for (int ni = 0; ni < 2; ++ni)
#pragma unroll
                for (int g = 0; g < 4; ++g) {
                    u32x2 o; o.x = pk2(w * acc[ni][mi][4 * g], w * acc[ni][mi][4 * g + 1]); o.y = pk2(w * acc[ni][mi][4 * g + 2], w * acc[ni][mi][4 * g + 3]);
                    *(LAS u32x2*)(wl + c * 144 + (32 * ni + 8 * g + 4 * h) * 2) = o;
                }
            asm volatile("s_waitcnt lgkmcnt(0)" ::: "memory");
#pragma unroll
            for (int p = 0; p < 4; ++p) {
                const int q = lane + 64 * p, row = q >> 3;
                const u32x4 v = *(LAS u32x4*)(wl + row * 144 + (q & 7) * 16);
                if (r0 + 32 * MI * wm + 32 * mi + row < cnt) *(u32x4*)(yp + (size_t)pre.tk[mi][p] * D + n0 + 64 * wn + 8 * (q & 7)) = v;
            }
            asm volatile("s_waitcnt lgkmcnt(0)" ::: "memory");
        }
    }
};

DI void transpose_tile(const float* W, int K, int N, bf16* Wt, int tile, LAS float* scr, int tid) {
    const int ntn = N / 64, k0 = (tile / ntn) * 64, n0 = (tile % ntn) * 64;
#pragma unroll 4
    for (int i = 0; i < 16; ++i) { const int kk = (tid >> 6) + 4 * i; scr[kk * 65 + (tid & 63)] = W[(size_t)(k0 + kk) * N + n0 + (tid & 63)]; }
    __syncthreads();
#pragma unroll
    for (int i = 0; i < 2; ++i) {
        const int q = tid + 256 * i, n = q >> 3, kc = q & 7;
        const LAS float* s = scr + (8 * kc) * 65 + n;
        u32x4 o; o.x = pk2(s[0], s[65]); o.y = pk2(s[2 * 65], s[3 * 65]); o.z = pk2(s[4 * 65], s[5 * 65]); o.w = pk2(s[6 * 65], s[7 * 65]);
        *(u32x4*)(Wt + (size_t)(n0 + n) * K + k0 + 8 * kc) = o;
    }
    __syncthreads();
}

DI f32x16 qk_tile(const bf16x8 (&qf)[4], const bf16* kp) {
    f32x16 s;
#pragma unroll
    for (int i = 0; i < 16; ++i) s[i] = 0.f;
    bf16x8 kf[4];
#pragma unroll
    for (int s4 = 0; s4 < 4; ++s4) kf[s4] = ldg8(kp + 16 * s4);
#pragma unroll
    for (int s4 = 0; s4 < 4; ++s4) s = MFMA(kf[s4], qf[s4], s);
    return s;
}
constexpr float RS_THR = 6.0f;
template <bool RAW>
DI bool softmax_tile(f32x16& s, float& m, float& l, float& alpha, bf16x8 (&pf)[2]) {
    float mx = s[0];
#pragma unroll
    for (int i = 1; i < 16; ++i) mx = fmaxf(mx, s[i]);
    mx = fmaxf(mx, __shfl_xor(mx, 32));
    if (RAW) mx *= SM_C;
    const bool resc = !__all(mx <= m + RS_THR);
    alpha = 1.f;
    if (resc) { const float mn = fmaxf(m, mx); alpha = fexp2(m - mn); m = mn; }
    float ps = 0.f;
#pragma unroll
    for (int i = 0; i < 16; ++i) { s[i] = RAW ? fexp2(__builtin_fmaf(s[i], SM_C, -m)) : fexp2(s[i] - m); ps += s[i]; }
    l = l * alpha + ps;
#pragma unroll
    for (int k2 = 0; k2 < 2; ++k2) {
        u32x4 w; w.x = pk2(s[8 * k2], s[8 * k2 + 1]); w.y = pk2(s[8 * k2 + 2], s[8 * k2 + 3]); w.z = pk2(s[8 * k2 + 4], s[8 * k2 + 5]); w.w = pk2(s[8 * k2 + 6], s[8 * k2 + 7]);
        pf[k2] = __builtin_bit_cast(bf16x8, w);
    }
    return resc;
}
template <int NDB>
DI void pv_tile(f32x16 (&O)[NDB], const bf16x8 (&pf)[2], const bf16* vp, float alpha) {
    bf16x8 vf[NDB][2];
#pragma unroll
    for (int db = 0; db < NDB; ++db)
#pragma unroll
        for (int k2 = 0; k2 < 2; ++k2) vf[db][k2] = ldg8(vp + (size_t)db * 32 * TPB + 16 * k2);
#pragma unroll
    for (int db = 0; db < NDB; ++db) {
#pragma unroll
        for (int i = 0; i < 16; ++i) O[db][i] *= alpha;
#pragma unroll
        for (int k2 = 0; k2 < 2; ++k2) O[db] = MFMA(vf[db][k2], pf[k2], O[db]);
    }
}
template <int NDB>
DI void store_o(const f32x16 (&O)[NDB], float inv, bf16* orow, int h) {
#pragma unroll
    for (int db = 0; db < NDB; ++db)
#pragma unroll
        for (int g = 0; g < 4; ++g) {
            u32x2 w; w.x = pk2(O[db][4 * g] * inv, O[db][4 * g + 1] * inv); w.y = pk2(O[db][4 * g + 2] * inv, O[db][4 * g + 3] * inv);
            *(u32x2*)(orow + 32 * db + 8 * g + 4 * h) = w;
        }
}

DI unsigned swz128(int row, int ch) { return (unsigned)(row * 128 + ((ch ^ ((row >> 1) & 7)) << 4)); }

template <bool RAW>
DI bool softmax_tile2(f32x16& sa, f32x16& sb, float& m, float& l, float& alpha, bf16x8 (&pf)[4]) {
    float mx = fmaxf(sa[0], sb[0]);
#pragma unroll
    for (int i = 1; i < 16; ++i) mx = fmaxf(mx, fmaxf(sa[i], sb[i]));
    mx = fmaxf(mx, __shfl_xor(mx, 32));
    if (RAW) mx *= SM_C;
    const bool resc = !__all(mx <= m + RS_THR);
    alpha = 1.f;
    if (resc) { const float mn = fmaxf(m, mx); alpha = fexp2(m - mn); m = mn; }
    float ps = 0.f;
#pragma unroll
    for (int i = 0; i < 16; ++i) {
        sa[i] = RAW ? fexp2(__builtin_fmaf(sa[i], SM_C, -m)) : fexp2(sa[i] - m);
        sb[i] = RAW ? fexp2(__builtin_fmaf(sb[i], SM_C, -m)) : fexp2(sb[i] - m);
        ps += sa[i] + sb[i];
    }
    l = l * alpha + ps;
#pragma unroll
    for (int k2 = 0; k2 < 2; ++k2) {
        u32x4 w; w.x = pk2(sa[8 * k2], sa[8 * k2 + 1]); w.y = pk2(sa[8 * k2 + 2], sa[8 * k2 + 3]); w.z = pk2(sa[8 * k2 + 4], sa[8 * k2 + 5]); w.w = pk2(sa[8 * k2 + 6], sa[8 * k2 + 7]);
        pf[k2] = __builtin_bit_cast(bf16x8, w);
        u32x4 v; v.x = pk2(sb[8 * k2], sb[8 * k2 + 1]); v.y = pk2(sb[8 * k2 + 2], sb[8 * k2 + 3]); v.z = pk2(sb[8 * k2 + 4], sb[8 * k2 + 5]); v.w = pk2(sb[8 * k2 + 6], sb[8 * k2 + 7]);
        pf[2 + k2] = __builtin_bit_cast(bf16x8, v);
    }
    return resc;
}

DI void attn_block_nasw(const Ctx& cx, int kind, int layer, bool need_ctx, int vbid) {
    const int tid = cx.tid, lane = cx.lane, w = cx.wave, c = lane & 31, h = lane >> 5;
    const int kw = (kind == 0) ? D : 256, vw = kw;
    const int n_lat = 2048, n_tasks = n_lat + (need_ctx ? 256 : 0);
    const float* rpb = cx.rpbp() + (size_t)(layer / 3) * 16 * 512;
    const float* sinks = cx.in(17);
    const int srow = tid >> 3, sch = (tid & 7) ^ ((srow >> 1) & 7);
    const int pr = pi32(c);
    const unsigned xk = (pr >> 1) & 7, xv = (c >> 1) & 7;
    LAS float* rpbs = (LAS float*)(cx.lds + 49152);
    LAS unsigned char* qreg = cx.lds + 51200 + w * 4096 + lane * 16;
    for (int base_ = 0; base_ < n_tasks; base_ += gridDim.x) {
        const int rem_ = n_tasks - base_;
        const int task = base_ + ((base_ + (int)gridDim.x <= n_tasks) ? vbid : (((rem_ & 7) || (int)blockIdx.x >= rem_) ? (int)blockIdx.x : (int)((blockIdx.x & 7) * (rem_ >> 3) + (blockIdx.x >> 3))));
        if (task >= n_tasks) break;
        int b, kmap, head, tq0, nt, rlo = 0, r0w = 0, rg = 0, qh = 0, p0 = 0, kb_lo = 0;
        const bool lat = task < n_lat;
        if (kind == 0) {
            if (lat) {
                const int rp = task & 15; head = (task >> 4) & 15; b = task >> 8; rg = 2 * rp + (c >> 4); qh = 0;
                tq0 = b * TPB + CTX + rg * 64 + 16 * w + (c & 15) - c;
                int a0 = 2 * rp - 4; a0 = a0 < 0 ? 0 : (a0 > 24 ? 24 : a0);
                int a1 = 2 * rp - 3; a1 = a1 < 0 ? 0 : (a1 > 24 ? 24 : a1);
                rlo = a0; nt = 4 + (a1 + 8 - a0); r0w = (c >> 4) ? a1 : a0;
            } else { const int u = task - n_lat; const int qb = u & 1; head = (u >> 1) & 15; b = u >> 5; tq0 = b * TPB + qb * 128 + w * 32; nt = 4; }
            kmap = head;
        } else {
            if (lat) {
                const int qb = task & 63; kmap = (task >> 6) & 3; b = task >> 8; p0 = qb * 32; tq0 = b * TPB + CTX + p0;
                int lo = p0 - 128; lo = lo < 0 ? 0 : lo; kb_lo = lo & ~63;
                int hi = p0 + 160; hi = hi > SEQ ? SEQ : hi; hi = (hi + 63) & ~63; nt = 4 + (hi - kb_lo) / 64;
            } else { const int u = task - n_lat; const int qb = u & 7; kmap = (u >> 3) & 3; b = u >> 5; tq0 = b * TPB + qb * 32; nt = 4; }
            head = kmap * 4 + w;
        }
#define KEY0(it) ((it) < 4 ? 64 * (it) : (kind == 0 ? CTX + (rlo + (it) - 4) * 64 : CTX + kb_lo + ((it) - 4) * 64))
        const bf16* kg = cx.K() + (size_t)(b * TPB + srow) * kw + kmap * 64 + sch * 8;
        const bf16* vg = cx.VT() + ((size_t)b * vw + kmap * 64 + srow) * TPB + sch * 8;
#define A_LOAD(it, buf) do { const int k0_ = KEY0(it); LAS unsigned char* b_ = cx.lds + (buf) * 16384 + tid * 16; \
                        glds16(kg + (size_t)k0_ * kw, b_); glds16(kg + (size_t)(k0_ + 32) * kw, b_ + 4096); \
                        glds16(vg + k0_, b_ + 8192); glds16(vg + (size_t)32 * TPB + k0_, b_ + 8192 + 4096); } while (0)
        __syncthreads();
        float m = NEG, l = 0.f;
        if (kind == 2) { m = sinks[head] * LOG2E; l = (h == 0) ? 1.f : 0.f; }
        { const bf16* qp = cx.Q() + (size_t)(tq0 + c) * D + head * 64 + 8 * h;
#pragma unroll
          for (int s4 = 0; s4 < 4; ++s4) glds16(qp + 16 * s4, qreg + s4 * 1024); }
        if (kind == 0 && lat && tid < 128) glds16(rpb + head * 512 + tid * 4, (LAS unsigned char*)rpbs + tid * 16);
#pragma unroll
        for (int s = 0; s < 2; ++s) if (s < nt) A_LOAD(s, s);
        asm volatile("" : "+v"(m));
        f32x16 O[2];
#pragma unroll
        for (int db = 0; db < 2; ++db)
#pragma unroll
            for (int i = 0; i < 16; ++i) O[db][i] = 0.f;
        const int qc = 16 * w + (c & 15); int c0 = qc - 8; c0 = c0 < 0 ? 0 : (c0 > 48 ? 48 : c0);
        int kbase = 16 * w - 8; kbase = kbase < 0 ? 0 : (kbase > 32 ? 32 : kbase);
        const unsigned xkn = ((kbase + pr) >> 1) & 7;
        const int qpos = p0 + c;
        bf16x8 qf[4];
        int stg = 0, istg = 2;
#pragma unroll 1
        for (int it = 0; it < nt; ++it) {
            if (it + 1 < nt) asm volatile("s_waitcnt vmcnt(4)" ::: "memory");
            else asm volatile("s_waitcnt vmcnt(0)" ::: "memory");
            __builtin_amdgcn_s_barrier();
            asm volatile("" ::: "memory");
            if (it + 2 < nt) A_LOAD(it + 2, istg);
            __builtin_amdgcn_sched_barrier(0);
            if (it == 0) {
#pragma unroll
                for (int s4 = 0; s4 < 4; ++s4) qf[s4] = *(LAS bf16x8*)(qreg + s4 * 1024);
            }
            LAS unsigned char* kb = cx.lds + stg * 16384; LAS unsigned char* vb = kb + 8192;
            if (kind == 0 && it >= 4) {
                const int ry = rlo + it - 4;
                f32x16 sa;
#pragma unroll
                for (int i = 0; i < 16; ++i) sa[i] = 0.f;
#pragma unroll
                for (int s4 = 0; s4 < 4; ++s4) {
                    const bf16x8 ka = *(LAS bf16x8*)(kb + (kbase + pr) * 128 + (((2 * s4 + h) ^ xkn) << 4));
                    sa = MFMA(ka, qf[s4], sa);
                }
                const bool rowok = (ry >= r0w) && (ry <= r0w + 7);
                int dyi = ry - rg + 7; dyi = dyi < 0 ? 0 : (dyi > 14 ? 14 : dyi);
                const LAS float* rrow = rpbs + dyi * 31;
                int dwin = rowok ? (kbase + 8 * h - c0) : 0x40000000;
                int dci = kbase + 8 * h - qc + 15;
                asm volatile("" : "+v"(dwin), "+v"(dci));
                float bias[16];
#pragma unroll
                for (int i = 0; i < 16; ++i) {
                    const int off = (i & 7) + 16 * (i >> 3);
                    int ci = dci + off; ci = ci < 0 ? 0 : (ci > 30 ? 30 : ci);
                    bias[i] = rrow[ci];
                }
#pragma unroll
                for (int i = 0; i < 16; ++i) asm volatile("" : "+v"(bias[i]));
#pragma unroll
                for (int i = 0; i < 16; ++i) {
                    const int off = (i & 7) + 16 * (i >> 3);
                    const bool ok = (unsigned)(dwin + off) < 16u;
                    const float sv = __builtin_fmaf(sa[i], SM_C, bias[i]);
                    sa[i] = ok ? sv : NEG;
                }
                float alpha; bf16x8 pf[2];
                const bool resc = softmax_tile<false>(sa, m, l, alpha, pf);
                if (resc) {
#pragma unroll
                    for (int db = 0; db < 2; ++db)
#pragma unroll
                        for (int i = 0; i < 16; ++i) O[db][i] *= alpha;
                }
                const int kb8 = kbase >> 3;
#pragma unroll
                for (int db = 0; db < 2; ++db)
#pragma unroll
                    for (int k2 = 0; k2 < 2; ++k2) {
                        const bf16x8 vf = *(LAS bf16x8*)(vb + (32 * db + c) * 128 + (((kb8 + 2 * k2 + h) ^ xv) << 4));
                        O[db] = MFMA(vf, pf[k2], O[db]);
                    }
            } else {
                f32x16 sa, sb;
#pragma unroll
                for (int i = 0; i < 16; ++i) { sa[i] = 0.f; sb[i] = 0.f; }
#pragma unroll
                for (int s4 = 0; s4 < 4; ++s4) {
                    const unsigned co = (unsigned)(((2 * s4 + h) ^ xk) << 4);
                    const bf16x8 ka = *(LAS bf16x8*)(kb + pr * 128 + co), kb2 = *(LAS bf16x8*)(kb + (32 + pr) * 128 + co);
                    sa = MFMA(ka, qf[s4], sa); sb = MFMA(kb2, qf[s4], sb);
                }
                bool resc; float alpha; bf16x8 pf[4];
                if (it < 4) {
                    resc = softmax_tile2<true>(sa, sb, m, l, alpha, pf);
                } else {
                    const int kb0 = kb_lo + (it - 4) * 64;
                    if (kb0 < p0 - 97 || kb0 > p0 + 65) {
                        int dq = kb0 + 8 * h - qpos + 128; asm volatile("" : "+v"(dq));
#pragma unroll
                        for (int i = 0; i < 16; ++i) {
                            const int off = (i & 7) + 16 * (i >> 3);
                            sa[i] = ((unsigned)(dq + off) <= 256u) ? sa[i] : NEG;
                            sb[i] = ((unsigned)(dq + off + 32) <= 256u) ? sb[i] : NEG;
                        }
                    }
                    resc = softmax_tile2<true>(sa, sb, m, l, alpha, pf);
                }
                if (resc) {
#pragma unroll
                    for (int db = 0; db < 2; ++db)
#pragma unroll
                        for (int i = 0; i < 16; ++i) O[db][i] *= alpha;
                }
#pragma unroll
                for (int db = 0; db < 2; ++db) {
#pragma unroll
                    for (int k4 = 0; k4 < 4; ++k4) {
                        const bf16x8 vf = *(LAS bf16x8*)(vb + (32 * db + c) * 128 + (((2 * k4 + h) ^ xv) << 4));
                        O[db] = MFMA(vf, pf[k4], O[db]);
                    }
                }
            }
            asm volatile("" ::: "memory");
            stg = (stg == 2) ? 0 : stg + 1; istg = (istg == 2) ? 0 : istg + 1;
        }
#undef KEY0
#undef A_LOAD
        l += __shfl_xor(l, 32);
        store_o<2>(O, 1.f / l, cx.O() + (size_t)(tq0 + c) * D + head * 64, h);
    }
}

DI void attn_block_da(const Ctx& cx, int layer, bool need_ctx, int vbid) {
    const int tid = cx.tid, lane = cx.lane, w = cx.wave, c = lane & 31, h = lane >> 5;
    const int n_lat = NB * 8 * 16, n_tasks = n_lat + (need_ctx ? NB * 8 * 2 : 0);
    const float* lp = cx.in(13);
    const float d1 = wave_sum(lp[lane] * lp[64 + lane]), d2 = wave_sum(lp[128 + lane] * lp[192 + lane]);
    const float lam_init = 0.8f - 0.6f * __expf(-0.3f * (float)layer);
    const float lam = __expf(d1) - __expf(d2) + lam_init;
    const float* sg = cx.in(14);
    const int krow = tid >> 3, kch = (tid & 7) ^ ((krow >> 1) & 7), vdim = tid >> 2, vch = (tid & 3) ^ ((vdim >> 2) & 3);
    const int pr = pi32(c);
    const unsigned xk = (pr >> 1) & 7, xv = (c >> 2) & 3;
    LAS unsigned char* qlds = cx.lds + 49152 + w * 4096 + lane * 16;
    for (int base_ = 0; base_ < n_tasks; base_ += gridDim.x) {
        const int rem_ = n_tasks - base_;
        const int task = base_ + ((base_ + (int)gridDim.x <= n_tasks) ? vbid : (((rem_ & 7) || (int)blockIdx.x >= rem_) ? (int)blockIdx.x : (int)((blockIdx.x & 7) * (rem_ >> 3) + (blockIdx.x >> 3))));
        if (task >= n_tasks) break;
        int b, head, tq0, nt;
        if (task < n_lat) { const int qb = task & 15; head = (task >> 4) & 7; b = task >> 7; tq0 = b * TPB + CTX + qb * 128 + w * 32; nt = TPB / 32; }
        else { const int u = task - n_lat; const int qb = u & 1; head = (u >> 1) & 7; b = u >> 4; tq0 = b * TPB + qb * 128 + w * 32; nt = CTX / 32; }
        const bf16* kg = cx.K() + (size_t)(b * TPB + krow) * D + head * 128 + kch * 8;
        const bf16* vg = cx.VT() + ((size_t)b * D + head * 128 + vdim) * TPB + vch * 8;
#define D_LOAD(it, buf) do { const int k0_ = 32 * (it); LAS unsigned char* b_ = cx.lds + (buf) * 16384 + tid * 16; \
                        glds16(kg + (size_t)k0_ * D, b_); glds16(kg + (size_t)k0_ * D + 64, b_ + 4096); \
                        glds16(vg + k0_, b_ + 8192); glds16(vg + (size_t)64 * TPB + k0_, b_ + 8192 + 4096); } while (0)
        __syncthreads();
        bf16x8 q1f[4];
        { const bf16* qp = cx.Q() + (size_t)(tq0 + c) * D + head * 128 + 8 * h;
#pragma unroll
          for (int s4 = 0; s4 < 4; ++s4) q1f[s4] = ldg8(qp + 64 + 16 * s4);
#pragma unroll
          for (int s4 = 0; s4 < 4; ++s4) glds16(qp + 16 * s4, qlds + s4 * 1024); }
#pragma unroll
        for (int s = 0; s < 2; ++s) if (s < nt) D_LOAD(s, s);
#pragma unroll
        for (int s4 = 0; s4 < 4; ++s4) asm volatile("" : "+v"(q1f[s4]));
        float m0 = NEG, l0 = 0.f, m1 = NEG, l1 = 0.f;
        f32x16 O0[4], O1[4];
#pragma unroll
        for (int db = 0; db < 4; ++db)
#pragma unroll
            for (int i = 0; i < 16; ++i) { O0[db][i] = 0.f; O1[db][i] = 0.f; }
        int stg = 0, istg = 2;
#pragma unroll 1
        for (int it = 0; it < nt; ++it) {
            if (it + 1 < nt) asm volatile("s_waitcnt vmcnt(4)" ::: "memory");
            else asm volatile("s_waitcnt vmcnt(0)" ::: "memory");
            __builtin_amdgcn_s_barrier();
            asm volatile("" ::: "memory");
            if (it + 2 < nt) D_LOAD(it + 2, istg);
            __builtin_amdgcn_sched_barrier(0);
            __builtin_amdgcn_iglp_opt(IGLP_ATT);
            LAS unsigned char* kb = cx.lds + stg * 16384; LAS unsigned char* vb = kb + 8192;
            f32x16 s0, s1;
#pragma unroll
            for (int i = 0; i < 16; ++i) { s0[i] = 0.f; s1[i] = 0.f; }
#pragma unroll
            for (int s4 = 0; s4 < 4; ++s4) {
                const unsigned co = (unsigned)(((2 * s4 + h) ^ xk) << 4);
                const bf16x8 k0f = *(LAS bf16x8*)(kb + pr * 128 + co), q0f = *(LAS bf16x8*)(qlds + s4 * 1024);
                s0 = MFMA(k0f, q0f, s0);
            }
#pragma unroll
            for (int s4 = 0; s4 < 4; ++s4) {
                const unsigned co = (unsigned)(((2 * s4 + h) ^ xk) << 4);
                const bf16x8 k1f = *(LAS bf16x8*)(kb + 4096 + pr * 128 + co);
                s1 = MFMA(k1f, q1f[s4], s1);
            }
            __builtin_amdgcn_sched_barrier(0);
            float a0; bf16x8 pf0[2];
            const bool r0 = softmax_tile<true>(s0, m0, l0, a0, pf0);
            float a1; bf16x8 pf1[2];
            const bool r1 = softmax_tile<true>(s1, m1, l1, a1, pf1);
            if (r0 || r1) {
#pragma unroll
                for (int db = 0; db < 4; ++db)
#pragma unroll
                    for (int i = 0; i < 16; ++i) { O0[db][i] *= a0; O1[db][i] *= a1; }
            }
            __builtin_amdgcn_s_setprio(1);
#pragma unroll
            for (int db = 0; db < 4; ++db) {
                bf16x8 vf[2];
#pragma unroll
                for (int k2 = 0; k2 < 2; ++k2) vf[k2] = *(LAS bf16x8*)(vb + (32 * db + c) * 64 + (((2 * k2 + h) ^ xv) << 4));
#pragma unroll
                for (int k2 = 0; k2 < 2; ++k2) { O0[db] = MFMA(vf[k2], pf0[k2], O0[db]); O1[db] = MFMA(vf[k2], pf1[k2], O1[db]); }
            }
            __builtin_amdgcn_s_setprio(0);
            asm volatile("" ::: "memory");
            stg = (stg == 2) ? 0 : stg + 1; istg = (istg == 2) ? 0 : istg + 1;
        }
#undef D_LOAD
        l0 += __shfl_xor(l0, 32); l1 += __shfl_xor(l1, 32);
        const int lane_e = __builtin_amdgcn_mbcnt_hi(~0u, __builtin_amdgcn_mbcnt_lo(~0u, 0u));
        const int c_e = lane_e & 31, h_e = lane_e >> 5;
        const float i0 = 1.f / l0, i1 = lam / l1;
        float ss = 0.f;
#pragma unroll
        for (int db = 0; db < 4; ++db)
#pragma unroll
            for (int i = 0; i < 16; ++i) { const float o = O0[db][i] * i0 - O1[db][i] * i1; O0[db][i] = o; ss += o * o; }
        ss += __shfl_xor(ss, 32);
        const float rn = rsqrtf(ss * (1.f / 128.f) + EPS) * (1.f - lam_init);
        bf16* orow = cx.O() + (size_t)(tq0 + c_e) * D + head * 128;
#pragma unroll
        for (int db = 0; db < 4; ++db)
#pragma unroll
            for (int g = 0; g < 4; ++g) {
                const int dim = 32 * db + 8 * g + 4 * h_e;
                const f32x4 gg = *(const f32x4*)(sg + dim);
                u32x2 wv; wv.x = pk2(O0[db][4 * g] * rn * gg[0], O0[db][4 * g + 1] * rn * gg[1]); wv.y = pk2(O0[db][4 * g + 2] * rn * gg[2], O0[db][4 * g + 3] * rn * gg[3]);
                *(u32x2*)(orow + dim) = wv;
            }
    }
}

DI void load_row(const float* row, f32x4 (&v)[4], int lane) {
#pragma unroll
    for (int j = 0; j < 4; ++j) v[j] = ((const f32x4*)row)[lane + 64 * j];
}
DI void load_row_bf16(const bf16* row, f32x4 (&v)[4], int lane) {
#pragma unroll
    for (int j = 0; j < 4; ++j) { const u32x2 a = ((const u32x2*)row)[lane + 64 * j];
        v[j][0] = __builtin_bit_cast(float, a.x << 16); v[j][1] = __builtin_bit_cast(float, a.x & 0xffff0000u);
        v[j][2] = __builtin_bit_cast(float, a.y << 16); v[j][3] = __builtin_bit_cast(float, a.y & 0xffff0000u); }
}
DI void norm_mod(f32x4 (&v)[4], const float* g, const float* sh, const float* sc, int lane) {
    float ss = 0.f;
#pragma unroll
    for (int j = 0; j < 4; ++j) ss += (v[j][0] * v[j][0] + v[j][1] * v[j][1]) + (v[j][2] * v[j][2] + v[j][3] * v[j][3]);
    const float rn = rsqrtf(wave_sum(ss) * (1.f / D) + EPS);
#pragma unroll
    for (int j = 0; j < 4; ++j) {
        const f32x4 gg = ((const f32x4*)g)[lane + 64 * j], s1 = ((const f32x4*)sc)[lane + 64 * j], s0 = ((const f32x4*)sh)[lane + 64 * j];
#pragma unroll
        for (int e = 0; e < 4; ++e) v[j][e] = (v[j][e] * rn * gg[e]) * (1.f + s1[e]) + s0[e];
    }
}
DI void norm_mod_pre(f32x4 (&v)[4], const f32x4 (&gv)[4], const f32x4 (&s0v)[4], const f32x4 (&s1v)[4]) {
    float ss = 0.f;
#pragma unroll
    for (int j = 0; j < 4; ++j) ss += (v[j][0] * v[j][0] + v[j][1] * v[j][1]) + (v[j][2] * v[j][2] + v[j][3] * v[j][3]);
    const float rn = rsqrtf(wave_sum(ss) * (1.f / D) + EPS);
#pragma unroll
    for (int j = 0; j < 4; ++j)
#pragma unroll
        for (int e = 0; e < 4; ++e) v[j][e] = (v[j][e] * rn * gv[j][e]) * (1.f + s1v[j][e]) + s0v[j][e];
}
DI void store_row_bf16(bf16* row, const f32x4 (&v)[4], int lane) {
#pragma unroll
    for (int j = 0; j < 4; ++j) { u32x2 w; w.x = pk2(v[j][0], v[j][1]); w.y = pk2(v[j][2], v[j][3]); ((u32x2*)row)[lane + 64 * j] = w; }
}

struct ConvTask { const float* src; bf16* dst; int N, K; };
DI ConvTask prologue_task(const Ctx& cx, int item, int lane) {
    const int layer = item < 2048 ? 0 : (item < 4096 ? 1 : (item < 5376 ? 2 : 3));
    const int u = item - (layer == 0 ? 0 : (layer == 1 ? 2048 : (layer == 2 ? 4096 : 5376)));
    const int kind = layer % 3, NQ = (kind == 2) ? 1536 : 3072, nq = 16 * (NQ / 32);
    const float* W; bf16* WT; int N, kt, nt;
    if (u < nq) { W = (kind == 0) ? cx.in(9) + (size_t)(layer / 3) * D * 3072 : (kind == 1 ? cx.in(12) : cx.in(16)); WT = cx.wqkv(layer); N = NQ; kt = u / (NQ / 32); nt = u - kt * (NQ / 32); }
    else { const int v = u - nq; W = (kind == 0) ? cx.in(11) + (size_t)(layer / 3) * D * D : (kind == 1 ? cx.in(15) : cx.in(18)); WT = cx.wo(layer); N = D; kt = v >> 5; nt = v & 31; }
    ConvTask t;
    t.src = W + (size_t)(kt * 64 + (lane >> 3)) * N + nt * 32 + (lane & 7) * 4;
    t.dst = WT + (size_t)(nt * 32 + (lane >> 3)) * D + kt * 64 + (lane & 7) * 8;
    t.N = N; t.K = D;
    return t;
}
constexpr int PRO_NT = 7424;
DI void prologue_convert(const Ctx& cx, int first, int stride) {
    const int lane = cx.lane;
    LAS float* scr = (LAS float*)(cx.lds + 36864) + cx.wave * (64 * 33);
#define PV_LOAD(X, task) do { const ConvTask ct_ = prologue_task(cx, (task), lane); \
        _Pragma("unroll") for (int p = 0; p < 8; ++p) X[p] = *(const f32x4*)(ct_.src + (size_t)(8 * p) * ct_.N); } while (0)
#define PV_PROC(X, task) do { const ConvTask ct_ = prologue_task(cx, (task), lane); \
        _Pragma("unroll") for (int p = 0; p < 8; ++p) { LAS float* d = scr + ((lane >> 3) + 8 * p) * 33 + (lane & 7) * 4; d[0] = X[p][0]; d[1] = X[p][1]; d[2] = X[p][2]; d[3] = X[p][3]; } \
        asm volatile("s_waitcnt lgkmcnt(0)" ::: "memory"); \
        _Pragma("unroll") for (int p = 0; p < 4; ++p) { const LAS float* s = scr + ((lane & 7) * 8) * 33 + (lane >> 3) + 8 * p; \
            u32x4 o; o.x = pk2(s[0], s[33]); o.y = pk2(s[2 * 33], s[3 * 33]); o.z = pk2(s[4 * 33], s[5 * 33]); o.w = pk2(s[6 * 33], s[7 * 33]); \
            *(u32x4*)(ct_.dst + (size_t)(8 * p) * ct_.K) = o; } \
        asm volatile("s_waitcnt lgkmcnt(0)" ::: "memory"); } while (0)
    f32x4 xa[8], xb[8];
    int task = first;
    if (task < PRO_NT) PV_LOAD(xa, task);
#pragma unroll 1
    while (task < PRO_NT) {
        const int t2 = task + stride, t3 = t2 + stride;
        if (t2 < PRO_NT) PV_LOAD(xb, t2);
        PV_PROC(xa, task);
        if (t3 < PRO_NT) PV_LOAD(xa, t3);
        if (t2 < PRO_NT) PV_PROC(xb, t2);
        task = t3;
    }
#undef PV_LOAD
#undef PV_PROC
}

DI void phase_prologue(const Ctx& cx) {
    LAS float* condS = (LAS float*)cx.lds;
    const float* cin = cx.in(1); const float* cctx = cx.in(3);
    for (int i = cx.tid; i < 9 * 1024; i += NTHREADS) { const int rr = i >> 10, k = i & 1023; const float v = (rr < 8) ? cin[rr * 1024 + k] : cctx[k]; condS[i] = silu(v); }
    __syncthreads();
    const float* ada_w = cx.in(4); const float* ada_b = cx.in(5);
    LAS float* red16 = (LAS float*)(cx.lds + 9 * 1024 * 4);
    for (int task = blockIdx.x; task < 4 * 96; task += gridDim.x) {
        const int layer = task / 96, cc = task % 96, r = cx.lane >> 4, cq = cx.lane & 15;
        const float* W = ada_w + (size_t)layer * D * 6144 + cc * 64 + 4 * cq;
        float acc[9][4];
#pragma unroll
        for (int rr = 0; rr < 9; ++rr)
#pragma unroll
            for (int e = 0; e < 4; ++e) acc[rr][e] = 0.f;
        const int k0 = cx.wave * 256 + r;
#pragma unroll 1
        for (int kb = 0; kb < 256; kb += 64) {
            f32x4 wv[16];
#pragma unroll
            for (int i = 0; i < 16; ++i) wv[i] = *(const f32x4*)(W + (size_t)(k0 + kb + 4 * i) * 6144);
#pragma unroll
            for (int i = 0; i < 16; ++i) {
#pragma unroll
                for (int rr = 0; rr < 9; ++rr) { const float cv = condS[rr * 1024 + k0 + kb + 4 * i];
#pragma unroll
                    for (int e = 0; e < 4; ++e) acc[rr][e] += cv * wv[i][e]; }
            }
        }
#pragma unroll
        for (int rr = 0; rr < 9; ++rr) *(LAS f32x4*)(red16 + ((cx.wave * 4 + r) * 9 + rr) * 64 + 4 * cq) = f32x4{acc[rr][0], acc[rr][1], acc[rr][2], acc[rr][3]};
        __syncthreads();
        for (int i = cx.tid; i < 9 * 64; i += NTHREADS) {
            const int rr = i >> 6, ln = i & 63;
            float s = 0.f;
#pragma unroll
            for (int g = 0; g < 16; ++g) s += red16[(g * 9 + rr) * 64 + ln];
            cx.mod()[((size_t)layer * 9 + rr) * 6144 + cc * 64 + ln] = s + ada_b[layer * 6144 + cc * 64 + ln];
        }
        __syncthreads();
    }
    {
        const int ng = (4 * 96 < (int)gridDim.x) ? 4 * 96 : (int)gridDim.x;
        const int nslots = ng * 4 + ((int)gridDim.x - ng) * 4 * 3;
        const int gw = blockIdx.x * 4 + cx.wave;
        if ((int)blockIdx.x < ng) prologue_convert(cx, gw, nslots);
        else { const int s0 = ng * 4 + (gw - ng * 4) * 3; prologue_convert(cx, s0, nslots); prologue_convert(cx, s0 + 1, nslots); prologue_convert(cx, s0 + 2, nslots); }
    }
    {
        bf16* wr = cx.wr();
        for (int i = blockIdx.x * NTHREADS + cx.tid; i < DEPTH * D * 64; i += gridDim.x * NTHREADS) {
            const int rho = i & 63, k = (i >> 6) & 1023, layer = i >> 16;
            float v = 0.f;
            if (rho < 32) v = cx.in(21)[((size_t)layer * D + k) * 32 + rho];
            else if (rho < 36) v = cx.in(19)[((size_t)layer * D + k) * 4 + (rho - 32)];
            const unsigned hi = pk2(v, 0.f) & 0xffffu;
            const unsigned lo = pk2(v - bf2f((unsigned short)hi), 0.f) & 0xffffu;
            wr[((size_t)(layer * 2 + 0) * 64 + rho) * D + k] = (bf16)hi;
            wr[((size_t)(layer * 2 + 1) * 64 + rho) * D + k] = (bf16)lo;
        }
    }
    for (int i = blockIdx.x * NTHREADS + cx.tid; i < 2 * 16 * 512; i += gridDim.x * NTHREADS) { const int s = i >> 9, e = i & 511; cx.rpbp()[i] = (e < 465) ? cx.in(10)[s * 465 + e] * LOG2E : 0.f; }
    {
        for (int i = blockIdx.x * NTHREADS + cx.tid; i < 64 * 16; i += gridDim.x * NTHREADS) {
            const int pos = i >> 4, f = i & 15;
            const float tab4[4] = {1.f, 0.5623413251903491f, 0.31622776601683794f, 0.1778279410038923f};
            float inv = (f & 3) == 0 ? tab4[0] : ((f & 3) == 1 ? tab4[1] : ((f & 3) == 2 ? tab4[2] : tab4[3]));
            const int dec = f >> 2; inv *= (dec == 0 ? 1.f : (dec == 1 ? 0.1f : (dec == 2 ? 0.01f : 0.001f)));
            const float ang = (float)pos * inv;
            const double rev = (double)ang * 0.15915494309189535; const float fr = (float)(rev - (double)(long long)rev);
            cx.ropec()[i] = __builtin_amdgcn_cosf(fr); cx.ropes()[i] = __builtin_amdgcn_sinf(fr);
        }
    }
}

DI void phase_first_norm(const Ctx& cx) {
    const int gw = blockIdx.x * 4 + cx.wave, gstride = gridDim.x * 4;
    {
        for (int pair = (int)gridDim.x - 1 - (int)blockIdx.x; pair < DEPTH * 9; pair += (int)gridDim.x) {
            const int layer = pair / 9, row = pair % 9;
            const float* md = cx.mod() + ((size_t)layer * 9 + row) * 6144;
            const float* g = cx.in(7) + layer * D;
            float* gmo = cx.gm() + (size_t)pair * D;
            const float* wexp = cx.in(21) + (size_t)layer * D * 32; const float* wgrp = cx.in(19) + (size_t)layer * D * 4;
            float acc[36];
#pragma unroll
            for (int e = 0; e < 36; ++e) acc[e] = 0.f;
#pragma unroll
            for (int i = 0; i < 4; ++i) {
                const int k = cx.lane + 64 * (4 * cx.wave + i);
                gmo[k] = g[k] * (1.f + md[4096 + k]);
                const float sh = md[3072 + k];
                const f32x4* we = (const f32x4*)(wexp + (size_t)k * 32);
#pragma unroll
                for (int q = 0; q < 8; ++q) { const f32x4 w = we[q];
#pragma unroll
                    for (int e = 0; e < 4; ++e) acc[4 * q + e] += sh * w[e]; }
                const f32x4 wg = *(const f32x4*)(wgrp + (size_t)k * 4);
#pragma unroll
                for (int e = 0; e < 4; ++e) acc[32 + e] += sh * wg[e];
            }
#pragma unroll
            for (int e = 0; e < 36; ++e) acc[e] = wave_sum(acc[e]);
            LAS float* part = (LAS float*)cx.lds;
            if (cx.lane == 0) {
#pragma unroll
                for (int e = 0; e < 36; ++e) part[cx.wave * 36 + e] = acc[e];
            }
            __syncthreads();
            if (cx.tid < 36) {
                const float s = (part[cx.tid] + part[36 + cx.tid]) + (part[72 + cx.tid] + part[108 + cx.tid]);
                float* rco = cx.rc() + (size_t)pair * 64;
                rco[cx.tid] = s + (cx.tid < 32 ? cx.in(22)[layer * 32 + cx.tid] : cx.in(20)[layer * 4 + cx.tid - 32]);
            }
            __syncthreads();
        }
    }
#define P1_SRC(tt) ({ const int b_ = (tt) / TPB, j_ = (tt) - b_ * TPB; (j_ < CTX) ? cx.in(2) + (size_t)(b_ * CTX + j_) * D : cx.in(0) + (size_t)(b_ * SEQ + j_ - CTX) * D; })
    f32x4 nv[4];
    if (gw < T) load_row(P1_SRC(gw), nv, cx.lane);
    for (int t = gw; t < T; t += gstride) {
        const int b = t / TPB, j = t - b * TPB;
        f32x4 v[4];
#pragma unroll
        for (int q = 0; q < 4; ++q) v[q] = nv[q];
        if (t + gstride < T) load_row(P1_SRC(t + gstride), nv, cx.lane);
        const float* md = cx.mod() + (size_t)(j < CTX ? 8 : b) * 6144;
        f32x4 ngv[4], ns0[4], ns1[4];
#pragma unroll
        for (int q = 0; q < 4; ++q) { ngv[q] = ((const f32x4*)cx.in(6))[cx.lane + 64 * q]; ns0[q] = ((const f32x4*)md)[cx.lane + 64 * q]; ns1[q] = ((const f32x4*)(md + 1024))[cx.lane + 64 * q]; }
#pragma unroll
        for (int q = 0; q < 4; ++q) asm volatile("" : "+v"(ngv[q]), "+v"(ns0[q]), "+v"(ns1[q]));
        store_row_bf16(cx.xres() + (size_t)t * D, v, cx.lane);
        norm_mod_pre(v, ngv, ns0, ns1);
        store_row_bf16(cx.H() + (size_t)t * D, v, cx.lane);
    }
#undef P1_SRC
}

DI void phase_norm_route(const Ctx& cx, int layer, bool last, bool dummy) {
    const int lane = cx.lane, c = lane & 31, h = lane >> 5, w = cx.wave;
    {
        int nhb = (T / 32) % (int)gridDim.x;
        if (4 * nhb >= (int)gridDim.x) nhb = 0;
        const int gw = ((int)blockIdx.x - nhb) * 4 + w, gstride = ((int)gridDim.x - nhb) * 4;
        for (int t = (gw < 0 ? T : gw); t < T; t += gstride) {
            const int b = t / TPB, j = t - b * TPB;
            if (last && j < CTX) continue;
            f32x4 v[4]; load_row_bf16(cx.xres() + (size_t)t * D, v, lane);
            const float* md = cx.mod() + ((size_t)layer * 9 + (j < CTX ? 8 : b)) * 6144;
            norm_mod(v, cx.in(7) + layer * D, md + 3072, md + 4096, lane);
            store_row_bf16(cx.H() + (size_t)t * D, v, lane);
        }
    }
    unsigned* cnt = cx.ctl() + CW_CNT + layer * 32 * 64 + (dummy ? 32 : 0);
    int* ltok_ = dummy ? (int*)cx.YP() : cx.ltok(); float* lw_ = dummy ? (float*)(cx.YP() + 4 * 1024 * 1024) : cx.lw();
    const bf16* whi = cx.wr() + (size_t)(layer * 2) * 64 * D + (size_t)c * D + 256 * w + 8 * h;
    LAS float* red = (LAS float*)cx.lds;
    LAS unsigned* hist = (LAS unsigned*)(cx.lds + 4 * 33 * 64 * 4);
    for (int task = blockIdx.x; task < T / 32; task += gridDim.x) {
        const int t0 = task * 32, b = t0 / TPB, j0 = t0 - b * TPB;
        if (last && j0 < CTX) continue;
        const int t = t0 + c, mrow = (j0 < CTX ? 8 : b);
        const bf16* xrow = cx.xres() + (size_t)t * D + 256 * w + 8 * h;
        const float* gmv = cx.gm() + ((size_t)layer * 9 + mrow) * D + 256 * w + 8 * h;
        float ss = 0.f;
        f32x16 acc0, acc1;
#pragma unroll
        for (int i = 0; i < 16; ++i) { acc0[i] = 0.f; acc1[i] = 0.f; }
        LAS unsigned char* park = cx.lds + w * 16384 + lane * 16;
#pragma unroll
        for (int s = 0; s < 16; ++s) glds16(xrow + 16 * s, park + s * 1024);
        asm volatile("s_waitcnt vmcnt(0)" ::: "memory");
#pragma unroll 4
        for (int s = 0; s < 16; ++s) {
            float x[8];
            { const u32x4 xq = *(LAS u32x4*)(park + s * 1024);
              const f32x4 a = {__builtin_bit_cast(float, xq.x << 16), __builtin_bit_cast(float, xq.x & 0xffff0000u), __builtin_bit_cast(float, xq.y << 16), __builtin_bit_cast(float, xq.y & 0xffff0000u)};
              const f32x4 bq = {__builtin_bit_cast(float, xq.z << 16), __builtin_bit_cast(float, xq.z & 0xffff0000u), __builtin_bit_cast(float, xq.w << 16), __builtin_bit_cast(float, xq.w & 0xffff0000u)};
              const f32x4 g0 = *(const f32x4*)(gmv + 16 * s), g1 = *(const f32x4*)(gmv + 16 * s + 4);
              ss += (a[0] * a[0] + a[1] * a[1]) + (a[2] * a[2] + a[3] * a[3]) + (bq[0] * bq[0] + bq[1] * bq[1]) + (bq[2] * bq[2] + bq[3] * bq[3]);
#pragma unroll
              for (int e = 0; e < 4; ++e) { x[e] = a[e] * g0[e]; x[4 + e] = bq[e] * g1[e]; } }
            u32x4 hi, lo;
            hi.x = pk2(x[0], x[1]); hi.y = pk2(x[2], x[3]); hi.z = pk2(x[4], x[5]); hi.w = pk2(x[6], x[7]);
            lo.x = pk2(x[0] - __builtin_bit_cast(float, hi.x << 16), x[1] - __builtin_bit_cast(float, hi.x & 0xffff0000u));
            lo.y = pk2(x[2] - __builtin_bit_cast(float, hi.y << 16), x[3] - __builtin_bit_cast(float, hi.y & 0xffff0000u));
            lo.z = pk2(x[4] - __builtin_bit_cast(float, hi.z << 16), x[5] - __builtin_bit_cast(float, hi.z & 0xffff0000u));
            lo.w = pk2(x[6] - __builtin_bit_cast(float, hi.w << 16), x[7] - __builtin_bit_cast(float, hi.w & 0xffff0000u));
            const bf16x8 bhi = __builtin_bit_cast(bf16x8, hi), blo = __builtin_bit_cast(bf16x8, lo);
            const bf16x8 ah0 = ldg8(whi + 16 * s), ah1 = ldg8(whi + 32 * D + 16 * s), al0 = ldg8(whi + 64 * D + 16 * s), al1 = ldg8(whi + 96 * D + 16 * s);
            acc0 = MFMA(ah0, bhi, acc0); acc0 = MFMA(al0, bhi, acc0); acc0 = MFMA(ah0, blo, acc0);
            acc1 = MFMA(ah1, bhi, acc1); acc1 = MFMA(al1, bhi, acc1); acc1 = MFMA(ah1, blo, acc1);
        }
        __syncthreads();
        LAS float* my = red + (size_t)w * 33 * 64 + lane;
#pragma unroll
        for (int i = 0; i < 16; ++i) { my[i * 64] = acc0[i]; my[(16 + i) * 64] = acc1[i]; }
        my[32 * 64] = ss;
        __syncthreads();
        if (w == 0) {
#pragma unroll
            for (int ww = 1; ww < 4; ++ww) {
                const LAS float* o = red + (size_t)ww * 33 * 64 + lane;
#pragma unroll
                for (int i = 0; i < 16; ++i) { acc0[i] += o[i * 64]; acc1[i] += o[(16 + i) * 64]; }
                ss += o[32 * 64];
            }
            ss += __shfl_xor(ss, 32);
            const float rn = rsqrtf(ss * (1.f / D) + EPS);
            const float* rcv = cx.rc() + ((size_t)layer * 9 + mrow) * 64;
            float gl[4];
#pragma unroll
            for (int g = 0; g < 4; ++g) gl[g] = __shfl(acc1[g], c) * rn + rcv[32 + g];
            int gi = 0; float gmx = gl[0];
#pragma unroll
            for (int g = 1; g < 4; ++g) if (gl[g] > gmx) { gmx = gl[g]; gi = g; }
            float gs = 0.f;
#pragma unroll
            for (int g = 0; g < 4; ++g) gs += __expf(gl[g] - gmx);
            const float gp = 1.f / gs;
            float mine[4], other[4], el[8];
#pragma unroll
            for (int e = 0; e < 4; ++e) {
                float xv = acc0[e];
#pragma unroll
                for (int g = 1; g < 4; ++g) xv = (gi == g) ? acc0[4 * g + e] : xv;
                mine[e] = xv * rn + rcv[gi * 8 + 4 * h + e];
            }
#pragma unroll
            for (int e = 0; e < 4; ++e) other[e] = __shfl_xor(mine[e], 32);
#pragma unroll
            for (int e = 0; e < 4; ++e) { el[e] = (h == 0) ? mine[e] : other[e]; el[4 + e] = (h == 0) ? other[e] : mine[e]; }
            int i1 = 0; float v1 = el[0];
#pragma unroll
            for (int e = 1; e < 8; ++e) if (el[e] > v1) { v1 = el[e]; i1 = e; }
            int i2 = 0; float v2 = -3.0e38f;
#pragma unroll
            for (int e = 0; e < 8; ++e) if (e != i1 && el[e] > v2) { v2 = el[e]; i2 = e; }
            const float ex = __expf(v2 - v1);
            const float w1 = gp / (1.f + ex), w2 = gp * ex / (1.f + ex);
            if (h == 0) {
                const int e1 = gi * 8 + i1, e2 = gi * 8 + i2;
                hist[c] = 0u;
                asm volatile("s_waitcnt lgkmcnt(0)" ::: "memory");
                const unsigned r1 = __hip_atomic_fetch_add(&hist[e1], 1u, __ATOMIC_RELAXED, __HIP_MEMORY_SCOPE_WORKGROUP);
                const unsigned r2 = __hip_atomic_fetch_add(&hist[e2], 1u, __ATOMIC_RELAXED, __HIP_MEMORY_SCOPE_WORKGROUP);
                asm volatile("s_waitcnt lgkmcnt(0)" ::: "memory");
                const unsigned n = hist[c];
                unsigned bs = 0u;
                if (n) bs = atomicAdd(&cnt[c * 64], n);
                hist[32 + c] = bs;
                asm volatile("s_waitcnt lgkmcnt(0)" ::: "memory");
                const unsigned s1 = hist[32 + e1] + r1, s2 = hist[32 + e2] + r2;
                ltok_[(size_t)e1 * LCAP + s1] = t * 2;     lw_[(size_t)e1 * LCAP + s1] = w1;
                ltok_[(size_t)e2 * LCAP + s2] = t * 2 + 1; lw_[(size_t)e2 * LCAP + s2] = w2;
            }
        }
        __syncthreads();
    }
}

DI ConvTask conv_task(const Ctx& cx, int layer, int task, int lane) {
    const int e = task / 768, u = task - e * 768, which = u >> 8, v = u & 255;
    const float* W; bf16* WT; int K, N, kt, nt;
    if (which == 0) { W = cx.in(23) + ((size_t)layer * NEXP + e) * D * DEXP; WT = cx.wmg() + (size_t)e * DEXP * D; K = D; N = DEXP; kt = v >> 4; nt = v & 15; }
    else if (which == 1) { W = cx.in(24) + ((size_t)layer * NEXP + e) * D * DEXP; WT = cx.wmu() + (size_t)e * DEXP * D; K = D; N = DEXP; kt = v >> 4; nt = v & 15; }
    else { W = cx.in(25) + ((size_t)layer * NEXP + e) * DEXP * D; WT = cx.wmd() + (size_t)e * D * DEXP; K = DEXP; N = D; kt = v >> 5; nt = v & 31; }
    ConvTask t;
    t.src = W + (size_t)(kt * 64 + (lane >> 3)) * N + nt * 32 + (lane & 7) * 4;
    t.dst = WT + (size_t)(nt * 32 + (lane >> 3)) * K + kt * 64 + (lane & 7) * 8;
    t.N = N; t.K = K;
    return t;
}
DI void moe_convert(const Ctx& cx, int layer) {
    const int gw = blockIdx.x * 4 + cx.wave, nw = gridDim.x * 4;
    const int lane = cx.lane;
    constexpr int NT = NEXP * 768;
    LAS float* scr = (LAS float*)(cx.lds + 36864) + cx.wave * (64 * 33);
#define CV_LOAD(X, task) do { const ConvTask ct_ = conv_task(cx, layer, (task), lane); \
        _Pragma("unroll") for (int p = 0; p < 8; ++p) X[p] = *(const f32x4*)(ct_.src + (size_t)(8 * p) * ct_.N); } while (0)
#define CV_PROC(X, task) do { const ConvTask ct_ = conv_task(cx, layer, (task), lane); \
        _Pragma("unroll") for (int p = 0; p < 8; ++p) { LAS float* d = scr + ((lane >> 3) + 8 * p) * 33 + (lane & 7) * 4; d[0] = X[p][0]; d[1] = X[p][1]; d[2] = X[p][2]; d[3] = X[p][3]; } \
        asm volatile("s_waitcnt lgkmcnt(0)" ::: "memory"); \
        _Pragma("unroll") for (int p = 0; p < 4; ++p) { const LAS float* s = scr + ((lane & 7) * 8) * 33 + (lane >> 3) + 8 * p; \
            u32x4 o; o.x = pk2(s[0], s[33]); o.y = pk2(s[2 * 33], s[3 * 33]); o.z = pk2(s[4 * 33], s[5 * 33]); o.w = pk2(s[6 * 33], s[7 * 33]); \
            *(u32x4*)(ct_.dst + (size_t)(8 * p) * ct_.K) = o; } \
        asm volatile("s_waitcnt lgkmcnt(0)" ::: "memory"); } while (0)
    int nheavy = ((T / 32) % (int)gridDim.x) * 4;
    if (2 * nheavy >= nw) nheavy = 0;
    const bool heavy = gw < nheavy;
    const int S = nw - nheavy, base = gw - nheavy;
#define CV_ITEM(j) (heavy ? NT : base + S * (j))
    f32x4 xa[8], xb[8];
    int j = 0, task = CV_ITEM(0);
    if (task < NT) CV_LOAD(xa, task);
#pragma unroll 1
    while (task < NT) {
        const int t2 = CV_ITEM(j + 1), t3 = CV_ITEM(j + 2);
        if (t2 < NT) CV_LOAD(xb, t2);
        CV_PROC(xa, task);
        if (t3 < NT) CV_LOAD(xa, t3);
        if (t2 < NT) CV_PROC(xb, t2);
        task = t3; j += 2;
    }
#undef CV_ITEM
#undef CV_LOAD
#undef CV_PROC
}

DI void phase_combine(const Ctx& cx, int layer, bool last, bool dummy) {
    const int gw = blockIdx.x * 4 + cx.wave, gstride = gridDim.x * 4;
    for (int t = gw; t < T; t += gstride) {
        const int b = t / TPB, j = t - b * TPB;
        if (last && j < CTX) continue;
        bf16* xr = cx.xres() + (size_t)t * D;
        f32x4 v[4]; load_row_bf16(xr, v, cx.lane);
        const int mr = (j < CTX) ? 8 : b;
        const float* g2 = cx.mod() + ((size_t)layer * 9 + mr) * 6144 + 5120;
        const bf16* y0 = cx.YP() + (size_t)(2 * t) * D; const bf16* y1 = y0 + D;
        f32x4 ngv[4], ns0[4], ns1[4];
        if (!last) {
            const float* md = cx.mod() + ((size_t)(layer + 1) * 9 + mr) * 6144;
            const float* gn = cx.in(6) + (layer + 1) * D;
#pragma unroll
            for (int jj = 0; jj < 4; ++jj) { ngv[jj] = ((const f32x4*)gn)[cx.lane + 64 * jj]; ns0[jj] = ((const f32x4*)md)[cx.lane + 64 * jj]; ns1[jj] = ((const f32x4*)(md + 1024))[cx.lane + 64 * jj]; }
        }
#pragma unroll
        for (int jj = 0; jj < 4; ++jj) {
            const u32x2 a = ((const u32x2*)y0)[cx.lane + 64 * jj], bq = ((const u32x2*)y1)[cx.lane + 64 * jj];
            const f32x4 gg = ((const f32x4*)g2)[cx.lane + 64 * jj];
            float ya[4] = {bf2f((unsigned short)(a.x & 0xffff)), bf2f((unsigned short)(a.x >> 16)), bf2f((unsigned short)(a.y & 0xffff)), bf2f((unsigned short)(a.y >> 16))};
            float yb[4] = {bf2f((unsigned short)(bq.x & 0xffff)), bf2f((unsigned short)(bq.x >> 16)), bf2f((unsigned short)(bq.y & 0xffff)), bf2f((unsigned short)(bq.y >> 16))};
#pragma unroll
            for (int e = 0; e < 4; ++e) v[jj][e] += gg[e] * (ya[e] + yb[e]);
        }
        if (!last) {
            bf16* xw = dummy ? cx.Q() + (size_t)t * D : xr;
#pragma unroll
            for (int jj = 0; jj < 4; ++jj) asm volatile("" : "+v"(ngv[jj]), "+v"(ns0[jj]), "+v"(ns1[jj]));
            store_row_bf16(xw, v, cx.lane);
            norm_mod_pre(v, ngv, ns0, ns1);
            store_row_bf16(cx.H() + (size_t)t * D, v, cx.lane);
        } else {
            float ss = 0.f;
#pragma unroll
            for (int jj = 0; jj < 4; ++jj) ss += (v[jj][0] * v[jj][0] + v[jj][1] * v[jj][1]) + (v[jj][2] * v[jj][2] + v[jj][3] * v[jj][3]);
            const float rn = rsqrtf(wave_sum(ss) * (1.f / D) + EPS);
            float* orow = cx.out() + (size_t)(b * SEQ + j - CTX) * D;
#pragma unroll
            for (int jj = 0; jj < 4; ++jj) {
                const f32x4 gg = ((const f32x4*)cx.in(8))[cx.lane + 64 * jj];
                f32x4 o;
#pragma unroll
                for (int e = 0; e < 4; ++e) o[e] = v[jj][e] * rn * gg[e];
                ((f32x4*)orow)[cx.lane + 64 * jj] = o;
            }
        }
    }
}

DI void moe_directory(const Ctx& cx, int layer, LAS int* s_off, LAS int* s_toff) {
    if (cx.tid < 64) {
        const unsigned* cnt = cx.ctl() + CW_CNT + layer * 32 * 64;
        const int e = cx.lane;
        const int c = (e < NEXP) ? (int)cnt[e * 64] : 0;
        int o = c, to = (c + 127) >> 7;
#pragma unroll
        for (int d = 1; d < NEXP; d <<= 1) { const int a = __shfl_up(o, d), b2 = __shfl_up(to, d); if (e >= d) { o += a; to += b2; } }
        if (e < NEXP) { s_off[e + 1] = o; s_toff[e + 1] = to; }
        if (e == 0) { s_off[0] = 0; s_toff[0] = 0; }
    }
    __syncthreads();
}

__global__ void __launch_bounds__(NTHREADS, 2) fwd_kernel(Params p) {
    extern __shared__ __attribute__((aligned(16))) unsigned char lds_raw[];
    Ctx cx;
    cx.pp = (ParamsPtr)__builtin_amdgcn_kernarg_segment_ptr();
    cx.lds = (LAS unsigned char*)lds_raw;
    cx.tid = threadIdx.x; cx.lane = cx.tid & 63; cx.wave = __builtin_amdgcn_readfirstlane(cx.tid >> 6);
    volatile LAS unsigned* misc = (volatile LAS unsigned*)(cx.lds + LDS_MISC);
    LAS int* s_off = (LAS int*)(cx.lds + LDS_MISC + 64);
    LAS int* s_toff = (LAS int*)(cx.lds + LDS_MISC + 64 + 160);
    if (cx.tid < 2) misc[cx.tid] = 0u;
    __syncthreads();
    if (cx.pp->ph_hi - cx.pp->ph_lo > 1) (void)xcd_barrier_post((unsigned*)(cx.pp->ws + WS_CTL) + CW_BAR, misc);
    bool again_ = false;
    for (int ph = cx.pp->ph_lo; ; ) {
        asm volatile("" : "+s"(cx.pp));
        { int tid_ = threadIdx.x; asm volatile("" : "+v"(tid_)); cx.tid = tid_; cx.lane = tid_ & 63; cx.wave = __builtin_amdgcn_readfirstlane(tid_ >> 6); }
        if (ph == 0) phase_prologue(cx);
        else if (ph == 1) phase_first_norm(cx);
        else {
            const int layer = (ph - 2) / 7, sub = (ph - 2) % 7, kind = layer % 3;
#ifdef PROBE_REP
            const bool dummy = !again_ && ((PROBE_REP >> ph) & 1ull);
#else
            const bool dummy = false;
#endif
            const bool last = (layer == DEPTH - 1);
            const int vbid = (gridDim.x & 7) ? (int)blockIdx.x : (int)((blockIdx.x & 7) * (gridDim.x >> 3) + (blockIdx.x >> 3));
            if (sub == 0) {
                QkvOp op; op.A = cx.H(); op.kind = kind; op.Q = cx.Q(); op.Kb = cx.K(); op.VT = cx.VT(); op.rc = cx.ropec(); op.rs = cx.ropes();
                op.Wt = cx.wqkv(layer);
                op.rl = (LAS const float*)(cx.lds + 65536);
                if (kind != 0) {
                    LAS float* rl_ = (LAS float*)(cx.lds + 65536);
                    for (int i = cx.tid; i < 512; i += NTHREADS) *(LAS f32x4*)(rl_ + 4 * i) = (i < 256) ? *(const f32x4*)(cx.ropec() + 4 * i) : *(const f32x4*)(cx.ropes() + 4 * (i - 256));
                    __syncthreads();
                }
                if (kind == 2) { op.N = 1536; op.kw = 256; op.voff = 1280; op.vw = 256; }
                else { op.N = 3072; op.kw = D; op.voff = 2048; op.vw = D; }
                const int ntn = op.N / 128, ntiles = (T / 128) * ntn;
                for (int tile = (kind == 2 ? vbid : (int)blockIdx.x); tile < ntiles; tile += gridDim.x) {
                    op.m0 = (tile / ntn) * 128; op.n0 = (tile % ntn) * 128;
                    gemm_tile<2, 2, 64>(op, cx.lds, cx.tid);
                }
            } else if (sub == 1) {
                if (kind == 1) attn_block_da(cx, layer, !last, vbid); else attn_block_nasw(cx, kind, layer, !last, vbid);
            } else if (sub == 2) {
                OutOp op; op.A = cx.O(); op.xres = cx.xres(); op.xdst = dummy ? cx.Q() : cx.xres(); op.modl = cx.mod() + (size_t)layer * 9 * 6144;
                op.Wt = cx.wo(layer);
                for (int tile = vbid; tile < 1024; tile += gridDim.x) {
                    int mt = tile >> 3;
                    if (last) mt = (mt >> 4) * 18 + 2 + (mt & 15);
                    op.m0 = mt * 128; op.n0 = (tile & 7) * 128;
                    gemm_tile<2, 2, 64>(op, cx.lds, cx.tid);
                }
                if (!last) for (int ub = blockIdx.x; ub < 256; ub += gridDim.x) {
                    const int u = (gridDim.x & 7) ? ub : ((ub & 7) * 32 + (ub >> 3));
                    op.m0 = 128 * 128 + (u >> 3) * 64; op.n0 = (u & 7) * 128;
                    gemm_tile<1, 2, 64>(op, cx.lds, cx.tid);
                }
            } else if (sub == 3) {
                if (blockIdx.x & 1) { moe_convert(cx, layer); __syncthreads(); }
                phase_norm_route(cx, layer, last, dummy);
                if (!(blockIdx.x & 1)) { __syncthreads(); moe_convert(cx, layer); }
#ifdef PROBE_CONV2
                moe_convert(cx, layer);
#endif
            } else if (sub == 4) {
                moe_directory(cx, layer, s_off, s_toff);
                const int ntiles = s_toff[NEXP] * 8;
                int ecur = 0;
                for (int tile = vbid; tile < ntiles; tile += gridDim.x) {
                    const int rtg = tile >> 3; int e = ecur;
                    while (s_toff[e + 1] <= rtg) ++e;
                    ecur = e;
                    GateUpOp op; op.H = cx.H(); op.cnt = s_off[e + 1] - s_off[e]; op.r0 = (rtg - s_toff[e]) * 128; op.f0 = (tile & 7) * 64;
                    op.WgT = cx.wmg() + (size_t)e * DEXP * D; op.WuT = cx.wmu() + (size_t)e * DEXP * D;
                    op.ltok = cx.ltok() + (size_t)e * LCAP; op.act = cx.ACT() + (size_t)s_off[e] * DEXP;
                    gemm_tile<2, 2, 64>(op, cx.lds, cx.tid);
                }
            } else if (sub == 5) {
                moe_directory(cx, layer, s_off, s_toff);
                const int ntiles = s_toff[NEXP] * 8;
                DownOp op, nop; op.yp = cx.YP(); nop.yp = op.yp;
#define F_SET(o, tl) do { const int rtg_ = (tl) >> 3; int e_ = ecur; while (s_toff[e_ + 1] <= rtg_) ++e_; ecur = e_; \
                    (o).cnt = s_off[e_ + 1] - s_off[e_]; (o).r0 = (rtg_ - s_toff[e_]) * 128; (o).n0 = ((tl) & 7) * 128; \
                    (o).act = cx.ACT() + (size_t)s_off[e_] * DEXP; (o).WdT = cx.wmd() + (size_t)e_ * D * DEXP; \
                    (o).ltok = cx.ltok() + (size_t)e_ * LCAP; (o).lw = cx.lw() + (size_t)e_ * LCAP; } while (0)
                int tile = vbid, ecur = 0; bool first = true;
                if (tile < ntiles) F_SET(op, tile);
                while (tile < ntiles) {
                    const int nt_ = tile + gridDim.x; const bool hn = nt_ < ntiles;
                    if (hn) F_SET(nop, nt_); else nop = op;
                    gemm_tile_x<2, 2, 64, true>(op, nop, hn, first, cx.lds, cx.tid);
                    op = nop; tile = nt_; first = false;
                }
#undef F_SET
            } else {
                phase_combine(cx, layer, last, dummy);
            }
        }
#ifdef PROBE_REP
        if (!again_ && ((PROBE_REP >> ph) & 1ull)) again_ = true; else { again_ = false; ++ph; }
#else
        ++ph;
#endif
        if (ph >= cx.pp->ph_hi) break;
        { XcdBarrier bar; bar.bar = cx.ctl() + CW_BAR; bar.x = xb_xcc_id(); bar.st = (volatile LAS unsigned*)(cx.lds + LDS_MISC); xcd_barrier(bar);
#ifdef PROBE_BAR2
          xcd_barrier(bar);
#endif
        }
    }
}

extern "C" void kernel_launch(void* const* d_in, const int* in_sizes, int n_in, void* d_out, int out_size, void* d_ws, size_t ws_size, hipStream_t stream) {
    static int grid = 0;
    if (grid == 0) {
        if (n_in != 26 || ws_size < WS_END) { fprintf(stderr, "kernel_launch: unexpected inputs (n_in %d) or workspace %zu < %zu\n", n_in, ws_size, (size_t)WS_END); grid = -1; return; }
        int dev = 0, cus = 0, per_cu = 0;
        (void)hipGetDevice(&dev);
        (void)hipDeviceGetAttribute(&cus, hipDeviceAttributeMultiprocessorCount, dev);
        if (hipFuncSetAttribute((const void*)fwd_kernel, hipFuncAttributeMaxDynamicSharedMemorySize, LDS_BYTES) != hipSuccess) { fprintf(stderr, "kernel_launch: hipFuncSetAttribute failed\n"); grid = -1; return; }
        if (hipOccupancyMaxActiveBlocksPerMultiprocessor(&per_cu, (const void*)fwd_kernel, NTHREADS, LDS_BYTES) != hipSuccess || per_cu < 1) { fprintf(stderr, "kernel_launch: occupancy query failed (%d)\n", per_cu); per_cu = 1; }
        (void)hipGetLastError();
        if (per_cu > 2) per_cu = 2;
        grid = cus * per_cu;
        fprintf(stderr, "kernel_launch: %d CUs x %d blocks\n", cus, per_cu);
    }
    if (grid < 0) return;
    (void)hipMemsetAsync((char*)d_ws + WS_CTL, 0, CTL_BYTES, stream);
    Params p{};
    for (int i = 0; i < 26; ++i) p.in[i] = (const float*)d_in[i];
    p.out = (float*)d_out; p.ws = (unsigned char*)d_ws;
#if ONE_LAUNCH
    p.ph_lo = 0; p.ph_hi = NPHASES;
    hipLaunchKernelGGL(fwd_kernel, dim3(grid), dim3(NTHREADS), LDS_BYTES, stream, p);
#else
    for (int ph = 0; ph < NPHASES; ++ph) {
        p.ph_lo = ph; p.ph_hi = ph + 1;
        hipLaunchKernelGGL(fwd_kernel, dim3(grid), dim3(NTHREADS), LDS_BYTES, stream, p);
    }
#endif
}
```
